# Optimizing an MI355X kernel written in HIP

```python
import math
import jax, jax.numpy as jnp
from jax import lax
import numpy as np

D_MODEL = 1024
BATCH = 2
SEQ = 16384
DEPTH = 2

F32 = jnp.float32
NEG = -1e30
LN_EPS = 1e-5
RMS_EPS = 1e-6
DN_ALPHA = (2.0 * DEPTH) ** 0.25
DN_BETA = (8.0 * DEPTH) ** -0.25

A_HEADS = 4
A_DK = 128
A_DV = 128
A_CHUNK = 64
A_KW = A_HEADS * A_DK
A_VW = A_HEADS * A_DV

B_WIDTH = 512
B_GROUP = 16
B_GROUPS = B_WIDTH // B_GROUP
B_STATE = 64
DT_MIN = 1e-3
DT_MAX = 1e-1

HEAD_DIM = 64
C_HEADS = 8
C_KV = 2
WINDOW = 128
D_HEADS = 8
D_KV = 2
MOBA_BLOCK = 256
MOBA_TOPK = 3
MOBA_QCHUNK = 64
C_QW = C_HEADS * HEAD_DIM
C_KVW = C_KV * HEAD_DIM
D_QW = D_HEADS * HEAD_DIM
D_KVW = D_KV * HEAD_DIM

EV_IN = 2 * A_KW + 2 * A_VW + B_WIDTH
EV_MIX = A_VW + B_WIDTH
OD_IN = C_QW + 2 * C_KVW + D_QW + 2 * D_KVW
OD_MIX = C_QW + D_QW

N_GROUPS = 4
EXP_PER_GROUP = 4
N_EXPERTS = N_GROUPS * EXP_PER_GROUP
EXP_HIDDEN = 256
EXP_TOPK = 2

kernel_name = 'hybrid_hgrn2_s5_swa_moba_hmoe'


def split_cols(p, widths):
    outs, start = [], 0
    for w in widths:
        outs.append(p[..., start:start + w])
        start += w
    return outs


def layer_norm(x, g, b):
    xf = x.astype(F32)
    mu = jnp.mean(xf, axis=-1, keepdims=True)
    var = jnp.mean(jnp.square(xf - mu), axis=-1, keepdims=True)
    return ((xf - mu) * lax.rsqrt(var + LN_EPS) * g.astype(F32) + b.astype(F32)).astype(x.dtype)


def hgrn2_mixer(q, f_logit, inp, gate, lower_bound, norm_g):
    Bsz, L, _ = q.shape
    n = L // A_CHUNK

    def heads(t, d):
        return t.astype(F32).reshape(Bsz, n, A_CHUNK, A_HEADS, d).transpose(0, 3, 1, 2, 4)

    lb = lower_bound.astype(F32)
    f = lb + (1.0 - lb) * jax.nn.sigmoid(f_logit.astype(F32))
    qh = heads(jax.nn.silu(q.astype(F32)), A_DK)
    kh = heads(1.0 - f, A_DK)
    lf = heads(jnp.log(f), A_DK)
    vh = heads(inp, A_DV)
    b = jnp.cumsum(lf, axis=3)
    b_last = b[:, :, :, -1:, :]
    q_dec = qh * jnp.exp(b)
    k_inv = kh * jnp.exp(-b)
    k_tail = kh * jnp.exp(b_last - b)
    causal = jnp.tril(jnp.ones((A_CHUNK, A_CHUNK), dtype=bool))
    att = jnp.where(causal, jnp.einsum('bhnck,bhnsk->bhncs', q_dec, k_inv), 0.0)
    o_intra = jnp.einsum('bhncs,bhnsv->bhncv', att, vh)
    d_state = jnp.einsum('bhnsk,bhnsv->bhnkv', k_tail, vh)
    chunk_decay = jnp.exp(b_last[:, :, :, 0, :])

    def step(S, xs):
        dec, ds = xs
        return dec[..., None] * S + ds, S

    S0 = jnp.zeros((Bsz, A_HEADS, A_DK, A_DV), F32)
    _, S_prev = lax.scan(step, S0, (jnp.moveaxis(chunk_decay, 2, 0), jnp.moveaxis(d_state, 2, 0)))
    S_prev = jnp.moveaxis(S_prev, 0, 2)
    o = o_intra + jnp.einsum('bhnck,bhnkv->bhncv', q_dec, S_prev)
    o = o * lax.rsqrt(jnp.mean(o * o, axis=-1, keepdims=True) + RMS_EPS)
    o = o.transpose(0, 2, 3, 1, 4).reshape(Bsz, L, A_VW)
    return (o * norm_g.astype(F32) * jax.nn.silu(gate.astype(F32))).astype(q.dtype)


def s5_mixer(u, a_re, a_im, log_dt, b_re, b_im, c_re, c_im, d_skip, w_glu):
    Bsz, L, _ = u.shape
    uf = u.astype(F32)
    ug = uf.reshape(Bsz, L, B_GROUPS, B_GROUP)
    dt = jnp.exp(log_dt.astype(F32))[:, None]
    ar, ai = a_re.astype(F32), a_im.astype(F32)
    mag = jnp.exp(dt * ar)
    abar_re, abar_im = mag * jnp.cos(dt * ai), mag * jnp.sin(dt * ai)
    den = ar * ar + ai * ai
    xr, xi = abar_re - 1.0, abar_im
    fr = (xr * ar + xi * ai) / den
    fi = (xi * ar - xr * ai) / den
    br, bi = b_re.astype(F32), b_im.astype(F32)
    bbar_re = fr[..., None] * br - fi[..., None] * bi
    bbar_im = fr[..., None] * bi + fi[..., None] * br
    drive_re = jnp.einsum('blgn,gpn->blgp', ug, bbar_re)
    drive_im = jnp.einsum('blgn,gpn->blgp', ug, bbar_im)
    a_full_re = jnp.broadcast_to(abar_re, drive_re.shape)
    a_full_im = jnp.broadcast_to(abar_im, drive_re.shape)

    def combine(e1, e2):
        a1r, a1i, b1r, b1i = e1
        a2r, a2i, b2r, b2i = e2
        return (a1r * a2r - a1i * a2i, a1r * a2i + a1i * a2r,
                a2r * b1r - a2i * b1i + b2r, a2r * b1i + a2i * b1r + b2i)

    _, _, h_re, h_im = lax.associative_scan(combine, (a_full_re, a_full_im, drive_re, drive_im), axis=1)
    y = (jnp.einsum('blgp,gnp->blgn', h_re, c_re.astype(F32))
         - jnp.einsum('blgp,gnp->blgn', h_im, c_im.astype(F32)))
    y = jax.nn.gelu(y.reshape(Bsz, L, B_WIDTH) + d_skip.astype(F32) * uf)
    z = jnp.einsum('blc,cf->blf', y, w_glu.astype(F32))
    return (z[..., :B_WIDTH] * jax.nn.sigmoid(z[..., B_WIDTH:])).astype(u.dtype)


def sliding_window_attention(q, k, v, sinks):
    Bsz, L, _ = q.shape
    nb = L // WINDOW
    G = C_HEADS // C_KV
    scale = HEAD_DIM ** -0.5
    qb = q.astype(F32).reshape(Bsz, nb, WINDOW, C_KV, G, HEAD_DIM) * scale
    kb = k.astype(F32).reshape(Bsz, nb, WINDOW, C_KV, HEAD_DIM)
    vb = v.astype(F32).reshape(Bsz, nb, WINDOW, C_KV, HEAD_DIM)
    prev = lambda t: jnp.concatenate([jnp.zeros_like(t[:, :1]), t[:, :-1]], axis=1)
    kk = jnp.concatenate([prev(kb), kb], axis=2)
    vv = jnp.concatenate([prev(vb), vb], axis=2)
    s = jnp.einsum('bnqhgd,bnkhd->bnhgqk', qb, kk)
    qpos = jnp.arange(WINDOW)[:, None] + WINDOW
    kpos = jnp.arange(2 * WINDOW)[None, :]
    band = (kpos <= qpos) & (qpos - kpos < WINDOW)
    first = (jnp.arange(nb) == 0)[:, None, None] & (kpos < WINDOW)[None]
    valid = band[None] & ~first
    s = jnp.where(valid[None, :, None, None], s, NEG)
    sink = sinks.astype(F32).reshape(C_KV, G)[None, None, :, :, None, None]
    m = jnp.maximum(jnp.max(s, axis=-1, keepdims=True), sink)
    p = jnp.exp(s - m)
    denom = jnp.sum(p, axis=-1, keepdims=True) + jnp.exp(sink - m)
    o = jnp.einsum('bnhgqk,bnkhd->bnqhgd', p / denom, vv)
    return o.reshape(Bsz, L, C_QW).astype(q.dtype)


def moba_attention(q, k, v):
    Bsz, L, _ = q.shape
    Lp = -(-L // MOBA_BLOCK) * MOBA_BLOCK
    nb = Lp // MOBA_BLOCK
    G = D_HEADS // D_KV
    scale = HEAD_DIM ** -0.5
    pad = ((0, 0), (0, Lp - L), (0, 0))
    qh = (jnp.pad(q.astype(F32), pad) * scale).reshape(Bsz, Lp, D_HEADS, HEAD_DIM).transpose(0, 2, 1, 3)
    kh = jnp.pad(k.astype(F32), pad).reshape(Bsz, Lp, D_KV, HEAD_DIM).transpose(0, 2, 1, 3)
    vh = jnp.pad(v.astype(F32), pad).reshape(Bsz, Lp, D_KV, HEAD_DIM).transpose(0, 2, 1, 3)
    kblk = kh.reshape(Bsz, D_KV, nb, MOBA_BLOCK, HEAD_DIM)
    vblk = vh.reshape(Bsz, D_KV, nb, MOBA_BLOCK, HEAD_DIM)
    qblk = qh.reshape(Bsz, D_KV, G, nb, MOBA_BLOCK, HEAD_DIM)
    causal = jnp.tril(jnp.ones((MOBA_BLOCK, MOBA_BLOCK), dtype=bool))
    s_own = jnp.where(causal, jnp.einsum('bhgnqd,bhnkd->bhgnqk', qblk, kblk), NEG)
    m_own = jnp.max(s_own, axis=-1)
    p_own = jnp.exp(s_own - m_own[..., None])
    l_own = jnp.sum(p_own, axis=-1).reshape(Bsz, D_HEADS, Lp)
    acc_own = jnp.einsum('bhgnqk,bhnkd->bhgnqd', p_own, vblk).reshape(Bsz, D_HEADS, Lp, HEAD_DIM)
    m_own = m_own.reshape(Bsz, D_HEADS, Lp)
    k_mean = jnp.mean(kblk, axis=3)
    cur_blk = jnp.arange(Lp) // MOBA_BLOCK
    past = jnp.arange(nb)[None, :] < cur_blk[:, None]
    gate = jnp.einsum('bhgtd,bhnd->bhgtn', qh.reshape(Bsz, D_KV, G, Lp, HEAD_DIM), k_mean)
    gate = jnp.where(past, gate, NEG).reshape(Bsz, D_HEADS, Lp, nb)
    n_sel = min(MOBA_TOPK, nb)
    _, sel = lax.top_k(gate, n_sel)
    sel_valid = sel < cur_blk[None, None, :, None]
    nc = Lp // MOBA_QCHUNK

    def chunks(t):
        return jnp.moveaxis(t.reshape(Bsz, D_HEADS, nc, MOBA_QCHUNK, *t.shape[3:]), 2, 0)

    bi = jnp.arange(Bsz)[:, None, None, None]
    hi = (jnp.arange(D_HEADS) // G)[None, :, None, None]

    def sel_chunk(args):
        qc, ic, vc, mo, lo, ao = args
        kg = kblk[bi, hi, ic]
        vg = vblk[bi, hi, ic]
        s = jnp.where(vc[..., None, None] if vc.ndim == 3 else vc[..., None],
                      jnp.einsum('bhqd,bhqsnd->bhqsn', qc, kg), NEG)
        m = jnp.maximum(mo, jnp.max(s, axis=(-2, -1)))
        p = jnp.exp(s - m[..., None, None])
        corr = jnp.exp(mo - m)
        l = lo * corr + jnp.sum(p, axis=(-2, -1))
        acc = ao * corr[..., None] + jnp.einsum('bhqsn,bhqsnd->bhqd', p, vg)
        return acc / l[..., None]

    out = lax.map(sel_chunk, (chunks(qh), chunks(sel), chunks(sel_valid),
                              chunks(m_own), chunks(l_own), chunks(acc_own)))
    out = jnp.moveaxis(out, 0, 2).reshape(Bsz, D_HEADS, Lp, HEAD_DIM).transpose(0, 2, 1, 3)
    return out.reshape(Bsz, Lp, D_QW)[:, :L].astype(q.dtype)


def hier_moe(x, w_group, b_group, w_expert, b_expert, w_gate_up, w_down):
    Bsz, L, D = x.shape
    xt = x.reshape(Bsz * L, D)
    g_prob = jax.nn.softmax((xt @ w_group).astype(F32) + b_group.astype(F32), axis=-1)
    g_top, g_idx = lax.top_k(g_prob, 1)
    e_logits = ((xt @ w_expert).astype(F32) + b_expert.astype(F32)).reshape(-1, N_GROUPS, EXP_PER_GROUP)
    e_in = jnp.take_along_axis(e_logits, g_idx[:, :, None], axis=1)[:, 0]
    e_top, e_idx = lax.top_k(e_in, EXP_TOPK)
    w_sel = jax.nn.softmax(e_top, axis=-1) * g_top
    eid = g_idx * EXP_PER_GROUP + e_idx
    gates = jnp.einsum('tk,tke->te', w_sel, jax.nn.one_hot(eid, N_EXPERTS, dtype=F32))
    y = jnp.zeros((Bsz * L, D), F32)
    for g in range(N_GROUPS):
        sl = slice(g * EXP_PER_GROUP, (g + 1) * EXP_PER_GROUP)
        hu = jnp.einsum('td,edf->tef', xt, w_gate_up[sl])
        h = jax.nn.silu(hu[..., :EXP_HIDDEN]) * hu[..., EXP_HIDDEN:]
        h = h * gates[:, sl, None].astype(h.dtype)
        y = y + jnp.einsum('tef,efd->td', h, w_down[sl])
    return y.reshape(Bsz, L, D).astype(x.dtype)


def setup_inputs(seed: int = 0) -> dict:
    key = jax.random.key(seed)
    ks = iter(jax.random.split(key, 48))
    nrm = lambda shape, s: jax.random.normal(next(ks), shape, F32) * s
    D = D_MODEL
    NEV = (DEPTH + 1) // 2
    NOD = DEPTH // 2
    sd = D ** -0.5
    x = nrm((BATCH, SEQ, D), 1.0)
    hgrn_lb_logits = nrm((DEPTH + 1, A_KW), 0.1)
    ev_w_in = jnp.concatenate([
        nrm((NEV, D, A_KW), sd),
        nrm((NEV, D, A_KW), sd),
        nrm((NEV, D, A_VW), sd * DN_BETA),
        nrm((NEV, D, A_VW), sd),
        nrm((NEV, D, B_WIDTH), sd * DN_BETA),
    ], axis=-1)
    ev_a_norm = 1.0 + nrm((NEV, A_VW), 0.02)
    ev_s5_a_re = -0.5 * jnp.exp(nrm((NEV, B_GROUPS, B_STATE), 0.02))
    ev_s5_a_im = math.pi * jnp.arange(B_STATE, dtype=F32) + nrm((NEV, B_GROUPS, B_STATE), 0.02)
    ev_s5_log_dt = jax.random.uniform(next(ks), (NEV, B_GROUPS), F32,
                                      minval=math.log(DT_MIN), maxval=math.log(DT_MAX))
    ev_s5_b_re = nrm((NEV, B_GROUPS, B_STATE, B_GROUP), (2.0 * B_GROUP) ** -0.5)
    ev_s5_b_im = nrm((NEV, B_GROUPS, B_STATE, B_GROUP), (2.0 * B_GROUP) ** -0.5)
    ev_s5_c_re = nrm((NEV, B_GROUPS, B_GROUP, B_STATE), (2.0 * B_STATE) ** -0.5)
    ev_s5_c_im = nrm((NEV, B_GROUPS, B_GROUP, B_STATE), (2.0 * B_STATE) ** -0.5)
    ev_s5_d = nrm((NEV, B_WIDTH), 1.0)
    ev_s5_w_glu = nrm((NEV, B_WIDTH, 2 * B_WIDTH), B_WIDTH ** -0.5)
    ev_w_out = nrm((NEV, EV_MIX, D), EV_MIX ** -0.5 * DN_BETA)
    od_w_in = jnp.concatenate([
        nrm((NOD, D, C_QW), sd), nrm((NOD, D, C_KVW), sd), nrm((NOD, D, C_KVW), sd * DN_BETA),
        nrm((NOD, D, D_QW), sd), nrm((NOD, D, D_KVW), sd), nrm((NOD, D, D_KVW), sd * DN_BETA),
    ], axis=-1)
    od_sinks = nrm((NOD, C_HEADS), 1.0)
    od_w_out = nrm((NOD, OD_MIX, D), OD_MIX ** -0.5 * DN_BETA)
    ln1_g = 1.0 + nrm((DEPTH, D), 0.02)
    ln1_b = nrm((DEPTH, D), 0.02)
    moe_w_group = nrm((DEPTH, D, N_GROUPS), sd)
    moe_b_group = nrm((DEPTH, N_GROUPS), 0.01)
    moe_w_expert = nrm((DEPTH, D, N_EXPERTS), sd)
    moe_b_expert = nrm((DEPTH, N_EXPERTS), 0.01)
    moe_w_gate_up = nrm((DEPTH, N_EXPERTS, D, 2 * EXP_HIDDEN), sd * DN_BETA)
    moe_w_down = nrm((DEPTH, N_EXPERTS, EXP_HIDDEN, D), EXP_HIDDEN ** -0.5 * DN_BETA)
    ln2_g = 1.0 + nrm((DEPTH, D), 0.02)
    ln2_b = nrm((DEPTH, D), 0.02)
    return {'x': x, 'hgrn_lb_logits': hgrn_lb_logits, 'ev_w_in': ev_w_in, 'ev_a_norm': ev_a_norm,
            'ev_s5_a_re': ev_s5_a_re, 'ev_s5_a_im': ev_s5_a_im, 'ev_s5_log_dt': ev_s5_log_dt,
            'ev_s5_b_re': ev_s5_b_re, 'ev_s5_b_im': ev_s5_b_im, 'ev_s5_c_re': ev_s5_c_re,
            'ev_s5_c_im': ev_s5_c_im, 'ev_s5_d': ev_s5_d, 'ev_s5_w_glu': ev_s5_w_glu,
            'ev_w_out': ev_w_out, 'od_w_in': od_w_in, 'od_sinks': od_sinks, 'od_w_out': od_w_out,
            'ln1_g': ln1_g, 'ln1_b': ln1_b, 'moe_w_group': moe_w_group, 'moe_b_group': moe_b_group,
            'moe_w_expert': moe_w_expert, 'moe_b_expert': moe_b_expert, 'moe_w_gate_up': moe_w_gate_up,
            'moe_w_down': moe_w_down, 'ln2_g': ln2_g, 'ln2_b': ln2_b}


def reference(x, hgrn_lb_logits, ev_w_in, ev_a_norm, ev_s5_a_re, ev_s5_a_im, ev_s5_log_dt,
              ev_s5_b_re, ev_s5_b_im, ev_s5_c_re, ev_s5_c_im, ev_s5_d, ev_s5_w_glu, ev_w_out,
              od_w_in, od_sinks, od_w_out, ln1_g, ln1_b, moe_w_group, moe_b_group, moe_w_expert,
              moe_b_expert, moe_w_gate_up, moe_w_down, ln2_g, ln2_b):
    lower_bounds = jnp.cumsum(jax.nn.softmax(hgrn_lb_logits.astype(F32), axis=0), axis=0)
    for layer in range(DEPTH):
        j = layer // 2
        if layer % 2 == 0:
            proj = jnp.einsum('bld,df->blf', x, ev_w_in[j])
            q_a, f_a, i_a, g_a, u_b = split_cols(proj, [A_KW, A_KW, A_VW, A_VW, B_WIDTH])
            y_a = hgrn2_mixer(q_a, f_a, i_a, g_a, lower_bounds[layer], ev_a_norm[j])
            y_b = s5_mixer(u_b, ev_s5_a_re[j], ev_s5_a_im[j], ev_s5_log_dt[j], ev_s5_b_re[j],
                           ev_s5_b_im[j], ev_s5_c_re[j], ev_s5_c_im[j], ev_s5_d[j], ev_s5_w_glu[j])
            mix = jnp.einsum('blf,fd->bld', jnp.concatenate([y_a, y_b], axis=-1), ev_w_out[j])
        else:
            proj = jnp.einsum('bld,df->blf', x, od_w_in[j])
            q_c, k_c, v_c, q_d, k_d, v_d = split_cols(proj, [C_QW, C_KVW, C_KVW, D_QW, D_KVW, D_KVW])
            y_c = sliding_window_attention(q_c, k_c, v_c, od_sinks[j])
            y_d = moba_attention(q_d, k_d, v_d)
            mix = jnp.einsum('blf,fd->bld', jnp.concatenate([y_c, y_d], axis=-1), od_w_out[j])
        x = layer_norm(DN_ALPHA * x + mix.astype(x.dtype), ln1_g[layer], ln1_b[layer])
        ffn = hier_moe(x, moe_w_group[layer], moe_b_group[layer], moe_w_expert[layer],
                       moe_b_expert[layer], moe_w_gate_up[layer], moe_w_down[layer])
        x = layer_norm(DN_ALPHA * x + ffn, ln2_g[layer], ln2_b[layer])
    return x
```

```cpp
#ifndef DUPMASK
#define DUPMASK 0
#endif
#ifndef GX
#define GX 0
#endif
#ifndef XSYNC
#define XSYNC 0
#endif
#define GSYNC xcd_barrier(xb)
#include <hip/hip_runtime.h>
#include <hip/hip_cooperative_groups.h>
#include <cstdio>
namespace cg = cooperative_groups;

typedef unsigned short bfu;
typedef __attribute__((ext_vector_type(8))) short bf16x8;
typedef __attribute__((ext_vector_type(4))) float f32x4;
typedef __attribute__((ext_vector_type(2))) float f32x2;

#define DEV __device__ __forceinline__

constexpr int T = 32768, L = 16384;
constexpr float ALPHA = 1.41421356237309515f;
constexpr float NEGF = -1e30f;

constexpr size_t MiB = 1u << 20;
constexpr size_t OFF_WEVIN = 0;
constexpr size_t OFF_WGLU = OFF_WEVIN + 5 * MiB;
constexpr size_t OFF_WEVOUT = OFF_WGLU + 1 * MiB;
constexpr size_t OFF_WODIN = OFF_WEVOUT + 2 * MiB;
constexpr size_t OFF_WODOUT = OFF_WODIN + 3 * MiB;
constexpr size_t OFF_WGU = OFF_WODOUT + 2 * MiB;
constexpr size_t OFF_WDN = OFF_WGU + 32 * MiB;
constexpr size_t OFF_SMALL = OFF_WDN + 16 * MiB;
constexpr size_t OFF_P = OFF_SMALL + 8 * MiB;
constexpr size_t OFF_A = OFF_P + 160 * MiB;
constexpr size_t OFF_X1 = OFF_A + 128 * MiB;
constexpr size_t WS_NEED = OFF_X1 + 128 * MiB;
constexpr size_t S_CNT = OFF_SMALL;
constexpr size_t S_LB = OFF_SMALL + 4096;
constexpr size_t S_ABAR = OFF_SMALL + 8192;
constexpr size_t S_APOW = OFF_SMALL + 24576;
constexpr size_t S_BBAR = OFF_SMALL + 40960;
constexpr size_t S_KMEAN = OFF_SMALL + 303104;
constexpr size_t S_TOKW = OFF_SMALL + 524288;
constexpr size_t S_LIST = OFF_SMALL + 1 * MiB;
constexpr size_t S_BAR = OFF_SMALL + 4 * MiB;
constexpr size_t OFF_BUCK = OFF_P + 96 * MiB;
constexpr size_t OFF_X1B = OFF_P;
constexpr size_t OFF_H = OFF_P + 64 * MiB;
constexpr size_t OFF_X2B = OFF_P + 96 * MiB;
constexpr size_t OFF_XB = OFF_A;
constexpr size_t OFF_DS = OFF_A;
constexpr size_t OFF_SP = OFF_A + 64 * MiB;
constexpr size_t OFF_MIX = OFF_A;
constexpr size_t OFF_PO = OFF_A;
constexpr size_t OFF_YS5 = OFF_X1;
constexpr size_t OFF_Y = OFF_X1 + 32 * MiB;
constexpr size_t OFF_HEND = OFF_X1 + 96 * MiB;
constexpr size_t OFF_CARRY = OFF_X1 + 104 * MiB;
constexpr size_t OFF_DEC = OFF_X1 + 112 * MiB;
constexpr size_t OFF_VT = OFF_X1;
constexpr size_t OFF_PM = OFF_X1 + 96 * MiB;
constexpr size_t OFF_PL = OFF_X1 + 100 * MiB;

constexpr int SMEM_BYTES = 80 * 1024;
constexpr int SM_AUX = 75 * 1024;
constexpr int BUCK_PER_BH = 2016 * 1024;

struct Params {
  const float *x, *lb_logits, *ev_w_in, *ev_a_norm, *a_re, *a_im, *log_dt, *b_re, *b_im, *c_re, *c_im, *s5_d,
      *w_glu, *ev_w_out, *od_w_in, *od_sinks, *od_w_out, *ln1_g, *ln1_b, *w_group, *b_group, *w_expert, *b_expert,
      *w_gate_up, *w_down, *ln2_g, *ln2_b;
  float* out;
  unsigned char* ws;
};

DEV int my_tid() { int t = threadIdx.x; asm volatile("" : "+v"(t)); return t; }
typedef __attribute__((ext_vector_type(2))) __bf16 bf16x2_t;
typedef __attribute__((ext_vector_type(2))) float f32x2c;
DEV bfu f2bf(float f) { __bf16 h = (__bf16)f; return __builtin_bit_cast(bfu, h); }
DEV float bf2f(bfu h) { return __uint_as_float(((unsigned)h) << 16); }
DEV unsigned pack2(float a, float b) { f32x2c v = {a, b}; bf16x2_t r = __builtin_convertvector(v, bf16x2_t); return __builtin_bit_cast(unsigned, r); }
DEV float frcp(float x) { return __builtin_amdgcn_rcpf(x); }
DEV float sigm(float x) { return frcp(1.f + __expf(-x)); }
DEV float siluf(float x) { return x * frcp(1.f + __expf(-x)); }
DEV float gelu_tanh(float x) {
  float u = 1.5957691216057308f * (x + 0.044715f * x * x * x);
  return x * frcp(1.f + __expf(-u));
}
DEV f32x4 mfma16(uint4 a, uint4 b, f32x4 c) {
  return __builtin_amdgcn_mfma_f32_16x16x32_bf16(__builtin_bit_cast(bf16x8, a), __builtin_bit_cast(bf16x8, b), c, 0, 0, 0);
}
DEV uint4 lds128(const bfu* p) { return *(const uint4*)p; }
DEV float wave_sum(float v) {
  v += __shfl_xor(v, 32); v += __shfl_xor(v, 16); v += __shfl_xor(v, 8);
  v += __shfl_xor(v, 4); v += __shfl_xor(v, 2); v += __shfl_xor(v, 1);
  return v;
}
DEV float sum16(float v) {
  v += __shfl_xor(v, 8); v += __shfl_xor(v, 4); v += __shfl_xor(v, 2); v += __shfl_xor(v, 1);
  return v;
}
DEV float max16(float v) {
  v = fmaxf(v, __shfl_xor(v, 8)); v = fmaxf(v, __shfl_xor(v, 4));
  v = fmaxf(v, __shfl_xor(v, 2)); v = fmaxf(v, __shfl_xor(v, 1));
  return v;
}
DEV uint4 ld8_f32(const float* p) {
  float4 u = ((const float4*)p)[0], v = ((const float4*)p)[1];
  return make_uint4(pack2(u.x, u.y), pack2(u.z, u.w), pack2(v.x, v.y), pack2(v.z, v.w));
}
DEV uint4 ld8_bf(const bfu* p) { return *(const uint4*)p; }
DEV int perm_half(int c, int half) {
  if (half == 0) return c;
  int hi = c >= half ? 1 : 0;
  int cc = hi ? c - half : c;
  return (cc >> 5) * 64 + hi * 32 + (cc & 31);
}

template <bool SWAP>
DEV void mma_tile(const bfu* As, const bfu* Bs, int wm, int wn, int l15, int lq, f32x4 (&acc)[4][4]) {
#pragma unroll
  for (int ks = 0; ks < 2; ++ks) {
    uint4 af[4], bfr[4];
#pragma unroll
    for (int i = 0; i < 4; ++i) {
      af[i] = lds128(As + (wm * 64 + i * 16 + l15) * 80 + ks * 32 + lq * 8);
      bfr[i] = lds128(Bs + (wn * 64 + i * 16 + l15) * 80 + ks * 32 + lq * 8);
    }
#pragma unroll
    for (int i1 = 0; i1 < 4; ++i1)
#pragma unroll
      for (int i2 = 0; i2 < 4; ++i2)
        acc[i1][i2] = SWAP ? mfma16(bfr[i1], af[i2], acc[i1][i2]) : mfma16(af[i1], bfr[i2], acc[i1][i2]);
    if (ks == 0) __builtin_amdgcn_sched_barrier(0);
  }
}

template <int N> struct IC { static constexpr int v = N; };
template <int I, int N, typename F> DEV void static_for(F&& f) { if constexpr (I < N) { f(IC<I>{}); static_for<I + 1, N>(f); } }

DEV uint4 ld8_at(const bfu* base, unsigned o) { asm volatile("" : "+v"(o)); return ld8_bf(base + o); }
struct RowLoader {
  const bfu* base; unsigned off; unsigned stride32;
  DEV uint4 operator()(int i, int kb, int so) const { return ld8_at(base, off + (unsigned)i * stride32 + (unsigned)kb + (unsigned)so); }
};
struct GatherLoader {
  const bfu* base; unsigned off[4];
  DEV uint4 operator()(int i, int kb, int so) const { return ld8_at(base, off[i] + (unsigned)kb + (unsigned)so); }
};
struct SplitKLoader {
  const bfu* base; unsigned lo; unsigned dhi;
  DEV uint4 operator()(int i, int kb, int so) const {
    const unsigned u = (kb < 256) ? 0u : dhi;
    return ld8_at(base, lo + u + (unsigned)i * 8192u + (unsigned)(kb & 255) + (unsigned)so);
  }
};
struct GemmPipe { uint4 ra[2][4], rb[2][4]; };

template <typename AL, typename BL, typename EP>
DEV void gemm128(bool SWAP, int K, bool first, bool hasNext, const AL& aload, const BL& bload, const AL& aloadN, const BL& bloadN,
                 EP epi, GemmPipe& gp, unsigned char* smem) {
  const int tid = my_tid(), lane = tid & 63, w = tid >> 6, wm = w >> 1, wn = w & 1, l15 = lane & 15, lq = lane >> 4;
  const int seg = tid & 7, r0 = tid >> 3;
  const int nk = K >> 6;
  f32x4 acc[4][4];
#pragma unroll
  for (int mi = 0; mi < 4; ++mi)
#pragma unroll
    for (int ni = 0; ni < 4; ++ni) acc[mi][ni] = f32x4{0.f, 0.f, 0.f, 0.f};
  if (first) {
#pragma unroll
    for (int i = 0; i < 4; ++i) { gp.ra[0][i] = aload(i, 0, seg * 8); gp.rb[0][i] = bload(i, 0, seg * 8); }
#pragma unroll
    for (int i = 0; i < 4; ++i) { gp.ra[1][i] = aload(i, 64, seg * 8); gp.rb[1][i] = bload(i, 64, seg * 8); }
    __syncthreads();
    bfu* As = (bfu*)smem; bfu* Bs = As + 128 * 80;
#pragma unroll
    for (int i = 0; i < 4; ++i) {
      *(uint4*)(As + (r0 + 32 * i) * 80 + seg * 8) = gp.ra[0][i];
      *(uint4*)(Bs + (r0 + 32 * i) * 80 + seg * 8) = gp.rb[0][i];
    }
#pragma unroll
    for (int i = 0; i < 4; ++i) { gp.ra[0][i] = aload(i, 128, seg * 8); gp.rb[0][i] = bload(i, 128, seg * 8); }
  }
  auto body = [&](auto pc, int kt) {
    constexpr int PAR = decltype(pc)::v;
    constexpr int NXT = PAR ^ 1;
    __syncthreads();
    if (kt + 1 < nk || hasNext) {
      bfu* As = (bfu*)(smem + NXT * 40960); bfu* Bs = As + 128 * 80;
#pragma unroll
      for (int i = 0; i < 4; ++i) {
        *(uint4*)(As + (r0 + 32 * i) * 80 + seg * 8) = gp.ra[NXT][i];
        *(uint4*)(Bs + (r0 + 32 * i) * 80 + seg * 8) = gp.rb[NXT][i];
      }
    }
    if (kt + 3 < nk) {
      const int k = (kt + 3) * 64;
#pragma unroll
      for (int i = 0; i < 4; ++i) { gp.ra[NXT][i] = aload(i, k, seg * 8); gp.rb[NXT][i] = bload(i, k, seg * 8); }
    } else if (hasNext) {
      const int k = (kt + 3 - nk) * 64;
#pragma unroll
      for (int i = 0; i < 4; ++i) { gp.ra[NXT][i] = aloadN(i, k, seg * 8); gp.rb[NXT][i] = bloadN(i, k, seg * 8); }
    } else {
      const int k = (nk - 1) * 64;
#pragma unroll
      for (int i = 0; i < 4; ++i) { gp.ra[NXT][i] = aload(i, k, seg * 8); gp.rb[NXT][i] = bload(i, k, seg * 8); }
    }
    const bfu* Ac = (const bfu*)(smem + PAR * 40960);
    mma_tile<true>(Ac, Ac + 128 * 80, wm, wn, l15, lq, acc);
  };
  for (int kt = 0; kt < nk; kt += 2) {
    body(IC<0>{}, kt);
    body(IC<1>{}, kt + 1);
  }
  epi(acc, wm, wn, l15, lq);
}

DEV bool gemm_item(int iter, int MT, int NT, int& mt, int& nt) {
  const int nl = gridDim.x >> 3;
  const int x = blockIdx.x & 7, lw = blockIdx.x >> 3;
  const int mper = MT >> 3;
  const int li = lw + iter * nl;
  if (li >= mper * NT) return false;
  const int per_group = mper * 4;
  const int g = li / per_group, r = li - g * per_group;
  mt = x * mper + (r >> 2);
  nt = g * 4 + (r & 3);
  return true;
}
DEV int xcd_item(int iter, int total, int inner) {
  const int nl = gridDim.x >> 3;
  const int x = blockIdx.x & 7, lw = blockIdx.x >> 3;
  const int outer = total / inner;
  const int chunk = (outer + 7) >> 3;
  const int o0 = x * chunk;
  int o1 = o0 + chunk; if (o1 > outer) o1 = outer;
  const int li = lw + iter * nl;
  if (o0 >= o1 || li >= (o1 - o0) * inner) return -1;
  return o0 * inner + li;
}

DEV void transpose_job(const float* __restrict__ src, bfu* __restrict__ dst, int nmat, int K, int N, int half, bfu* tl) {
  const int tk = K >> 6, tn = N >> 6;
  const int per = tk * tn, total = nmat * per;
  const int tid = my_tid();
  const int c4 = tid & 15, r = tid >> 4;
  int it = blockIdx.x;
  if (it >= total) return;
  auto tile_src = [&](int itx) -> const float* {
    const int m = itx / per, rem = itx - m * per;
    const int kt = rem / tn, nt = rem - kt * tn;
    return src + (size_t)m * K * N + (size_t)(kt * 64) * N + nt * 64;
  };
  float4 nv[4];
  {
    const float* s = tile_src(it);
#pragma unroll
    for (int i = 0; i < 4; ++i) nv[i] = *(const float4*)(s + (size_t)(r + 16 * i) * N + c4 * 4);
  }
  for (; it < total; it += gridDim.x) {
    const int m = it / per, rem = it - m * per;
    const int kt = rem / tn, nt = rem - kt * tn;
    float4 v[4];
#pragma unroll
    for (int i = 0; i < 4; ++i) v[i] = nv[i];
    {
      const float* s = tile_src(it + gridDim.x < total ? it + gridDim.x : it);
#pragma unroll
      for (int i = 0; i < 4; ++i) nv[i] = *(const float4*)(s + (size_t)(r + 16 * i) * N + c4 * 4);
    }
    __syncthreads();
#pragma unroll
    for (int i = 0; i < 4; ++i) {
      tl[(c4 * 4 + 0) * 72 + r + 16 * i] = f2bf(v[i].x);
      tl[(c4 * 4 + 1) * 72 + r + 16 * i] = f2bf(v[i].y);
      tl[(c4 * 4 + 2) * 72 + r + 16 * i] = f2bf(v[i].z);
      tl[(c4 * 4 + 3) * 72 + r + 16 * i] = f2bf(v[i].w);
    }
    __syncthreads();
    bfu* d = dst + (size_t)m * K * N;
#pragma unroll
    for (int i = 0; i < 2; ++i) {
      const int idx = tid + 256 * i, n = idx >> 3, sg = idx & 7;
      const int pn = perm_half(nt * 64 + n, half);
      *(uint4*)(d + (size_t)pn * K + kt * 64 + sg * 8) = *(const uint4*)(tl + n * 72 + sg * 8);
    }
  }
}

DEV void phase_prep(const Params& p, unsigned char* smem) {
  bfu* tl = (bfu*)smem;
  unsigned char* ws = p.ws;
  const int gtid = blockIdx.x * 256 + my_tid();
  if (gtid < 512) ((int*)(ws + S_CNT))[gtid] = 0;
  if (gtid < 512) {
    float l0 = p.lb_logits[gtid], l1 = p.lb_logits[512 + gtid], l2 = p.lb_logits[1024 + gtid];
    float m = fmaxf(l0, fmaxf(l1, l2));
    float e0 = expf(l0 - m), e1 = expf(l1 - m), e2 = expf(l2 - m);
    ((float*)(ws + S_LB))[gtid] = e0 / (e0 + e1 + e2);
  }
  if (gtid < 2048) {
    int g = gtid >> 6;
    float dt = expf(p.log_dt[g]);
    float ar = p.a_re[gtid], ai = p.a_im[gtid];
    float mag = expf(dt * ar);
    float abr = mag * cosf(dt * ai), abi = mag * sinf(dt * ai);
    float den = ar * ar + ai * ai;
    float xr = abr - 1.f, xi = abi;
    float fr = (xr * ar + xi * ai) / den, fi = (xi * ar - xr * ai) / den;
    float* ab = (float*)(ws + S_ABAR);
    ab[gtid * 2] = abr; ab[gtid * 2 + 1] = abi;
    float pr = abr, pi = abi;
#pragma unroll
    for (int i = 0; i < 6; ++i) { float nr = pr * pr - pi * pi, ni = 2.f * pr * pi; pr = nr; pi = ni; }
    float* ap = (float*)(ws + S_APOW);
    ap[gtid * 2] = pr; ap[gtid * 2 + 1] = pi;
    float* bb = (float*)(ws + S_BBAR) + (size_t)gtid * 32;
    for (int m = 0; m < 16; ++m) {
      float br = p.b_re[gtid * 16 + m], bi = p.b_im[gtid * 16 + m];
      bb[m] = fr * br - fi * bi;
      bb[16 + m] = fr * bi + fi * br;
    }
  }
  transpose_job(p.ev_w_in, (bfu*)(ws + OFF_WEVIN), 1, 1024, 2560, 0, tl);
  transpose_job(p.w_glu, (bfu*)(ws + OFF_WGLU), 1, 512, 1024, 512, tl);
  transpose_job(p.ev_w_out, (bfu*)(ws + OFF_WEVOUT), 1, 1024, 1024, 0, tl);
  transpose_job(p.od_w_in, (bfu*)(ws + OFF_WODIN), 1, 1024, 1536, 0, tl);
  transpose_job(p.od_w_out, (bfu*)(ws + OFF_WODOUT), 1, 1024, 1024, 0, tl);
  transpose_job(p.w_gate_up, (bfu*)(ws + OFF_WGU), 32, 1024, 512, 256, tl);
  transpose_job(p.w_down, (bfu*)(ws + OFF_WDN), 32, 256, 1024, 0, tl);
  {
    uint4* xb = (uint4*)(ws + OFF_XB);
    const size_t n8 = (size_t)T * 1024 / 8;
    for (size_t i = (size_t)blockIdx.x * 256 + my_tid(); i < n8; i += (size_t)gridDim.x * 256) xb[i] = ld8_f32(p.x + i * 8);
  }
}

DEV void phase_proj(const bfu* __restrict__ X, const bfu* __restrict__ Wt, bfu* __restrict__ P, int N, bfu* __restrict__ VT, int layer, unsigned char* smem) {
  const int ntn = N >> 7;
  const int total = (T >> 7) * ntn;
  const int r0 = my_tid() >> 3;
  GemmPipe gp;
  bool first = true;
  for (int it = blockIdx.x; it < total; it += gridDim.x) {
    const int mt = it / ntn, nt = it - mt * ntn;
    const int itn = it + gridDim.x;
    const bool hasNext = itn < total;
    const int itq = hasNext ? itn : it;
    const int mtn = itq / ntn, ntq = itq - mtn * ntn;
    const RowLoader al{X, (unsigned)(mt * 128 + r0) * 1024u, 32768u}, bl{Wt, (unsigned)(nt * 128 + r0) * 1024u, 32768u};
    const RowLoader aln{X, (unsigned)(mtn * 128 + r0) * 1024u, 32768u}, bln{Wt, (unsigned)(ntq * 128 + r0) * 1024u, 32768u};
    auto epi = [&](f32x4(&acc)[4][4], int wm, int wn, int l15, int lq) {
#pragma unroll
      for (int ai = 0; ai < 4; ++ai)
#pragma unroll
        for (int bi = 0; bi < 4; ++bi) {
          const int row = mt * 128 + wm * 64 + bi * 16 + l15, col = nt * 128 + wn * 64 + ai * 16 + lq * 4;
          *(uint2*)(P + (size_t)row * N + col) = make_uint2(pack2(acc[ai][bi][0], acc[ai][bi][1]), pack2(acc[ai][bi][2], acc[ai][bi][3]));
        }
    };
    const bool vt_tile = layer == 0 ? (nt >= 8 && nt <= 11) : (nt == 5 || nt == 11);
    auto epi2 = [&](f32x4(&acc)[4][4], int wm, int wn, int l15, int lq) {
      if (vt_tile) {
        bfu* Ct = (bfu*)(smem + 40960);
        __syncthreads();
#pragma unroll
        for (int ai = 0; ai < 4; ++ai)
#pragma unroll
          for (int bi = 0; bi < 4; ++bi)
#pragma unroll
            for (int j = 0; j < 4; ++j)
              Ct[(wn * 64 + ai * 16 + lq * 4 + j) * 136 + wm * 64 + bi * 16 + l15] = f2bf(acc[ai][bi][j]);
        __syncthreads();
        const int which = nt == 11 ? 1 : 0;
        const int m0 = mt * 128;
        const int b = m0 >> 14, t0 = m0 & (L - 1);
        const int tid = my_tid();
#pragma unroll
        for (int i = 0; i < 8; ++i) {
          const int idx = tid + 256 * i, n = idx >> 4, c = idx & 15;
          const size_t vrow = layer == 0 ? (size_t)((b * 4 + (nt - 8)) * 128 + n) : (size_t)(((which * 2 + b) * 2 + (n >> 6)) * 64 + (n & 63));
          *(uint4*)(VT + vrow * L + t0 + c * 8) = *(const uint4*)(Ct + n * 136 + c * 8);
        }
      } else {
        epi(acc, wm, wn, l15, lq);
      }
    };
    gemm128(true, 1024, first, hasNext, al, bl, aln, bln, epi2, gp, smem);
    first = false;
  }
}

DEV void phase_glu(const Params& p, unsigned char* smem) {
  const bfu* A = (const bfu*)(p.ws + OFF_YS5);
  const bfu* Wt = (const bfu*)(p.ws + OFF_WGLU);
  bfu* Y = (bfu*)(p.ws + OFF_Y);
  const int r0 = my_tid() >> 3;
  const int total = (T >> 7) * 8;
  GemmPipe gp;
  bool first = true;
  for (int it = blockIdx.x; it < total; it += gridDim.x) {
    const int mt = it >> 3, nt = it & 7;
    const int itn = it + gridDim.x;
    const bool hasNext = itn < total;
    const int itq = hasNext ? itn : it;
    const RowLoader al{A, (unsigned)(mt * 128 + r0) * 512u, 16384u}, bl{Wt, (unsigned)(nt * 128 + r0) * 512u, 16384u};
    const RowLoader aln{A, (unsigned)((itq >> 3) * 128 + r0) * 512u, 16384u}, bln{Wt, (unsigned)((itq & 7) * 128 + r0) * 512u, 16384u};
    auto epi = [&](f32x4(&acc)[4][4], int wm, int wn, int l15, int lq) {
      const int q = nt * 2 + wn;
#pragma unroll
      for (int ai = 0; ai < 2; ++ai)
#pragma unroll
        for (int bi = 0; bi < 4; ++bi) {
          const int row = mt * 128 + wm * 64 + bi * 16 + l15, col = q * 32 + ai * 16 + lq * 4;
          float o[4];
#pragma unroll
          for (int j = 0; j < 4; ++j) o[j] = acc[ai][bi][j] * sigm(acc[ai + 2][bi][j]);
          *(uint2*)(Y + (size_t)row * 1024 + 512 + col) = make_uint2(pack2(o[0], o[1]), pack2(o[2], o[3]));
        }
    };
    gemm128(true, 512, first, hasNext, al, bl, aln, bln, epi, gp, smem);
    first = false;
  }
}

DEV void phase_outproj(const Params& p, const bfu* __restrict__ Wt, unsigned char* smem) {
  const bfu* A = (const bfu*)(p.ws + OFF_Y);
  bfu* MIX = (bfu*)(p.ws + OFF_MIX);
  const int r0 = my_tid() >> 3;
  const int total = (T >> 7) * 8;
  GemmPipe gp;
  bool first = true;
  for (int it = blockIdx.x; it < total; it += gridDim.x) {
    const int mt = it >> 3, nt = it & 7;
    const int itn = it + gridDim.x;
    const bool hasNext = itn < total;
    const int itq = hasNext ? itn : it;
    const RowLoader al{A, (unsigned)(mt * 128 + r0) * 1024u, 32768u}, bl{Wt, (unsigned)(nt * 128 + r0) * 1024u, 32768u};
    const RowLoader aln{A, (unsigned)((itq >> 3) * 128 + r0) * 1024u, 32768u}, bln{Wt, (unsigned)((itq & 7) * 128 + r0) * 1024u, 32768u};
    auto epi = [&](f32x4(&acc)[4][4], int wm, int wn, int l15, int lq) {
#pragma unroll
      for (int ai = 0; ai < 4; ++ai)
#pragma unroll
        for (int bi = 0; bi < 4; ++bi) {
          const int row = mt * 128 + wm * 64 + bi * 16 + l15, col = nt * 128 + wn * 64 + ai * 16 + lq * 4;
          *(uint2*)(MIX + (size_t)row * 1024 + col) = make_uint2(pack2(acc[ai][bi][0], acc[ai][bi][1]), pack2(acc[ai][bi][2], acc[ai][bi][3]));
        }
    };
    gemm128(true, 1024, first, hasNext, al, bl, aln, bln, epi, gp, smem);
    first = false;
  }
}


DEV void stage_tile64x128(const bfu* __restrict__ src, int ld, bfu* dst, int ls) {
#pragma unroll
  for (int i = 0; i < 4; ++i) {
    const int idx = my_tid() + 256 * i, row = idx >> 4, sg = idx & 15;
    *(uint4*)(dst + row * ls + sg * 8) = *(const uint4*)(src + (size_t)row * ld + sg * 8);
  }
}
DEV void stage_tile64x128_T(const bfu* __restrict__ src, int ld, bfu* dst, int ls) {
#pragma unroll
  for (int i = 0; i < 4; ++i) {
    const int idx = my_tid() + 256 * i, row = idx >> 4, sg = idx & 15;
    uint4 v = *(const uint4*)(src + (size_t)row * ld + sg * 8);
    unsigned uu[4] = {v.x, v.y, v.z, v.w};
#pragma unroll
    for (int e = 0; e < 4; ++e) {
      dst[(sg * 8 + 2 * e) * ls + row] = (bfu)(uu[e] & 0xffffu);
      dst[(sg * 8 + 2 * e + 1) * ls + row] = (bfu)(uu[e] >> 16);
    }
  }
}


DEV void stage_vt(const bfu* __restrict__ vt0, int bh, int tl0, bfu* dst, int ls) {
#pragma unroll
  for (int i = 0; i < 4; ++i) {
    const int idx = my_tid() + 256 * i, v = idx >> 3, c = idx & 7;
    *(uint4*)(dst + v * ls + c * 8) = *(const uint4*)(vt0 + ((size_t)(bh * 128 + v)) * L + tl0 + c * 8);
  }
}

DEV void hgrn_dstate_item(const Params& p, int ch, unsigned char* smem) {
  const int bh = ch >> 8, n = ch & 255, b = bh >> 2, h = bh & 3;
  const size_t t0 = (size_t)b * L + (size_t)n * 64;
  const bfu* P = (const bfu*)(p.ws + OFF_P);
  bfu* As = (bfu*)smem;
  bfu* Bs = As + 128 * 80;
  bfu* Fr = Bs + 128 * 80;
  const int tid = my_tid(), k = tid & 127, half = tid >> 7;
  const float lb = ((const float*)(p.ws + S_LB))[h * 128 + k];
  __syncthreads();
  stage_tile64x128(P + t0 * 2560 + 512 + h * 128, 2560, Fr, 128);
  stage_vt((const bfu*)p.out, bh, n * 64, As, 80);
  __syncthreads();
  float* tot = (float*)(Fr + 64 * 128);
  float fv[32], cum[32];
  float run = 0.f;
#pragma unroll
  for (int i = 0; i < 32; ++i) {
    const float f = lb + (1.f - lb) * sigm(bf2f(Fr[(half * 32 + i) * 128 + k]));
    run += __logf(f);
    fv[i] = f; cum[i] = run;
  }
  tot[half * 128 + k] = run;
  __syncthreads();
  const float t0s = tot[k], t1s = tot[128 + k];
  const float btot = t0s + t1s;
  const float boff = half ? t0s : 0.f;
#pragma unroll
  for (int i = 0; i < 32; ++i) Bs[k * 80 + half * 32 + i] = f2bf((1.f - fv[i]) * __expf(btot - (boff + cum[i])));
  if (half == 0) ((float*)(p.ws + OFF_DEC))[(size_t)ch * 128 + k] = __expf(btot);
  __syncthreads();
  const int lane = tid & 63, w = tid >> 6, wm = w >> 1, wn = w & 1, l15 = lane & 15, lq = lane >> 4;
  f32x4 acc[4][4];
#pragma unroll
  for (int mi = 0; mi < 4; ++mi)
#pragma unroll
    for (int ni = 0; ni < 4; ++ni) acc[mi][ni] = f32x4{0.f, 0.f, 0.f, 0.f};
  mma_tile<true>(As, Bs, wm, wn, l15, lq, acc);
  bfu* DS = (bfu*)(p.ws + OFF_DS) + (size_t)ch * 16384;
#pragma unroll
  for (int ai = 0; ai < 4; ++ai)
#pragma unroll
    for (int bi = 0; bi < 4; ++bi) {
      const int v = wm * 64 + bi * 16 + l15, kk = wn * 64 + ai * 16 + lq * 4;
      *(uint2*)(DS + v * 128 + kk) = make_uint2(pack2(acc[ai][bi][0], acc[ai][bi][1]), pack2(acc[ai][bi][2], acc[ai][bi][3]));
    }
}

DEV void s5_load_bfrag(const Params& p, int g, int l15, int lq, uint4 (&bf)[8]) {
#pragma unroll
  for (int ni = 0; ni < 8; ++ni) {
    bf[ni] = make_uint4(0u, 0u, 0u, 0u);
    if (lq < 2) {
      const int col = ni * 16 + l15, pp = col & 63, part = col >> 6;
      const float* s = (const float*)(p.ws + S_BBAR) + (size_t)(g * 64 + pp) * 32 + part * 16 + lq * 8;
      const float4 u = ((const float4*)s)[0], v = ((const float4*)s)[1];
      bf[ni] = make_uint4(pack2(u.x, u.y), pack2(u.z, u.w), pack2(v.x, v.y), pack2(v.z, v.w));
    }
  }
}
DEV void s5_drive16(const uint4 a, const uint4 (&bf)[8], float* Dr, int l15, int lq) {
#pragma unroll
  for (int ni = 0; ni < 8; ++ni) {
    f32x4 acc = mfma16(a, bf[ni], f32x4{0.f, 0.f, 0.f, 0.f});
#pragma unroll
    for (int j = 0; j < 4; ++j) Dr[(lq * 4 + j) * 132 + ni * 16 + l15] = acc[j];
  }
}

struct S5Const { uint4 bf[8]; uint4 cf[4]; float2 ab; float dsk; };

DEV void s5_pass1_item(const Params& p, int it, const uint4 (&bf)[8], const float2 ab, unsigned char* smem) {
  const int gq = it & 7, bc = it >> 3;
  const size_t t0 = (size_t)(bc >> 8) * L + (size_t)(bc & 255) * 64;
  const int tid = my_tid(), lane = tid & 63, w = tid >> 6, l15 = lane & 15, lq = lane >> 4;
  float* Dr = (float*)smem + w * (16 * 132);
  const int g = gq * 4 + w;
  const int gp = g * 64 + lane;
  const bfu* P = (const bfu*)(p.ws + OFF_P);
  uint4 af[4];
#pragma unroll
  for (int sub = 0; sub < 4; ++sub) {
    af[sub] = make_uint4(0u, 0u, 0u, 0u);
    if (lq < 2) af[sub] = *(const uint4*)(P + (t0 + sub * 16 + l15) * 2560 + 2048 + g * 16 + lq * 8);
  }
  float hr = 0.f, hi = 0.f;
#pragma unroll
  for (int sub = 0; sub < 4; ++sub) {
    __syncthreads();
    s5_drive16(af[sub], bf, Dr, l15, lq);
    __syncthreads();
#pragma unroll 4
    for (int tt = 0; tt < 16; ++tt) {
      const float dr = Dr[tt * 132 + lane], di = Dr[tt * 132 + 64 + lane];
      const float nr = ab.x * hr - ab.y * hi + dr;
      const float ni = ab.x * hi + ab.y * hr + di;
      hr = nr; hi = ni;
    }
  }
  ((float2*)(p.ws + OFF_HEND))[(size_t)bc * 2048 + gp] = make_float2(hr, hi);
}

DEV void s5_pass2_item(const Params& p, int it, const uint4 (&bf)[8], const uint4 (&cf)[4], const float2 ab, const float dsk, unsigned char* smem) {
  const int gq = it & 7, bc = it >> 3;
  const size_t t0 = (size_t)(bc >> 8) * L + (size_t)(bc & 255) * 64;
  const int tid = my_tid(), lane = tid & 63, w = tid >> 6, l15 = lane & 15, lq = lane >> 4;
  float* Dr = (float*)smem + w * (16 * 132);
  bfu* Hs = (bfu*)(smem + 4 * 16 * 132 * 4) + w * (16 * 144);
  const int g = gq * 4 + w;
  const int gp = g * 64 + lane;
  const bfu* P = (const bfu*)(p.ws + OFF_P);
  uint4 af[4];
#pragma unroll
  for (int sub = 0; sub < 4; ++sub) {
    af[sub] = make_uint4(0u, 0u, 0u, 0u);
    if (lq < 2) af[sub] = *(const uint4*)(P + (t0 + sub * 16 + l15) * 2560 + 2048 + g * 16 + lq * 8);
  }
  float2 hc = ((const float2*)(p.ws + OFF_CARRY))[(size_t)bc * 2048 + gp];
  float hr = hc.x, hi = hc.y;
  bfu* YS = (bfu*)(p.ws + OFF_YS5);
#pragma unroll
  for (int sub = 0; sub < 4; ++sub) {
    float us[4];
#pragma unroll
    for (int j = 0; j < 4; ++j) us[j] = bf2f(P[(t0 + sub * 16 + lq * 4 + j) * 2560 + 2048 + g * 16 + l15]);
    __syncthreads();
    s5_drive16(af[sub], bf, Dr, l15, lq);
    __syncthreads();
#pragma unroll 4
    for (int tt = 0; tt < 16; ++tt) {
      const float dr = Dr[tt * 132 + lane], di = Dr[tt * 132 + 64 + lane];
      const float nr = ab.x * hr - ab.y * hi + dr;
      const float ni = ab.x * hi + ab.y * hr + di;
      hr = nr; hi = ni;
      Hs[tt * 144 + lane] = f2bf(hr);
      Hs[tt * 144 + 64 + lane] = f2bf(hi);
    }
    __syncthreads();
    f32x4 acc = f32x4{0.f, 0.f, 0.f, 0.f};
#pragma unroll
    for (int ks = 0; ks < 4; ++ks) acc = mfma16(lds128(Hs + l15 * 144 + ks * 32 + lq * 8), cf[ks], acc);
#pragma unroll
    for (int j = 0; j < 4; ++j) {
      const int t = sub * 16 + lq * 4 + j;
      const float y = acc[j] + dsk * us[j];
      YS[(t0 + t) * 512 + g * 16 + l15] = f2bf(gelu_tanh(y));
    }
  }
}


DEV void s5_load_consts(const Params& p, int g, int lane, uint4 (&bf)[8], uint4 (&cf)[4], float2& ab, float& dsk) {
  const int l15 = lane & 15, lq = lane >> 4;
  s5_load_bfrag(p, g, l15, lq, bf);
  ab = ((const float2*)(p.ws + S_ABAR))[g * 64 + lane];
#pragma unroll
  for (int ks = 0; ks < 4; ++ks) {
    const float* src = (ks < 2 ? p.c_re : p.c_im) + ((size_t)g * 16 + l15) * 64 + (ks & 1) * 32 + lq * 8;
    float4 u = ((const float4*)src)[0], v = ((const float4*)src)[1];
    float sgn = ks < 2 ? 1.f : -1.f;
    cf[ks] = make_uint4(pack2(sgn * u.x, sgn * u.y), pack2(sgn * u.z, sgn * u.w), pack2(sgn * v.x, sgn * v.y), pack2(sgn * v.z, sgn * v.w));
  }
  dsk = p.s5_d[g * 16 + l15];
}

DEV void hgrn_scan_item(const Params& p, int it) {
  const int bh = it >> 3, vs = it & 7;
  const int tid = my_tid(), v = vs * 16 + (tid >> 4), k8 = tid & 15;
  const bfu* DS = (const bfu*)(p.ws + OFF_DS);
  bfu* SP = (bfu*)(p.ws + OFF_SP);
  const float* DEC = (const float*)(p.ws + OFF_DEC);
  float S[8];
#pragma unroll
  for (int i = 0; i < 8; ++i) S[i] = 0.f;
  uint4 dsr[8];
  float4 dca[8], dcb[8];
  const size_t base0 = ((size_t)(bh * 256) * 128 + v) * 128 + k8 * 8;
  const size_t dbase0 = (size_t)(bh * 256) * 128 + k8 * 8;
#pragma unroll
  for (int s = 0; s < 8; ++s) {
    dsr[s] = *(const uint4*)(DS + base0 + (size_t)s * 16384);
    dca[s] = *(const float4*)(DEC + dbase0 + (size_t)s * 128);
    dcb[s] = *(const float4*)(DEC + dbase0 + (size_t)s * 128 + 4);
  }
  for (int n0 = 0; n0 < 256; n0 += 8) {
#pragma unroll
    for (int s = 0; s < 8; ++s) {
      const int n = n0 + s;
      *(uint4*)(SP + base0 + (size_t)n * 16384) = make_uint4(pack2(S[0], S[1]), pack2(S[2], S[3]), pack2(S[4], S[5]), pack2(S[6], S[7]));
      const uint4 d = dsr[s];
      const float4 a = dca[s], c = dcb[s];
      S[0] = a.x * S[0] + __uint_as_float(d.x << 16); S[1] = a.y * S[1] + __uint_as_float(d.x & 0xffff0000u);
      S[2] = a.z * S[2] + __uint_as_float(d.y << 16); S[3] = a.w * S[3] + __uint_as_float(d.y & 0xffff0000u);
      S[4] = c.x * S[4] + __uint_as_float(d.z << 16); S[5] = c.y * S[5] + __uint_as_float(d.z & 0xffff0000u);
      S[6] = c.z * S[6] + __uint_as_float(d.w << 16); S[7] = c.w * S[7] + __uint_as_float(d.w & 0xffff0000u);
      if (n + 8 < 256) {
        dsr[s] = *(const uint4*)(DS + base0 + (size_t)(n + 8) * 16384);
        dca[s] = *(const float4*)(DEC + dbase0 + (size_t)(n + 8) * 128);
        dcb[s] = *(const float4*)(DEC + dbase0 + (size_t)(n + 8) * 128 + 4);
      }
    }
  }
}

DEV void s5_carry_item(const Params& p, int it) {
  const int id = it * 256 + my_tid();
  const int b = id >> 11, gp = id & 2047;
  const float2 ap = ((const float2*)(p.ws + S_APOW))[gp];
  const float2* HE = (const float2*)(p.ws + OFF_HEND) + (size_t)b * 256 * 2048 + gp;
  float2* CA = (float2*)(p.ws + OFF_CARRY) + (size_t)b * 256 * 2048 + gp;
  float cr = 0.f, ci = 0.f;
  float2 ring[8];
#pragma unroll
  for (int s = 0; s < 8; ++s) ring[s] = HE[(size_t)s * 2048];
  for (int c0 = 0; c0 < 256; c0 += 8) {
#pragma unroll
    for (int s = 0; s < 8; ++s) {
      const int c = c0 + s;
      CA[(size_t)c * 2048] = make_float2(cr, ci);
      float nr = ap.x * cr - ap.y * ci + ring[s].x;
      float ni = ap.x * ci + ap.y * cr + ring[s].y;
      cr = nr; ci = ni;
      if (c + 8 < 256) ring[s] = HE[(size_t)(c + 8) * 2048];
    }
  }
}

DEV void hgrn_out_item(const Params& p, int ch, unsigned char* smem) {
  const int bh = ch >> 8, n = ch & 255, b = bh >> 2, h = bh & 3;
  const size_t t0 = (size_t)b * L + (size_t)n * 64;
  const bfu* P = (const bfu*)(p.ws + OFF_P);
  bfu* Qs = (bfu*)smem;
  bfu* RB = Qs + 64 * 144;
  bfu* Ks = RB;
  bfu* ATT = RB;
  bfu* Vt = RB + 64 * 80;
  bfu* St = RB;
  bfu* Fr = RB + 64 * 144;
  float* tot = (float*)(Fr + 64 * 128);
  bfu* Gs = (bfu*)(smem + 55296);
  const int tid = my_tid(), lane = tid & 63, w = tid >> 6, l15 = lane & 15, lq = lane >> 4;
  uint4 rq0, rq1, rq2, rq3, rf0, rf1, rf2, rf3, rv0, rv1, rv2, rv3, rg0, rg1, rg2, rg3, rs0, rs1, rs2, rs3, rs4, rs5, rs6, rs7;
  {
    const bfu* qsrc = P + t0 * 2560 + h * 128;
    const bfu* vt0 = (const bfu*)p.out;
    const bfu* SPc = (const bfu*)(p.ws + OFF_SP) + (size_t)ch * 16384;
#define HG_LD(i) { const int idx = tid + 256 * i, row = idx >> 4, sg = idx & 15; \
      rq##i = *(const uint4*)(qsrc + (size_t)row * 2560 + sg * 8); \
      rf##i = *(const uint4*)(qsrc + 512 + (size_t)row * 2560 + sg * 8); \
      rg##i = *(const uint4*)(qsrc + 1536 + (size_t)row * 2560 + sg * 8); \
      const int v = idx >> 3, c = idx & 7; \
      rv##i = *(const uint4*)(vt0 + ((size_t)(bh * 128 + v)) * L + n * 64 + c * 8); }
    HG_LD(0) HG_LD(1) HG_LD(2) HG_LD(3)
#undef HG_LD
#define HG_LS(i) { const int idx = tid + 256 * i, v = idx >> 4, sg = idx & 15; rs##i = *(const uint4*)(SPc + v * 128 + sg * 8); }
    HG_LS(0) HG_LS(1) HG_LS(2) HG_LS(3) HG_LS(4) HG_LS(5) HG_LS(6) HG_LS(7)
#undef HG_LS
  }
  float ng[8];
#pragma unroll
  for (int ni = 0; ni < 8; ++ni) ng[ni] = p.ev_a_norm[h * 128 + ni * 16 + l15];
  __syncthreads();
#define HG_ST(i) { const int idx = tid + 256 * i, row = idx >> 4, sg = idx & 15; \
    *(uint4*)(Qs + row * 144 + sg * 8) = rq##i; *(uint4*)(Fr + row * 128 + sg * 8) = rf##i; *(uint4*)(Gs + row * 144 + sg * 8) = rg##i; }
  HG_ST(0) HG_ST(1) HG_ST(2) HG_ST(3)
#undef HG_ST
  __syncthreads();
  {
    const int k = tid & 127, half = tid >> 7;
    const float lb = ((const float*)(p.ws + S_LB))[h * 128 + k];
    float fv[32], cum[32];
    float run = 0.f;
#pragma unroll
    for (int i = 0; i < 32; ++i) {
      const float f = lb + (1.f - lb) * sigm(bf2f(Fr[(half * 32 + i) * 128 + k]));
      run += __logf(f);
      fv[i] = f; cum[i] = run;
    }
    tot[half * 128 + k] = run;
    __syncthreads();
    const float boff = half ? tot[k] : 0.f;
#pragma unroll
    for (int i = 0; i < 32; ++i) {
      const int s = half * 32 + i;
      const float eb = __expf(boff + cum[i]);
      const float q = siluf(bf2f(Qs[s * 144 + k]));
      Qs[s * 144 + k] = f2bf(q * eb);
      Ks[s * 144 + k] = f2bf((1.f - fv[i]) * frcp(eb));
    }
  }
  __syncthreads();
  f32x4 at[4];
#pragma unroll
  for (int ni = 0; ni < 4; ++ni) at[ni] = f32x4{0.f, 0.f, 0.f, 0.f};
#pragma unroll
  for (int ks = 0; ks < 4; ++ks) {
    uint4 a = lds128(Qs + (16 * w + l15) * 144 + ks * 32 + lq * 8);
#pragma unroll
    for (int ni = 0; ni < 4; ++ni) at[ni] = mfma16(a, lds128(Ks + (ni * 16 + l15) * 144 + ks * 32 + lq * 8), at[ni]);
  }
  __syncthreads();
#pragma unroll
  for (int ni = 0; ni < 4; ++ni)
#pragma unroll
    for (int j = 0; j < 4; ++j) {
      int c = 16 * w + lq * 4 + j, s = ni * 16 + l15;
      ATT[c * 80 + s] = f2bf(s <= c ? at[ni][j] : 0.f);
    }
#define HG_SV(i) { const int idx = tid + 256 * i, v = idx >> 3, c = idx & 7; *(uint4*)(Vt + v * 80 + c * 8) = rv##i; }
  HG_SV(0) HG_SV(1) HG_SV(2) HG_SV(3)
#undef HG_SV
  __syncthreads();
  f32x4 o[8];
#pragma unroll
  for (int ni = 0; ni < 8; ++ni) o[ni] = f32x4{0.f, 0.f, 0.f, 0.f};
#pragma unroll
  for (int ks = 0; ks < 2; ++ks) {
    uint4 a = lds128(ATT + (16 * w + l15) * 80 + ks * 32 + lq * 8);
#pragma unroll
    for (int ni = 0; ni < 8; ++ni) o[ni] = mfma16(a, lds128(Vt + (ni * 16 + l15) * 80 + ks * 32 + lq * 8), o[ni]);
  }
  __syncthreads();
#define HG_SS(i) { const int idx = tid + 256 * i, v = idx >> 4, sg = idx & 15; *(uint4*)(St + v * 144 + sg * 8) = rs##i; }
  HG_SS(0) HG_SS(1) HG_SS(2) HG_SS(3) HG_SS(4) HG_SS(5) HG_SS(6) HG_SS(7)
#undef HG_SS
  __syncthreads();
#pragma unroll
  for (int ks = 0; ks < 4; ++ks) {
    uint4 a = lds128(Qs + (16 * w + l15) * 144 + ks * 32 + lq * 8);
#pragma unroll
    for (int ni = 0; ni < 8; ++ni) o[ni] = mfma16(a, lds128(St + (ni * 16 + l15) * 144 + ks * 32 + lq * 8), o[ni]);
  }
#pragma unroll
  for (int j = 0; j < 4; ++j) {
    float ss = 0.f;
#pragma unroll
    for (int ni = 0; ni < 8; ++ni) ss += o[ni][j] * o[ni][j];
    ss = sum16(ss);
    const float rsn = rsqrtf(ss * (1.f / 128.f) + 1e-6f);
    const int c = 16 * w + lq * 4 + j;
#pragma unroll
    for (int ni = 0; ni < 8; ++ni) {
      const int v = ni * 16 + l15;
      const float gate = bf2f(Gs[c * 144 + v]);
      Gs[c * 144 + v] = f2bf(o[ni][j] * rsn * ng[ni] * siluf(gate));
    }
  }
  __syncthreads();
  bfu* Y = (bfu*)(p.ws + OFF_Y);
#pragma unroll
  for (int i = 0; i < 4; ++i) {
    const int idx = tid + 256 * i, row = idx >> 4, sg = idx & 15;
    *(uint4*)(Y + (t0 + row) * 1024 + h * 128 + sg * 8) = *(const uint4*)(Gs + row * 144 + sg * 8);
  }
}

DEV void phase_ln1_router(const Params& p, const float* __restrict__ Xin, int layer, unsigned char* smem) {
  const bfu* MIX = (const bfu*)(p.ws + OFF_MIX);
  float* X1 = (float*)(p.ws + OFF_X1);
  bfu* X1b = (bfu*)(p.ws + OFF_X1B);
  const float* g1 = p.ln1_g + layer * 1024;
  const float* b1 = p.ln1_b + layer * 1024;
  const float* wg = p.w_group + (size_t)layer * 1024 * 4;
  const float* we = p.w_expert + (size_t)layer * 1024 * 16;
  const float* bg = p.b_group + layer * 4;
  const float* be = p.b_expert + layer * 16;
  float* tokw = (float*)(p.ws + S_TOKW);
  int* list = (int*)(p.ws + S_LIST);
  int* gcnt = (int*)(p.ws + S_CNT) + layer * 32;
  float* Wes = (float*)smem;
  int* tokb = (int*)(smem + 65536);
  int* lcnt = tokb + 64;
  int* lbase = lcnt + 32;
  int* lpos = lbase + 32;
  const int tid = my_tid(), lane = tid & 63, w = tid >> 6;
  __syncthreads();
  {
    float4 wv[16];
#pragma unroll
    for (int i = 0; i < 16; ++i) wv[i] = *(const float4*)(we + (size_t)(tid + 256 * i) * 4);
#pragma unroll
    for (int i = 0; i < 16; ++i) {
      const int idx = tid + 256 * i, d = idx >> 2, c4 = idx & 3;
      Wes[(c4 * 4 + 0) * 1024 + d] = wv[i].x; Wes[(c4 * 4 + 1) * 1024 + d] = wv[i].y;
      Wes[(c4 * 4 + 2) * 1024 + d] = wv[i].z; Wes[(c4 * 4 + 3) * 1024 + d] = wv[i].w;
    }
  }
  __syncthreads();
  for (int it = blockIdx.x; it < T / 64; it += gridDim.x) {
    const int tb = it * 64;
    __syncthreads();
    if (tid < 24) lcnt[tid] = 0;
    float4 nxa[4]; uint2 nxm[4];
    {
      const size_t tn = (size_t)tb + w * 16;
#pragma unroll
      for (int i = 0; i < 4; ++i) {
        nxa[i] = *(const float4*)(Xin + tn * 1024 + i * 256 + lane * 4);
        nxm[i] = *(const uint2*)(MIX + tn * 1024 + i * 256 + lane * 4);
      }
    }
    for (int tk = 0; tk < 16; ++tk) {
      const size_t t = (size_t)tb + w * 16 + tk;
      float4 cxa[4]; uint2 cxm[4];
#pragma unroll
      for (int i = 0; i < 4; ++i) { cxa[i] = nxa[i]; cxm[i] = nxm[i]; }
      {
        const size_t tn = (size_t)tb + w * 16 + (tk < 15 ? tk + 1 : 15);
#pragma unroll
        for (int i = 0; i < 4; ++i) {
          nxa[i] = *(const float4*)(Xin + tn * 1024 + i * 256 + lane * 4);
          nxm[i] = *(const uint2*)(MIX + tn * 1024 + i * 256 + lane * 4);
        }
      }
      float xv[16];
      float s = 0.f;
#pragma unroll
      for (int i = 0; i < 4; ++i) {
        const float4 a = cxa[i];
        const float4 m = make_float4(__uint_as_float(cxm[i].x << 16), __uint_as_float(cxm[i].x & 0xffff0000u), __uint_as_float(cxm[i].y << 16), __uint_as_float(cxm[i].y & 0xffff0000u));
        xv[4 * i] = ALPHA * a.x + m.x; xv[4 * i + 1] = ALPHA * a.y + m.y;
        xv[4 * i + 2] = ALPHA * a.z + m.z; xv[4 * i + 3] = ALPHA * a.w + m.w;
        s += xv[4 * i] + xv[4 * i + 1] + xv[4 * i + 2] + xv[4 * i + 3];
      }
      const float mu = wave_sum(s) * (1.f / 1024.f);
      float vs = 0.f;
#pragma unroll
      for (int e = 0; e < 16; ++e) { float d = xv[e] - mu; vs += d * d; }
      const float rstd = rsqrtf(wave_sum(vs) * (1.f / 1024.f) + 1e-5f);
      float acc[20];
#pragma unroll
      for (int c = 0; c < 20; ++c) acc[c] = 0.f;
#pragma unroll
      for (int i = 0; i < 4; ++i) {
        float4 gg = *(const float4*)(g1 + i * 256 + lane * 4);
        float4 bb = *(const float4*)(b1 + i * 256 + lane * 4);
        const float o0 = (xv[4 * i] - mu) * rstd * gg.x + bb.x;
        const float o1 = (xv[4 * i + 1] - mu) * rstd * gg.y + bb.y;
        const float o2 = (xv[4 * i + 2] - mu) * rstd * gg.z + bb.z;
        const float o3 = (xv[4 * i + 3] - mu) * rstd * gg.w + bb.w;
        *(uint2*)(X1b + t * 1024 + i * 256 + lane * 4) = make_uint2(pack2(o0, o1), pack2(o2, o3));
#pragma unroll
        for (int c = 0; c < 16; ++c) {
          float4 wv = *(const float4*)(Wes + c * 1024 + i * 256 + lane * 4);
          acc[4 + c] += o0 * wv.x + o1 * wv.y + o2 * wv.z + o3 * wv.w;
        }
        const float* wgp = wg + (size_t)(i * 256 + lane * 4) * 4;
        float4 q0 = *(const float4*)(wgp), q1 = *(const float4*)(wgp + 4), q2 = *(const float4*)(wgp + 8), q3 = *(const float4*)(wgp + 12);
        acc[0] += o0 * q0.x + o1 * q1.x + o2 * q2.x + o3 * q3.x;
        acc[1] += o0 * q0.y + o1 * q1.y + o2 * q2.y + o3 * q3.y;
        acc[2] += o0 * q0.z + o1 * q1.z + o2 * q2.z + o3 * q3.z;
        acc[3] += o0 * q0.w + o1 * q1.w + o2 * q2.w + o3 * q3.w;
      }
#pragma unroll
      for (int c = 0; c < 20; ++c) acc[c] = wave_sum(acc[c]);
      float lg[4];
#pragma unroll
      for (int c = 0; c < 4; ++c) lg[c] = acc[c] + bg[c];
      int gi = 0; float gm = lg[0];
#pragma unroll
      for (int c = 1; c < 4; ++c) if (lg[c] > gm) { gm = lg[c]; gi = c; }
      float gs = 0.f;
#pragma unroll
      for (int c = 0; c < 4; ++c) gs += __expf(lg[c] - gm);
      const float gtop = 1.f / gs;
      float ev[4] = {0.f, 0.f, 0.f, 0.f};
#pragma unroll
      for (int gg = 0; gg < 4; ++gg)
#pragma unroll
        for (int c = 0; c < 4; ++c) if (gi == gg) ev[c] = acc[4 + gg * 4 + c] + be[gg * 4 + c];
      int i1 = 0; float v1 = ev[0];
#pragma unroll
      for (int c = 1; c < 4; ++c) if (ev[c] > v1) { v1 = ev[c]; i1 = c; }
      int i2 = -1; float v2 = -3e38f;
#pragma unroll
      for (int c = 0; c < 4; ++c) if (c != i1 && ev[c] > v2) { v2 = ev[c]; i2 = c; }
      const float ex = __expf(v2 - v1);
      const float w1 = gtop / (1.f + ex), w2 = gtop * ex / (1.f + ex);
      const int lo = min(i1, i2), hi = max(i1, i2);
      const float wlo = (i1 < i2) ? w1 : w2, whi = (i1 < i2) ? w2 : w1;
      const int pi = (lo == 0) ? (hi - 1) : ((lo == 1) ? (hi + 1) : 5);
      if (lane == 0) {
        const int tl = w * 16 + tk;
        tokb[tl] = gi * 6 + pi;
        tokw[(size_t)(tb + tl) * 2] = wlo;
        tokw[(size_t)(tb + tl) * 2 + 1] = whi;
      }
    }
    __syncthreads();
    int myb = 0;
    if (tid < 64) { myb = tokb[tid]; lpos[tid] = atomicAdd(&lcnt[myb], 1); }
    __syncthreads();
    if (tid < 24) { int c = lcnt[tid]; lbase[tid] = c ? atomicAdd(&gcnt[tid], c) : 0; }
    __syncthreads();
    if (tid < 64) list[(size_t)myb * T + lbase[myb] + lpos[tid]] = tb + tid;
  }
}

struct MoeTile { int bk, r0, cnt, srow0, elo, ehi; };
DEV int moe_total_tiles(const int* gcnt) {
  int tot = 0;
  for (int b = 0; b < 24; ++b) tot += (gcnt[b] + 127) >> 7;
  return tot;
}
DEV MoeTile moe_find(const int* gcnt, int tile) {
  MoeTile r; int acc = 0, srow = 0; r.bk = 0; r.r0 = 0; r.cnt = 0; r.srow0 = 0;
  for (int b = 0; b < 24; ++b) {
    int c = gcnt[b]; int nt = (c + 127) >> 7;
    if (tile >= acc && tile < acc + nt) { r.bk = b; r.r0 = (tile - acc) * 128; r.cnt = c; r.srow0 = srow; }
    acc += nt; srow += c;
  }
  int g = r.bk / 6, pi = r.bk - g * 6;
  int lo = (pi < 3) ? 0 : ((pi < 5) ? 1 : 2);
  int hi = (pi < 3) ? pi + 1 : ((pi < 5) ? pi - 1 : 3);
  r.elo = g * 4 + lo; r.ehi = g * 4 + hi;
  return r;
}

DEV void phase_moe1(const Params& p, int layer, unsigned char* smem) {
  const int* gcnt = (const int*)(p.ws + S_CNT) + layer * 32;
  const int* list = (const int*)(p.ws + S_LIST);
  const float* tokw = (const float*)(p.ws + S_TOKW);
  const bfu* X1b = (const bfu*)(p.ws + OFF_X1B);
  const bfu* Wgu = (const bfu*)(p.ws + OFF_WGU) + (size_t)layer * 16 * 512 * 1024;
  bfu* H = (bfu*)(p.ws + OFF_H);
  const int total = moe_total_tiles(gcnt) * 8;
  const int r0 = my_tid() >> 3;
  auto mkA = [&](const MoeTile& mt) {
    GatherLoader g;
    g.base = X1b;
#pragma unroll
    for (int i = 0; i < 4; ++i) {
      const int r = mt.r0 + r0 + 32 * i;
      const int tok = list[(size_t)mt.bk * T + (r < mt.cnt ? r : 0)];
      g.off[i] = (unsigned)tok * 1024u;
    }
    return g;
  };
  auto mkB = [&](const MoeTile& mt, int nt) {
    const int ex = (nt < 4) ? mt.elo : mt.ehi;
    return RowLoader{Wgu, (unsigned)(ex * 512 + (nt & 3) * 128 + r0) * 1024u, 32768u};
  };
  GemmPipe gp;
  bool first = true;
  int it = blockIdx.x;
  if (it >= total) return;
  MoeTile mt = moe_find(gcnt, it >> 3);
  GatherLoader al = mkA(mt);
  RowLoader bl = mkB(mt, it & 7);
  for (;;) {
    const int nt = it & 7;
    const int itn = it + gridDim.x;
    const bool hasNext = itn < total;
    const int itq = hasNext ? itn : it;
    const MoeTile mtn = moe_find(gcnt, itq >> 3);
    const GatherLoader aln = mkA(mtn);
    const RowLoader bln = mkB(mtn, itq & 7);
    auto epi = [&](f32x4(&acc)[4][4], int wm, int wn, int l15, int lq) {
      const int q = (nt & 3) * 2 + wn;
#pragma unroll
      for (int bi = 0; bi < 4; ++bi) {
        const int r = mt.r0 + wm * 64 + bi * 16 + l15;
        if (r < mt.cnt) {
          const int tok = list[(size_t)mt.bk * T + r];
          const float gw = tokw[(size_t)tok * 2 + (nt >> 2)];
#pragma unroll
          for (int ai = 0; ai < 2; ++ai) {
            float o[4];
#pragma unroll
            for (int j = 0; j < 4; ++j) o[j] = siluf(acc[ai][bi][j]) * acc[ai + 2][bi][j] * gw;
            *(uint2*)(H + (size_t)(mt.srow0 + r) * 512 + (nt >> 2) * 256 + q * 32 + ai * 16 + lq * 4) =
                make_uint2(pack2(o[0], o[1]), pack2(o[2], o[3]));
          }
        }
      }
    };
    gemm128(true, 1024, first, hasNext, al, bl, aln, bln, epi, gp, smem);
    first = false;
    if (!hasNext) break;
    it = itn; mt = mtn; al = aln; bl = bln;
  }
}

DEV void phase_moe2(const Params& p, int layer, unsigned char* smem) {
  const int* gcnt = (const int*)(p.ws + S_CNT) + layer * 32;
  const int* list = (const int*)(p.ws + S_LIST);
  const bfu* H = (const bfu*)(p.ws + OFF_H);
  const bfu* Wdn = (const bfu*)(p.ws + OFF_WDN) + (size_t)layer * 16 * 1024 * 256;
  bfu* FF = (bfu*)(p.ws + OFF_MIX);
  const int total = moe_total_tiles(gcnt) * 8;
  const int r0 = my_tid() >> 3;
  auto mkA = [&](const MoeTile& mt) { return RowLoader{H, (unsigned)(mt.srow0 + mt.r0 + r0) * 512u, 16384u}; };
  auto mkB = [&](const MoeTile& mt, int nt) {
    return SplitKLoader{Wdn, (unsigned)(mt.elo * 1024 + nt * 128 + r0) * 256u, (unsigned)((mt.ehi - mt.elo) * 1024) * 256u};
  };
  GemmPipe gp;
  bool first = true;
  int it = blockIdx.x;
  if (it >= total) return;
  MoeTile mt = moe_find(gcnt, it >> 3);
  RowLoader al = mkA(mt);
  SplitKLoader bl = mkB(mt, it & 7);
  for (;;) {
    const int nt = it & 7;
    const int itn = it + gridDim.x;
    const bool hasNext = itn < total;
    const int itq = hasNext ? itn : it;
    const MoeTile mtn = moe_find(gcnt, itq >> 3);
    const RowLoader aln = mkA(mtn);
    const SplitKLoader bln = mkB(mtn, itq & 7);
    auto epi = [&](f32x4(&acc)[4][4], int wm, int wn, int l15, int lq) {
#pragma unroll
      for (int bi = 0; bi < 4; ++bi) {
        const int r = mt.r0 + wm * 64 + bi * 16 + l15;
        if (r < mt.cnt) {
          const int tok = list[(size_t)mt.bk * T + r];
#pragma unroll
          for (int ai = 0; ai < 4; ++ai)
            *(uint2*)(FF + (size_t)tok * 1024 + nt * 128 + wn * 64 + ai * 16 + lq * 4) =
                make_uint2(pack2(acc[ai][bi][0], acc[ai][bi][1]), pack2(acc[ai][bi][2], acc[ai][bi][3]));
        }
      }
    };
    gemm128(true, 512, first, hasNext, al, bl, aln, bln, epi, gp, smem);
    first = false;
    if (!hasNext) break;
    it = itn; mt = mtn; al = aln; bl = bln;
  }
}

DEV void phase_ln2(const Params& p, int layer, float* __restrict__ outp, bfu* __restrict__ outb) {
  const bfu* X1b = (const bfu*)(p.ws + OFF_X1B);
  const bfu* FF = (const bfu*)(p.ws + OFF_MIX);
  const float* g2 = p.ln2_g + layer * 1024;
  const float* b2 = p.ln2_b + layer * 1024;
  const int lane = my_tid() & 63, w = my_tid() >> 6;
  const int stride = gridDim.x * 4;
  int t = blockIdx.x * 4 + w;
  if (t >= T) return;
  uint2 nxa[4]; uint2 nxm[4];
#pragma unroll
  for (int i = 0; i < 4; ++i) {
    nxa[i] = *(const uint2*)(X1b + (size_t)t * 1024 + i * 256 + lane * 4);
    nxm[i] = *(const uint2*)(FF + (size_t)t * 1024 + i * 256 + lane * 4);
  }
  for (; t < T; t += stride) {
    uint2 cxa[4]; uint2 cxm[4];
#pragma unroll
    for (int i = 0; i < 4; ++i) { cxa[i] = nxa[i]; cxm[i] = nxm[i]; }
    {
      const int tn = (t + stride < T) ? t + stride : t;
#pragma unroll
      for (int i = 0; i < 4; ++i) {
        nxa[i] = *(const uint2*)(X1b + (size_t)tn * 1024 + i * 256 + lane * 4);
        nxm[i] = *(const uint2*)(FF + (size_t)tn * 1024 + i * 256 + lane * 4);
      }
    }
    float xv[16];
    float s = 0.f;
#pragma unroll
    for (int i = 0; i < 4; ++i) {
      const uint2 ab_ = cxa[i];
      const float4 a = make_float4(__uint_as_float(ab_.x << 16), __uint_as_float(ab_.x & 0xffff0000u), __uint_as_float(ab_.y << 16), __uint_as_float(ab_.y & 0xffff0000u));
      const uint2 mb = cxm[i];
      const float4 m = make_float4(__uint_as_float(mb.x << 16), __uint_as_float(mb.x & 0xffff0000u), __uint_as_float(mb.y << 16), __uint_as_float(mb.y & 0xffff0000u));
      xv[4 * i] = ALPHA * a.x + m.x; xv[4 * i + 1] = ALPHA * a.y + m.y;
      xv[4 * i + 2] = ALPHA * a.z + m.z; xv[4 * i + 3] = ALPHA * a.w + m.w;
      s += xv[4 * i] + xv[4 * i + 1] + xv[4 * i + 2] + xv[4 * i + 3];
    }
    const float mu = wave_sum(s) * (1.f / 1024.f);
    float vs = 0.f;
#pragma unroll
    for (int e = 0; e < 16; ++e) { float d = xv[e] - mu; vs += d * d; }
    const float rstd = rsqrtf(wave_sum(vs) * (1.f / 1024.f) + 1e-5f);
#pragma unroll
    for (int i = 0; i < 4; ++i) {
      float4 gg = *(const float4*)(g2 + i * 256 + lane * 4);
      float4 bb = *(const float4*)(b2 + i * 256 + lane * 4);
      const float o0 = (xv[4 * i] - mu) * rstd * gg.x + bb.x, o1 = (xv[4 * i + 1] - mu) * rstd * gg.y + bb.y;
      const float o2 = (xv[4 * i + 2] - mu) * rstd * gg.z + bb.z, o3 = (xv[4 * i + 3] - mu) * rstd * gg.w + bb.w;
      *(float4*)(outp + (size_t)t * 1024 + i * 256 + lane * 4) = make_float4(o0, o1, o2, o3);
      if (outb) *(uint2*)(outb + (size_t)t * 1024 + i * 256 + lane * 4) = make_uint2(pack2(o0, o1), pack2(o2, o3));
    }
  }
}

template <int NK, bool SINK, typename KP, typename VP, typename MK, typename OUT>
DEV void attn_core(const bfu* qptr, KP kptr, VP vptr, MK maskf, float sink, OUT outf, unsigned char* smem) {
  constexpr int NT = NK / 16;
  constexpr int VS = NK + 16;
  constexpr int KS = 80;
  bfu* Ks = (bfu*)smem;
  bfu* Ps = Ks;
  bfu* Vt = Ks + NK * KS;
  const int tid = my_tid(), lane = tid & 63, w = tid >> 6, l15 = lane & 15, lq = lane >> 4;
  uint4 k0, k1, k2, k3, k4, k5, k6, k7, v0, v1, v2, v3, v4, v5, v6, v7;
#define ATT_LD(i) if constexpr (i < NK / 32) { const int idx = tid + 256 * i; const int kk = idx >> 3, sg = idx & 7; \
    k##i = *(const uint4*)(kptr(kk) + sg * 8); const int d = idx / (NK / 8), k8 = idx - d * (NK / 8); v##i = *(const uint4*)(vptr(d, k8)); }
  ATT_LD(0) ATT_LD(1) ATT_LD(2) ATT_LD(3) ATT_LD(4) ATT_LD(5) ATT_LD(6) ATT_LD(7)
#undef ATT_LD
  const uint4 qf0 = *(const uint4*)(qptr + lq * 8), qf1 = *(const uint4*)(qptr + 32 + lq * 8);
  __syncthreads();
#define ATT_ST(i) if constexpr (i < NK / 32) { const int idx = tid + 256 * i; const int kk = idx >> 3, sg = idx & 7; \
    *(uint4*)(Ks + kk * KS + sg * 8) = k##i; const int d = idx / (NK / 8), k8 = idx - d * (NK / 8); *(uint4*)(Vt + d * VS + k8 * 8) = v##i; }
  ATT_ST(0) ATT_ST(1) ATT_ST(2) ATT_ST(3) ATT_ST(4) ATT_ST(5) ATT_ST(6) ATT_ST(7)
#undef ATT_ST
  __syncthreads();
  f32x4 s[NT];
#pragma unroll
  for (int ni = 0; ni < NT; ++ni) {
    f32x4 a = f32x4{0.f, 0.f, 0.f, 0.f};
    a = mfma16(lds128(Ks + (ni * 16 + l15) * KS + lq * 8), qf0, a);
    a = mfma16(lds128(Ks + (ni * 16 + l15) * KS + 32 + lq * 8), qf1, a);
    s[ni] = a;
  }
  const int row = 16 * w + l15;
  float mx = NEGF;
#pragma unroll
  for (int ni = 0; ni < NT; ++ni)
#pragma unroll
    for (int j = 0; j < 4; ++j) {
      const int kk = ni * 16 + lq * 4 + j;
      float v = maskf(row, kk) ? s[ni][j] * 0.125f : NEGF;
      s[ni][j] = v;
      mx = fmaxf(mx, v);
    }
  mx = fmaxf(mx, __shfl_xor(mx, 16));
  mx = fmaxf(mx, __shfl_xor(mx, 32));
  if (SINK) mx = fmaxf(mx, sink);
  float ls = 0.f;
#pragma unroll
  for (int ni = 0; ni < NT; ++ni)
#pragma unroll
    for (int j = 0; j < 4; ++j) {
      float pv = __expf(s[ni][j] - mx);
      ls += pv;
      s[ni][j] = pv;
    }
  ls += __shfl_xor(ls, 16);
  ls += __shfl_xor(ls, 32);
  if (SINK) ls += __expf(sink - mx);
  __syncthreads();
#pragma unroll
  for (int ni = 0; ni < NT; ++ni)
    *(uint2*)(Ps + row * VS + ni * 16 + lq * 4) = make_uint2(pack2(s[ni][0], s[ni][1]), pack2(s[ni][2], s[ni][3]));
  __syncthreads();
  f32x4 o[4];
#pragma unroll
  for (int ni = 0; ni < 4; ++ni) o[ni] = f32x4{0.f, 0.f, 0.f, 0.f};
#pragma unroll
  for (int ks = 0; ks < NK / 32; ++ks) {
    uint4 pb = lds128(Ps + row * VS + ks * 32 + lq * 8);
#pragma unroll
    for (int ni = 0; ni < 4; ++ni) o[ni] = mfma16(lds128(Vt + (ni * 16 + l15) * VS + ks * 32 + lq * 8), pb, o[ni]);
  }
#pragma unroll
  for (int ni = 0; ni < 4; ++ni) outf(row, ni * 16 + lq * 4, o[ni], mx, ls);
}

DEV void swa_item(const Params& p, int it, unsigned char* smem) {
  const int h = it & 7, qt = (it >> 3) & 255, b = it >> 11;
  const int hk = h >> 2;
  const int t0 = qt * 64, kstart = t0 - 128;
  const bfu* P = (const bfu*)(p.ws + OFF_P);
  bfu* Y = (bfu*)(p.ws + OFF_Y);
  const int lane = my_tid() & 63, w = my_tid() >> 6, l15 = lane & 15;
  const bfu* qptr = P + ((size_t)b * L + t0 + 16 * w + l15) * 1536 + h * 64;
  const bfu* kb = P + (size_t)b * L * 1536 + 512 + hk * 64;
  auto kptr = [&](int kk) -> const bfu* { int pos = kstart + kk; pos = pos < 0 ? 0 : pos; return kb + (size_t)pos * 1536; };
  const bfu* vtb = (const bfu*)(p.ws + OFF_VT) + (size_t)((0 * 2 + b) * 2 + hk) * 64 * L;
  auto vptr = [&](int d, int k8) -> const bfu* { int pos = kstart + k8 * 8; pos = pos < 0 ? 0 : pos; return vtb + (size_t)d * L + pos; };
  auto maskf = [&](int row, int kk) -> bool { int pos = kstart + kk, t = t0 + row; return pos >= 0 && pos <= t && (t - pos) < 128; };
  auto outf = [&](int row, int d0, f32x4 o, float m, float l) {
    const float inv = 1.f / l;
    *(uint2*)(Y + ((size_t)b * L + t0 + row) * 1024 + h * 64 + d0) = make_uint2(pack2(o[0] * inv, o[1] * inv), pack2(o[2] * inv, o[3] * inv));
  };
  attn_core<192, true>(qptr, kptr, vptr, maskf, p.od_sinks[h], outf, smem);
}

DEV void kmean_item(const Params& p, int it, unsigned char* smem) {
  const int j = it & 63, bhk = it >> 6, b = bhk >> 1, hk = bhk & 1;
  const bfu* P = (const bfu*)(p.ws + OFF_P);
  float* red = (float*)smem;
  const int tid = my_tid(), d = tid & 63, part = tid >> 6;
  const bfu* kb = P + ((size_t)b * L + j * 256 + part * 64) * 1536 + 1280 + hk * 64 + d;
  float s = 0.f;
  for (int i = 0; i < 64; ++i) s += bf2f(kb[(size_t)i * 1536]);
  __syncthreads();
  red[part * 64 + d] = s;
  __syncthreads();
  if (tid < 64) {
    float tot = red[tid] + red[64 + tid] + red[128 + tid] + red[192 + tid];
    ((bfu*)(p.ws + S_KMEAN))[(size_t)it * 64 + tid] = f2bf(tot * (1.f / 256.f));
  }
}

DEV int cap_off(int j) { return 1024 * (63 * j - (j * (j - 1)) / 2); }

DEV void moba_own_item(const Params& p, int it, unsigned char* smem) {
  const int h = it & 7, o4 = (it >> 3) & 3, c = (it >> 5) & 63, b = it >> 11;
  const int hk = h >> 2, g = h & 3;
  const int t0 = c * 256 + o4 * 64;
  const bfu* P = (const bfu*)(p.ws + OFF_P);
  bfu* PO = (bfu*)(p.ws + OFF_PO);
  float* PM = (float*)(p.ws + OFF_PM);
  float* PL = (float*)(p.ws + OFF_PL);
  const int tid = my_tid(), lane = tid & 63, w = tid >> 6, l15 = lane & 15, lq = lane >> 4;
  const bfu* qptr = P + ((size_t)b * L + t0 + 16 * w + l15) * 1536 + 768 + h * 64;
  const bfu* kb = P + ((size_t)b * L + c * 256) * 1536 + 1280 + hk * 64;
  auto kptr = [&](int kk) -> const bfu* { return kb + (size_t)kk * 1536; };
  const bfu* vtb = (const bfu*)(p.ws + OFF_VT) + (size_t)((1 * 2 + b) * 2 + hk) * 64 * L + c * 256;
  auto vptr = [&](int d, int k8) -> const bfu* { return vtb + (size_t)d * L + k8 * 8; };
  auto maskf = [&](int row, int kk) -> bool { return kk <= o4 * 64 + row; };
  auto outf = [&](int row, int d0, f32x4 o, float m, float l) {
    const size_t idx = (((size_t)b * L + t0 + row) * 8 + h) * 4;
    const float inv = 1.f / l;
    *(uint2*)(PO + idx * 64 + d0) = make_uint2(pack2(o[0] * inv, o[1] * inv), pack2(o[2] * inv, o[3] * inv));
    if (d0 == 0) { PM[idx] = m; PL[idx] = l; }
  };
  attn_core<256, false>(qptr, kptr, vptr, maskf, 0.f, outf, smem);
  int* lcnt = (int*)(smem + SM_AUX);
  int* lbase = lcnt + 64;
  int* sel = lbase + 64;
  if (tid < 64) lcnt[tid] = 0;
  __syncthreads();
  const uint4 qf0 = *(const uint4*)(qptr + lq * 8), qf1 = *(const uint4*)(qptr + 32 + lq * 8);
  const bfu* km = (const bfu*)(p.ws + S_KMEAN) + (size_t)(b * 2 + hk) * 64 * 64;
  float cand[4][4];
#pragma unroll
  for (int ni = 0; ni < 4; ++ni) {
    f32x4 a = f32x4{0.f, 0.f, 0.f, 0.f};
    a = mfma16(qf0, *(const uint4*)(km + (ni * 16 + l15) * 64 + lq * 8), a);
    a = mfma16(qf1, *(const uint4*)(km + (ni * 16 + l15) * 64 + 32 + lq * 8), a);
#pragma unroll
    for (int j = 0; j < 4; ++j) cand[ni][j] = (ni * 16 + l15 < c) ? a[j] : -3e38f;
  }
#pragma unroll
  for (int j = 0; j < 4; ++j) {
    const int row = 16 * w + lq * 4 + j;
#pragma unroll
    for (int sl = 0; sl < 3; ++sl) {
      float bv = cand[0][j]; int bi = l15;
#pragma unroll
      for (int ni = 1; ni < 4; ++ni) if (cand[ni][j] > bv) { bv = cand[ni][j]; bi = ni * 16 + l15; }
#pragma unroll
      for (int off = 8; off >= 1; off >>= 1) {
        float ov = __shfl_xor(bv, off); int oi = __shfl_xor(bi, off);
        if (ov > bv || (ov == bv && oi < bi)) { bv = ov; bi = oi; }
      }
      const bool valid = bv > -1e38f;
#pragma unroll
      for (int ni = 0; ni < 4; ++ni) if (ni * 16 + l15 == bi) cand[ni][j] = -3e38f;
      if (l15 == 0) {
        const size_t idx = (((size_t)b * L + t0 + row) * 8 + h) * 4 + 1 + sl;
        if (valid) {
          int lp = atomicAdd(&lcnt[bi], 1);
          sel[row * 3 + sl] = bi | (lp << 8);
        } else {
          sel[row * 3 + sl] = -1;
          PM[idx] = NEGF; PL[idx] = 0.f;
        }
      }
    }
  }
  __syncthreads();
  int* gcnt = (int*)(p.ws + S_CNT) + 64 + (b * 2 + hk) * 64;
  if (tid < 64) { int cc = lcnt[tid]; lbase[tid] = cc ? atomicAdd(&gcnt[tid], cc) : 0; }
  __syncthreads();
  if (tid < 192) {
    const int row = tid / 3, sl = tid - row * 3;
    const int sv = sel[tid];
    if (sv >= 0) {
      const int bi = sv & 255, lp = sv >> 8;
      int* bucket = (int*)(p.ws + OFF_BUCK) + (size_t)(b * 2 + hk) * BUCK_PER_BH + cap_off(bi);
      bucket[lbase[bi] + lp] = ((t0 + row) << 4) | (g << 2) | (sl + 1);
    }
  }
}

DEV void phase_moba_bucket(const Params& p, unsigned char* smem) {
  int* pref = (int*)(smem + SM_AUX);
  const int* gcnt = (const int*)(p.ws + S_CNT) + 64;
  const int tid = my_tid(), lane = tid & 63, w = tid >> 6, l15 = lane & 15;
  {
    int nt = (gcnt[tid] + 63) >> 6;
    __syncthreads();
    pref[tid] = nt;
    __syncthreads();
    for (int off = 1; off < 256; off <<= 1) {
      int v = pref[tid];
      if (tid >= off) v += pref[tid - off];
      __syncthreads();
      pref[tid] = v;
      __syncthreads();
    }
  }
  const int total = pref[255];
  const bfu* P = (const bfu*)(p.ws + OFF_P);
  bfu* PO = (bfu*)(p.ws + OFF_PO);
  float* PM = (float*)(p.ws + OFF_PM);
  float* PL = (float*)(p.ws + OFF_PL);
  const int lq = lane >> 4;
  struct Item { int bk, cnt, rbase; };
  auto decode = [&](int it) -> Item {
    int lo = 0, hi = 255;
    while (lo < hi) { int mid = (lo + hi) >> 1; if (pref[mid] > it) hi = mid; else lo = mid + 1; }
    Item r; r.bk = lo; r.cnt = gcnt[lo];
    const int ntb = (r.cnt + 63) >> 6;
    r.rbase = (it - (pref[lo] - ntb)) * 64;
    return r;
  };
  auto bucket_of = [&](int bk) -> const int* {
    return (const int*)(p.ws + OFF_BUCK) + (size_t)(bk >> 6) * BUCK_PER_BH + cap_off(bk & 63);
  };
  auto load_entries = [&](const Item& im, int& e, int (&en)[4]) {
    const int* bucket = bucket_of(im.bk);
    const int rr = im.rbase + 16 * w + l15;
    e = bucket[rr < im.cnt ? rr : 0];
#pragma unroll
    for (int j = 0; j < 4; ++j) { const int r = im.rbase + 16 * w + lq * 4 + j; en[j] = bucket[r < im.cnt ? r : 0]; }
  };
  int it = blockIdx.x;
  if (it >= total) return;
  Item cur = decode(it);
  int e, en[4];
  load_entries(cur, e, en);
  for (;;) {
    const int itn = it + gridDim.x;
    const bool hasNext = itn < total;
    Item nxt = cur; int e2 = e, en2[4] = {en[0], en[1], en[2], en[3]};
    if (hasNext) { nxt = decode(itn); load_entries(nxt, e2, en2); }
    const int bk = cur.bk, cnt = cur.cnt, rbase = cur.rbase;
    const int j = bk & 63, bhk = bk >> 6, b = bhk >> 1, hk = bhk & 1;
    const bfu* qptr = P + ((size_t)b * L + (e >> 4)) * 1536 + 768 + (hk * 4 + ((e >> 2) & 3)) * 64;
    const bfu* kb = P + ((size_t)b * L + j * 256) * 1536 + 1280 + hk * 64;
    auto kptr = [&](int kk) -> const bfu* { return kb + (size_t)kk * 1536; };
    const bfu* vtb = (const bfu*)(p.ws + OFF_VT) + (size_t)((1 * 2 + b) * 2 + hk) * 64 * L + j * 256;
    auto vptr = [&](int d, int k8) -> const bfu* { return vtb + (size_t)d * L + k8 * 8; };
    auto maskf = [&](int row, int kk) -> bool { return true; };
    auto outf = [&](int row, int d0, f32x4 o, float m, float l) {
      if (rbase + row < cnt) {
        const size_t idx = (((size_t)b * L + (e >> 4)) * 8 + hk * 4 + ((e >> 2) & 3)) * 4 + (e & 3);
        const float inv = 1.f / l;
        *(uint2*)(PO + idx * 64 + d0) = make_uint2(pack2(o[0] * inv, o[1] * inv), pack2(o[2] * inv, o[3] * inv));
        if (d0 == 0) { PM[idx] = m; PL[idx] = l; }
      }
    };
    attn_core<256, false>(qptr, kptr, vptr, maskf, 0.f, outf, smem);
    if (!hasNext) break;
    it = itn; cur = nxt; e = e2;
#pragma unroll
    for (int q = 0; q < 4; ++q) en[q] = en2[q];
  }
}

DEV void phase_moba_merge(const Params& p) {
  const bfu* PO = (const bfu*)(p.ws + OFF_PO);
  const float* PM = (const float*)(p.ws + OFF_PM);
  const float* PL = (const float*)(p.ws + OFF_PL);
  bfu* Y = (bfu*)(p.ws + OFF_Y);
  const size_t total = (size_t)T * 8 * 8;
  for (size_t id = (size_t)blockIdx.x * 256 + my_tid(); id < total; id += (size_t)gridDim.x * 256) {
    const int ds = (int)(id & 7);
    const size_t th = id >> 3;
    const float4 m4 = *(const float4*)(PM + th * 4);
    const float4 l4 = *(const float4*)(PL + th * 4);
    float mm[4] = {m4.x, m4.y, m4.z, m4.w}, ll[4] = {l4.x, l4.y, l4.z, l4.w};
    float M = mm[0];
#pragma unroll
    for (int s = 1; s < 4; ++s) if (ll[s] > 0.f) M = fmaxf(M, mm[s]);
    float wsum = 0.f;
    float acc[8] = {0.f, 0.f, 0.f, 0.f, 0.f, 0.f, 0.f, 0.f};
#pragma unroll
    for (int s = 0; s < 4; ++s) {
      if (s == 0 || ll[s] > 0.f) {
        const float wgt = ll[s] * __expf(mm[s] - M);
        wsum += wgt;
        uint4 ov = *(const uint4*)(PO + (th * 4 + s) * 64 + ds * 8);
        unsigned uu[4] = {ov.x, ov.y, ov.z, ov.w};
#pragma unroll
        for (int e = 0; e < 4; ++e) {
          acc[2 * e] += wgt * __uint_as_float(uu[e] << 16);
          acc[2 * e + 1] += wgt * __uint_as_float(uu[e] & 0xffff0000u);
        }
      }
    }
    const float inv = 1.f / wsum;
    const size_t t = th >> 3; const int h = (int)(th & 7);
    *(uint4*)(Y + t * 1024 + 512 + h * 64 + ds * 8) =
        make_uint4(pack2(acc[0] * inv, acc[1] * inv), pack2(acc[2] * inv, acc[3] * inv),
                   pack2(acc[4] * inv, acc[5] * inv), pack2(acc[6] * inv, acc[7] * inv));
  }
}


#define XB_TMO      128
#define XB_XCNT(j)  (256  + 64 * (j))
#define XB_XSUB(j)  (1280 + 64 * (j))
#define XB_XGEN(j)  (2304 + 64 * (j))
#define XB_TOP      3328
#define XB_TOPGEN   3392
#define XCD_BAR_WORDS 3456
#define XB_SPIN_CAP (1u << 22)
#define LAS __attribute__((address_space(3)))
DEV unsigned xb_ld(unsigned* p) { return __hip_atomic_load(p, __ATOMIC_RELAXED, __HIP_MEMORY_SCOPE_AGENT); }
DEV unsigned xb_add(unsigned* p, unsigned v) { return __hip_atomic_fetch_add(p, v, __ATOMIC_RELAXED, __HIP_MEMORY_SCOPE_AGENT); }
DEV unsigned xb_xcc_id() { return (unsigned)__builtin_amdgcn_s_getreg((3 << 11) | 20) & 0xFu; }
#define XB_SPIN(cond, bar) do { unsigned _sp = 0; while (cond) { __builtin_amdgcn_s_sleep(1); \
    if ((++_sp & 255u) == 0u) { if (xb_ld(&(bar)[XB_TMO])) break; if (_sp > XB_SPIN_CAP) { atomicAdd(&(bar)[XB_TMO], 1u); break; } } } } while (0)
struct XcdBarrier { unsigned* bar; unsigned x; volatile LAS unsigned* st; };
DEV XcdBarrier xcd_barrier_post(unsigned* bar, volatile LAS unsigned* st) {
  XcdBarrier b; b.bar = bar; b.x = xb_xcc_id(); b.st = st;
  if (threadIdx.x == 0) (void)xb_add(&bar[XB_XCNT(b.x)], 1u);
  return b;
}
DEV void xcd_barrier_complete(unsigned* bar, unsigned x, unsigned& nloc, unsigned& nx) {
  const unsigned G = gridDim.x * gridDim.y * gridDim.z;
  unsigned sum, cnt, mine, sp = 0u;
  for (;;) {
    sum = 0u; cnt = 0u; mine = 0u;
#pragma unroll
    for (unsigned j = 0; j < 16; ++j) { const unsigned c = xb_ld(&bar[XB_XCNT(j)]); sum += c; cnt += (c > 0u) ? 1u : 0u; mine = (j == x) ? c : mine; }
    if (sum == G) break;
    __builtin_amdgcn_s_sleep(1);
    if ((++sp & 255u) == 0u) { if (xb_ld(&bar[XB_TMO])) break; if (sp > XB_SPIN_CAP) { atomicAdd(&bar[XB_TMO], 1u); break; } }
  }
  nloc = mine > 0u ? mine : 1u; nx = cnt > 0u ? cnt : 1u;
}
DEV void xcd_barrier(const XcdBarrier& b) {
  asm volatile("s_waitcnt vmcnt(0)" ::: "memory");
  __syncthreads();
  if (threadIdx.x == 0) {
    unsigned* bar = b.bar;
    __builtin_amdgcn_s_waitcnt(0);
    unsigned nloc = b.st[0], nx = b.st[1];
    if (nloc == 0u) { xcd_barrier_complete(bar, b.x, nloc, nx); b.st[0] = nloc; b.st[1] = nx; }
    const unsigned old = xb_add(&bar[XB_XSUB(b.x)], 1u);
    const unsigned gen = old / nloc;
    if (old + 1u == (gen + 1u) * nloc) {
      __builtin_amdgcn_fence(__ATOMIC_RELEASE, "agent");
      asm volatile("s_waitcnt vmcnt(0)" ::: "memory");
      const unsigned og = xb_add(&bar[XB_TOP], 1u);
      const unsigned tg = og / nx;
      if (og + 1u == (tg + 1u) * nx) xb_add(&bar[XB_TOPGEN], 1u);
      else XB_SPIN(xb_ld(&bar[XB_TOPGEN]) == tg, bar);
      __builtin_amdgcn_fence(__ATOMIC_ACQUIRE, "agent");
      xb_add(&bar[XB_XGEN(b.x)], 1u);
      asm volatile("s_waitcnt vmcnt(0)" ::: "memory");
    } else {
      XB_SPIN(xb_ld(&bar[XB_XGEN(b.x)]) == gen, bar);
      __builtin_amdgcn_fence(__ATOMIC_ACQUIRE, "agent");
      asm volatile("s_waitcnt vmcnt(0)" ::: "memory");
    }
  }
  __syncthreads();
}

__global__ void __launch_bounds__(256, 2) mega(Params p) {
  __shared__ __attribute__((aligned(16))) unsigned char smem[SMEM_BYTES];
  cg::grid_group grid = cg::this_grid();
  unsigned char* ws = p.ws;
  unsigned* barw = (unsigned*)(ws + S_BAR);
  volatile LAS unsigned* xbst = (volatile LAS unsigned*)(smem + SMEM_BYTES - 16);
  if (threadIdx.x == 0) { xbst[0] = 0u; xbst[1] = 0u; }
  if (blockIdx.x == 0) for (int i = threadIdx.x; i < XCD_BAR_WORDS; i += 256) barw[i] = 0u;

#if XSYNC
  for (int i = 0; i < 20; ++i) grid.sync();
#endif
  phase_prep(p, smem);
#if (DUPMASK >> 0) & 1
  grid.sync();
  phase_prep(p, smem);
#endif
  grid.sync();
  XcdBarrier xb = xcd_barrier_post(barw, xbst);
  phase_proj((const bfu*)(ws + OFF_XB), (const bfu*)(ws + OFF_WEVIN), (bfu*)(ws + OFF_P), 2560, (bfu*)p.out, 0, smem);
#if (DUPMASK >> 1) & 1
  GSYNC;
  phase_proj((const bfu*)(ws + OFF_XB), (const bfu*)(ws + OFF_WEVIN), (bfu*)(ws + OFF_P), 2560, (bfu*)p.out, 0, smem);
#endif
  GSYNC;
  for (int it = blockIdx.x; it < 2048; it += gridDim.x) hgrn_dstate_item(p, it, smem);
  {
    uint4 bf[8], cf[4]; float2 ab; float dsk;
    s5_load_consts(p, (blockIdx.x & 7) * 4 + (my_tid() >> 6), my_tid() & 63, bf, cf, ab, dsk);
    for (int it = blockIdx.x; it < 4096; it += gridDim.x) s5_pass1_item(p, it, bf, ab, smem);
  }
#if (DUPMASK >> 2) & 1
  GSYNC;
  for (int it = blockIdx.x; it < 2048; it += gridDim.x) hgrn_dstate_item(p, it, smem);
  {
    uint4 bf[8], cf[4]; float2 ab; float dsk;
    s5_load_consts(p, (blockIdx.x & 7) * 4 + (my_tid() >> 6), my_tid() & 63, bf, cf, ab, dsk);
    for (int it = blockIdx.x; it < 4096; it += gridDim.x) s5_pass1_item(p, it, bf, ab, smem);
  }
#endif
  GSYNC;
  if (blockIdx.x < 64) hgrn_scan_item(p, blockIdx.x);
  else if (blockIdx.x < 80) s5_carry_item(p, blockIdx.x - 64);
#if (DUPMASK >> 3) & 1
  GSYNC;
  if (blockIdx.x < 64) hgrn_scan_item(p, blockIdx.x);
  else if (blockIdx.x < 80) s5_carry_item(p, blockIdx.x - 64);
#endif
  GSYNC;
  for (int it = blockIdx.x; it < 2048; it += gridDim.x) hgrn_out_item(p, it, smem);
  {
    uint4 bf[8], cf[4]; float2 ab; float dsk;
    s5_load_consts(p, (blockIdx.x & 7) * 4 + (my_tid() >> 6), my_tid() & 63, bf, cf, ab, dsk);
    for (int it = blockIdx.x; it < 4096; it += gridDim.x) s5_pass2_item(p, it, bf, cf, ab, dsk, smem);
  }
#if (DUPMASK >> 4) & 1
  GSYNC;
  for (int it = blockIdx.x; it < 2048; it += gridDim.x) hgrn_out_item(p, it, smem);
  {
    uint4 bf[8], cf[4]; float2 ab; float dsk;
    s5_load_consts(p, (blockIdx.x & 7) * 4 + (my_tid() >> 6), my_tid() & 63, bf, cf, ab, dsk);
    for (int it = blockIdx.x; it < 4096; it += gridDim.x) s5_pass2_item(p, it, bf, cf, ab, dsk, smem);
  }
#endif
  GSYNC;
  phase_glu(p, smem);
#if (DUPMASK >> 5) & 1
  GSYNC;
  phase_glu(p, smem);
#endif
  GSYNC;
  phase_outproj(p, (const bfu*)(ws + OFF_WEVOUT), smem);
#if (DUPMASK >> 6) & 1
  GSYNC;
  phase_outproj(p, (const bfu*)(ws + OFF_WEVOUT), smem);
#endif
  GSYNC;
  phase_ln1_router(p, p.x, 0, smem);
#if (DUPMASK >> 7) & 1
  GSYNC;
  if (blockIdx.x == 0 && my_tid() < 24) ((int*)(ws + S_CNT))[my_tid()] = 0;
  GSYNC;
  phase_ln1_router(p, p.x, 0, smem);
#endif
  GSYNC;
  phase_moe1(p, 0, smem);
#if (DUPMASK >> 8) & 1
  GSYNC;
  phase_moe1(p, 0, smem);
#endif
  GSYNC;
  phase_moe2(p, 0, smem);
#if (DUPMASK >> 9) & 1
  GSYNC;
  phase_moe2(p, 0, smem);
#endif
  GSYNC;
  phase_ln2(p, 0, p.out, (bfu*)(ws + OFF_X2B));
#if (DUPMASK >> 10) & 1
  GSYNC;
  phase_ln2(p, 0, p.out, (bfu*)(ws + OFF_X2B));
#endif
  GSYNC;
  phase_proj((const bfu*)(ws + OFF_X2B), (const bfu*)(ws + OFF_WODIN), (bfu*)(ws + OFF_P), 1536, (bfu*)(ws + OFF_VT), 1, smem);
#if (DUPMASK >> 11) & 1
  GSYNC;
  phase_proj((const bfu*)(ws + OFF_X2B), (const bfu*)(ws + OFF_WODIN), (bfu*)(ws + OFF_P), 1536, (bfu*)(ws + OFF_VT), 1, smem);
#endif
  GSYNC;
  for (int it = blockIdx.x; it < 4096 + 256; it += gridDim.x) {
    if (it < 4096) swa_item(p, it, smem); else kmean_item(p, it - 4096, smem);
  }
#if (DUPMASK >> 12) & 1
  GSYNC;
  for (int it = blockIdx.x; it < 4096 + 256; it += gridDim.x) {
    if (it < 4096) swa_item(p, it, smem); else kmean_item(p, it - 4096, smem);
  }
#endif
  GSYNC;
  for (int it = blockIdx.x; it < 4096; it += gridDim.x) moba_own_item(p, it, smem);
#if (DUPMASK >> 13) & 1
  GSYNC;
  if (blockIdx.x == 0) ((int*)(ws + S_CNT))[64 + my_tid()] = 0;
  GSYNC;
  for (int it = blockIdx.x; it < 4096; it += gridDim.x) moba_own_item(p, it, smem);
#endif
  GSYNC;
  phase_moba_bucket(p, smem);
#if (DUPMASK >> 14) & 1
  GSYNC;
  phase_moba_bucket(p, smem);
#endif
  GSYNC;
  phase_moba_merge(p);
#if (DUPMASK >> 15) & 1
  GSYNC;
  phase_moba_merge(p);
#endif
  GSYNC;
  phase_outproj(p, (const bfu*)(ws + OFF_WODOUT), smem);
#if (DUPMASK >> 16) & 1
  GSYNC;
  phase_outproj(p, (const bfu*)(ws + OFF_WODOUT), smem);
#endif
  GSYNC;
  phase_ln1_router(p, p.out, 1, smem);
#if (DUPMASK >> 17) & 1
  GSYNC;
  phase_ln1_router(p, p.out, 1, smem);
#endif
  GSYNC;
  phase_moe1(p, 1, smem);
#if (DUPMASK >> 18) & 1
  GSYNC;
  phase_moe1(p, 1, smem);
#endif
  GSYNC;
  phase_moe2(p, 1, smem);
#if (DUPMASK >> 19) & 1
  GSYNC;
  phase_moe2(p, 1, smem);
#endif
  GSYNC;
  phase_ln2(p, 1, p.out, (bfu*)nullptr);
#if (DUPMASK >> 20) & 1
  GSYNC;
  phase_ln2(p, 1, p.out, (bfu*)nullptr);
#endif
}

extern "C" void kernel_launch(void* const* d_in, const int* in_sizes, int n_in, void* d_out, int out_size, void* d_ws,
                              size_t ws_size, hipStream_t stream) {
  static int grid_blocks = 0;
  if (!grid_blocks) {
    int dev = 0, cus = 0, per_cu = 0;
    hipGetDevice(&dev);
    hipDeviceGetAttribute(&cus, hipDeviceAttributeMultiprocessorCount, dev);
    hipOccupancyMaxActiveBlocksPerMultiprocessor(&per_cu, mega, 256, 0);
    if (per_cu < 1) per_cu = 1;
    if (per_cu > 2) per_cu = 2;
    grid_blocks = (cus * per_cu) & ~7;
    if (ws_size < WS_NEED) fprintf(stderr, "workspace too small: %zu < %zu\n", ws_size, (size_t)WS_NEED);
  }
  Params p{};
  const float** f = (const float**)&p;
  for (int i = 0; i < 27; ++i) f[i] = (const float*)d_in[i];
  p.out = (float*)d_out;
  p.ws = (unsigned char*)d_ws;
  void* args[] = {&p};
  hipError_t e = hipLaunchCooperativeKernel((void*)mega, dim3(grid_blocks), dim3(256), args, 0, stream);
  if (e != hipSuccess) fprintf(stderr, "cooperative launch failed: %s (grid %d)\n", hipGetErrorString(e), grid_blocks);
}
```

```cpp
#ifndef DUPMASK
#define DUPMASK 0
#endif
#ifndef GX
#define GX 0
#endif
#ifndef XSYNC
#define XSYNC 0
#endif
#define GSYNC xcd_barrier(xb)
#include <hip/hip_runtime.h>
#include <hip/hip_cooperative_groups.h>
#include <cstdio>
namespace cg = cooperative_groups;

typedef unsigned short bfu;
typedef __attribute__((ext_vector_type(8))) short bf16x8;
typedef __attribute__((ext_vector_type(4))) float f32x4;
typedef __attribute__((ext_vector_type(2))) float f32x2;

#define DEV __device__ __forceinline__

constexpr int T = 32768, L = 16384;
constexpr float ALPHA = 1.41421356237309515f;
constexpr float NEGF = -1e30f;

constexpr size_t MiB = 1u << 20;
constexpr size_t OFF_WEVIN = 0;
constexpr size_t OFF_WGLU = OFF_WEVIN + 5 * MiB;
constexpr size_t OFF_WEVOUT = OFF_WGLU + 1 * MiB;
constexpr size_t OFF_WODIN = OFF_WEVOUT + 2 * MiB;
constexpr size_t OFF_WODOUT = OFF_WODIN + 3 * MiB;
constexpr size_t OFF_WGU = OFF_WODOUT + 2 * MiB;
constexpr size_t OFF_WDN = OFF_WGU + 32 * MiB;
constexpr size_t OFF_SMALL = OFF_WDN + 16 * MiB;
constexpr size_t OFF_P = OFF_SMALL + 8 * MiB;
constexpr size_t OFF_A = OFF_P + 160 * MiB;
constexpr size_t OFF_X1 = OFF_A + 128 * MiB;
constexpr size_t WS_NEED = OFF_X1 + 128 * MiB;
constexpr size_t S_CNT = OFF_SMALL;
constexpr size_t S_LB = OFF_SMALL + 4096;
constexpr size_t S_ABAR = OFF_SMALL + 8192;
constexpr size_t S_APOW = OFF_SMALL + 24576;
constexpr size_t S_BBAR = OFF_SMALL + 40960;
constexpr size_t S_KMEAN = OFF_SMALL + 303104;
constexpr size_t S_TOKW = OFF_SMALL + 524288;
constexpr size_t S_LIST = OFF_SMALL + 1 * MiB;
constexpr size_t S_BAR = OFF_SMALL + 4 * MiB;
constexpr size_t OFF_BUCK = OFF_P + 96 * MiB;
constexpr size_t OFF_X1B = OFF_P;
constexpr size_t OFF_H = OFF_P + 64 * MiB;
constexpr size_t OFF_X2B = OFF_P + 96 * MiB;
constexpr size_t OFF_XB = OFF_A;
constexpr size_t OFF_DS = OFF_A;
constexpr size_t OFF_SP = OFF_A + 64 * MiB;
constexpr size_t OFF_MIX = OFF_A;
constexpr size_t OFF_PO = OFF_A;
constexpr size_t OFF_YS5 = OFF_X1;
constexpr size_t OFF_Y = OFF_X1 + 32 * MiB;
constexpr size_t OFF_HEND = OFF_X1 + 96 * MiB;
constexpr size_t OFF_CARRY = OFF_X1 + 104 * MiB;
constexpr size_t OFF_DEC = OFF_X1 + 112 * MiB;
constexpr size_t OFF_VT = OFF_X1;
constexpr size_t OFF_PM = OFF_X1 + 96 * MiB;
constexpr size_t OFF_PL = OFF_X1 + 100 * MiB;

constexpr int SMEM_BYTES = 80 * 1024;
constexpr int SM_AUX = 75 * 1024;
constexpr int BUCK_PER_BH = 2016 * 1024;

struct Params {
  const float *x, *lb_logits, *ev_w_in, *ev_a_norm, *a_re, *a_im, *log_dt, *b_re, *b_im, *c_re, *c_im, *s5_d,
      *w_glu, *ev_w_out, *od_w_in, *od_sinks, *od_w_out, *ln1_g, *ln1_b, *w_group, *b_group, *w_expert, *b_expert,
      *w_gate_up, *w_down, *ln2_g, *ln2_b;
  float* out;
  unsigned char* ws;
};

DEV int my_tid() { int t = threadIdx.x; asm volatile("" : "+v"(t)); return t; }
typedef __attribute__((ext_vector_type(2))) __bf16 bf16x2_t;
typedef __attribute__((ext_vector_type(2))) float f32x2c;
DEV bfu f2bf(float f) { __bf16 h = (__bf16)f; return __builtin_bit_cast(bfu, h); }
DEV float bf2f(bfu h) { return __uint_as_float(((unsigned)h) << 16); }
DEV unsigned pack2(float a, float b) { f32x2c v = {a, b}; bf16x2_t r = __builtin_convertvector(v, bf16x2_t); return __builtin_bit_cast(unsigned, r); }
DEV float frcp(float x) { return __builtin_amdgcn_rcpf(x); }
DEV float sigm(float x) { return frcp(1.f + __expf(-x)); }
DEV float siluf(float x) { return x * frcp(1.f + __expf(-x)); }
DEV float gelu_tanh(float x) {
  float u = 1.5957691216057308f * (x + 0.044715f * x * x * x);
  return x * frcp(1.f + __expf(-u));
}
DEV f32x4 mfma16(uint4 a, uint4 b, f32x4 c) {
  return __builtin_amdgcn_mfma_f32_16x16x32_bf16(__builtin_bit_cast(bf16x8, a), __builtin_bit_cast(bf16x8, b), c, 0, 0, 0);
}
DEV uint4 lds128(const bfu* p) { return *(const uint4*)p; }
template <int CTRL> DEV float dpp_f(float v) {
  return __int_as_float(__builtin_amdgcn_update_dpp(0, __float_as_int(v), CTRL, 0xF, 0xF, false));
}
DEV float sum16(float v) {
  v += dpp_f<0xB1>(v);
  v += dpp_f<0x4E>(v);
  v += dpp_f<0x141>(v);
  v += dpp_f<0x140>(v);
  return v;
}
DEV float wave_sum(float v) {
  v = sum16(v);
  const int iv = __float_as_int(v);
  const float s0 = __int_as_float(__builtin_amdgcn_readlane(iv, 0)), s1 = __int_as_float(__builtin_amdgcn_readlane(iv, 16));
  const float s2 = __int_as_float(__builtin_amdgcn_readlane(iv, 32)), s3 = __int_as_float(__builtin_amdgcn_readlane(iv, 48));
  return (s0 + s1) + (s2 + s3);
}
DEV float max16(float v) {
  v = fmaxf(v, __shfl_xor(v, 8)); v = fmaxf(v, __shfl_xor(v, 4));
  v = fmaxf(v, __shfl_xor(v, 2)); v = fmaxf(v, __shfl_xor(v, 1));
  return v;
}
DEV uint4 ld8_f32(const float* p) {
  float4 u = ((const float4*)p)[0], v = ((const float4*)p)[1];
  return make_uint4(pack2(u.x, u.y), pack2(u.z, u.w), pack2(v.x, v.y), pack2(v.z, v.w));
}
DEV uint4 ld8_bf(const bfu* p) { return *(const uint4*)p; }
DEV int perm_half(int c, int half) {
  if (half == 0) return c;
  int hi = c >= half ? 1 : 0;
  int cc = hi ? c - half : c;
  return (cc >> 5) * 64 + hi * 32 + (cc & 31);
}

template <bool SWAP>
DEV void mma_tile(const bfu* As, const bfu* Bs, int wm, int wn, int l15, int lq, f32x4 (&acc)[4][4]) {
#pragma unroll
  for (int ks = 0; ks < 2; ++ks) {
    uint4 af[4], bfr[4];
#pragma unroll
    for (int i = 0; i < 4; ++i) {
      af[i] = lds128(As + (wm * 64 + i * 16 + l15) * 80 + ks * 32 + lq * 8);
      bfr[i] = lds128(Bs + (wn * 64 + i * 16 + l15) * 80 + ks * 32 + lq * 8);
    }
#pragma unroll
    for (int i1 = 0; i1 < 4; ++i1)
#pragma unroll
      for (int i2 = 0; i2 < 4; ++i2)
        acc[i1][i2] = SWAP ? mfma16(bfr[i1], af[i2], acc[i1][i2]) : mfma16(af[i1], bfr[i2], acc[i1][i2]);
    if (ks == 0) __builtin_amdgcn_sched_barrier(0);
  }
}

template <int N> struct IC { static constexpr int v = N; };
template <int I, int N, typename F> DEV void static_for(F&& f) { if constexpr (I < N) { f(IC<I>{}); static_for<I + 1, N>(f); } }

DEV uint4 ld8_at(const bfu* base, unsigned o) { asm volatile("" : "+v"(o)); return ld8_bf(base + o); }
struct RowLoader {
  const bfu* base; unsigned off; unsigned stride32;
  DEV uint4 operator()(int i, int kb, int so) const { return ld8_at(base, off + (unsigned)i * stride32 + (unsigned)kb + (unsigned)so); }
};
struct GatherLoader {
  const bfu* base; unsigned off[4];
  DEV uint4 operator()(int i, int kb, int so) const { return ld8_at(base, off[i] + (unsigned)kb + (unsigned)so); }
};
struct SplitKLoader {
  const bfu* base; unsigned lo; unsigned dhi;
  DEV uint4 operator()(int i, int kb, int so) const {
    const unsigned u = (kb < 256) ? 0u : dhi;
    return ld8_at(base, lo + u + (unsigned)i * 8192u + (unsigned)(kb & 255) + (unsigned)so);
  }
};
struct GemmPipe { uint4 ra[2][4], rb[2][4]; };

template <typename AL, typename BL, typename EP>
DEV void gemm128(bool SWAP, int K, bool first, bool hasNext, const AL& aload, const BL& bload, const AL& aloadN, const BL& bloadN,
                 EP epi, GemmPipe& gp, unsigned char* smem) {
  const int tid = my_tid(), lane = tid & 63, w = tid >> 6, wm = w >> 1, wn = w & 1, l15 = lane & 15, lq = lane >> 4;
  const int seg = tid & 7, r0 = tid >> 3;
  const int nk = K >> 6;
  f32x4 acc[4][4];
#pragma unroll
  for (int mi = 0; mi < 4; ++mi)
#pragma unroll
    for (int ni = 0; ni < 4; ++ni) acc[mi][ni] = f32x4{0.f, 0.f, 0.f, 0.f};
  if (first) {
#pragma unroll
    for (int i = 0; i < 4; ++i) { gp.ra[0][i] = aload(i, 0, seg * 8); gp.rb[0][i] = bload(i, 0, seg * 8); }
#pragma unroll
    for (int i = 0; i < 4; ++i) { gp.ra[1][i] = aload(i, 64, seg * 8); gp.rb[1][i] = bload(i, 64, seg * 8); }
    __syncthreads();
    bfu* As = (bfu*)smem; bfu* Bs = As + 128 * 80;
#pragma unroll
    for (int i = 0; i < 4; ++i) {
      *(uint4*)(As + (r0 + 32 * i) * 80 + seg * 8) = gp.ra[0][i];
      *(uint4*)(Bs + (r0 + 32 * i) * 80 + seg * 8) = gp.rb[0][i];
    }
#pragma unroll
    for (int i = 0; i < 4; ++i) { gp.ra[0][i] = aload(i, 128, seg * 8); gp.rb[0][i] = bload(i, 128, seg * 8); }
  }
  auto body = [&](auto pc, int kt) {
    constexpr int PAR = decltype(pc)::v;
    constexpr int NXT = PAR ^ 1;
    __syncthreads();
    if (kt + 1 < nk || hasNext) {
      bfu* As = (bfu*)(smem + NXT * 40960); bfu* Bs = As + 128 * 80;
#pragma unroll
      for (int i = 0; i < 4; ++i) {
        *(uint4*)(As + (r0 + 32 * i) * 80 + seg * 8) = gp.ra[NXT][i];
        *(uint4*)(Bs + (r0 + 32 * i) * 80 + seg * 8) = gp.rb[NXT][i];
      }
    }
    if (kt + 3 < nk) {
      const int k = (kt + 3) * 64;
#pragma unroll
      for (int i = 0; i < 4; ++i) { gp.ra[NXT][i] = aload(i, k, seg * 8); gp.rb[NXT][i] = bload(i, k, seg * 8); }
    } else if (hasNext) {
      const int k = (kt + 3 - nk) * 64;
#pragma unroll
      for (int i = 0; i < 4; ++i) { gp.ra[NXT][i] = aloadN(i, k, seg * 8); gp.rb[NXT][i] = bloadN(i, k, seg * 8); }
    } else {
      const int k = (nk - 1) * 64;
#pragma unroll
      for (int i = 0; i < 4; ++i) { gp.ra[NXT][i] = aload(i, k, seg * 8); gp.rb[NXT][i] = bload(i, k, seg * 8); }
    }
    const bfu* Ac = (const bfu*)(smem + PAR * 40960);
    mma_tile<true>(Ac, Ac + 128 * 80, wm, wn, l15, lq, acc);
  };
  for (int kt = 0; kt < nk; kt += 2) {
    body(IC<0>{}, kt);
    body(IC<1>{}, kt + 1);
  }
  epi(acc, wm, wn, l15, lq);
}

DEV bool gemm_item(int iter, int MT, int NT, int& mt, int& nt) {
  const int nl = gridDim.x >> 3;
  const int x = blockIdx.x & 7, lw = blockIdx.x >> 3;
  const int mper = MT >> 3;
  const int li = lw + iter * nl;
  if (li >= mper * NT) return false;
  const int per_group = mper * 4;
  const int g = li / per_group, r = li - g * per_group;
  mt = x * mper + (r >> 2);
  nt = g * 4 + (r & 3);
  return true;
}
DEV int xcd_item(int iter, int total, int inner) {
  const int nl = gridDim.x >> 3;
  const int x = blockIdx.x & 7, lw = blockIdx.x >> 3;
  const int outer = total / inner;
  const int chunk = (outer + 7) >> 3;
  const int o0 = x * chunk;
  int o1 = o0 + chunk; if (o1 > outer) o1 = outer;
  const int li = lw + iter * nl;
  if (o0 >= o1 || li >= (o1 - o0) * inner) return -1;
  return o0 * inner + li;
}

DEV void transpose_job(const float* __restrict__ src, bfu* __restrict__ dst, int nmat, int K, int N, int half, bfu* tl) {
  const int tk = K >> 6, tn = N >> 6;
  const int per = tk * tn, total = nmat * per;
  const int tid = my_tid();
  const int c4 = tid & 15, r = tid >> 4;
  int it = blockIdx.x;
  if (it >= total) return;
  auto tile_src = [&](int itx) -> const float* {
    const int m = itx / per, rem = itx - m * per;
    const int kt = rem / tn, nt = rem - kt * tn;
    return src + (size_t)m * K * N + (size_t)(kt * 64) * N + nt * 64;
  };
  float4 nv[4];
  {
    const float* s = tile_src(it);
#pragma unroll
    for (int i = 0; i < 4; ++i) nv[i] = *(const float4*)(s + (size_t)(r + 16 * i) * N + c4 * 4);
  }
  for (; it < total; it += gridDim.x) {
    const int m = it / per, rem = it - m * per;
    const int kt = rem / tn, nt = rem - kt * tn;
    float4 v[4];
#pragma unroll
    for (int i = 0; i < 4; ++i) v[i] = nv[i];
    {
      const float* s = tile_src(it + gridDim.x < total ? it + gridDim.x : it);
#pragma unroll
      for (int i = 0; i < 4; ++i) nv[i] = *(const float4*)(s + (size_t)(r + 16 * i) * N + c4 * 4);
    }
    __syncthreads();
#pragma unroll
    for (int i = 0; i < 4; ++i) {
      tl[(c4 * 4 + 0) * 72 + r + 16 * i] = f2bf(v[i].x);
      tl[(c4 * 4 + 1) * 72 + r + 16 * i] = f2bf(v[i].y);
      tl[(c4 * 4 + 2) * 72 + r + 16 * i] = f2bf(v[i].z);
      tl[(c4 * 4 + 3) * 72 + r + 16 * i] = f2bf(v[i].w);
    }
    __syncthreads();
    bfu* d = dst + (size_t)m * K * N;
#pragma unroll
    for (int i = 0; i < 2; ++i) {
      const int idx = tid + 256 * i, n = idx >> 3, sg = idx & 7;
      const int pn = perm_half(nt * 64 + n, half);
      *(uint4*)(d + (size_t)pn * K + kt * 64 + sg * 8) = *(const uint4*)(tl + n * 72 + sg * 8);
    }
  }
}

DEV void phase_prep(const Params& p, unsigned char* smem) {
  bfu* tl = (bfu*)smem;
  unsigned char* ws = p.ws;
  const int gtid = blockIdx.x * 256 + my_tid();
  if (gtid < 512) ((int*)(ws + S_CNT))[gtid] = 0;
  if (gtid < 512) {
    float l0 = p.lb_logits[gtid], l1 = p.lb_logits[512 + gtid], l2 = p.lb_logits[1024 + gtid];
    float m = fmaxf(l0, fmaxf(l1, l2));
    float e0 = expf(l0 - m), e1 = expf(l1 - m), e2 = expf(l2 - m);
    ((float*)(ws + S_LB))[gtid] = e0 / (e0 + e1 + e2);
  }
  if (gtid < 2048) {
    int g = gtid >> 6;
    float dt = expf(p.log_dt[g]);
    float ar = p.a_re[gtid], ai = p.a_im[gtid];
    float mag = expf(dt * ar);
    float abr = mag * cosf(dt * ai), abi = mag * sinf(dt * ai);
    float den = ar * ar + ai * ai;
    float xr = abr - 1.f, xi = abi;
    float fr = (xr * ar + xi * ai) / den, fi = (xi * ar - xr * ai) / den;
    float* ab = (float*)(ws + S_ABAR);
    ab[gtid * 2] = abr; ab[gtid * 2 + 1] = abi;
    float pr = abr, pi = abi;
#pragma unroll
    for (int i = 0; i < 6; ++i) { float nr = pr * pr - pi * pi, ni = 2.f * pr * pi; pr = nr; pi = ni; }
    float* ap = (float*)(ws + S_APOW);
    ap[gtid * 2] = pr; ap[gtid * 2 + 1] = pi;
    float* bb = (float*)(ws + S_BBAR) + (size_t)gtid * 32;
    for (int m = 0; m < 16; ++m) {
      float br = p.b_re[gtid * 16 + m], bi = p.b_im[gtid * 16 + m];
      bb[m] = fr * br - fi * bi;
      bb[16 + m] = fr * bi + fi * br;
    }
  }
  transpose_job(p.ev_w_in, (bfu*)(ws + OFF_WEVIN), 1, 1024, 2560, 0, tl);
  transpose_job(p.w_glu, (bfu*)(ws + OFF_WGLU), 1, 512, 1024, 512, tl);
  transpose_job(p.ev_w_out, (bfu*)(ws + OFF_WEVOUT), 1, 1024, 1024, 0, tl);
  transpose_job(p.od_w_in, (bfu*)(ws + OFF_WODIN), 1, 1024, 1536, 0, tl);
  transpose_job(p.od_w_out, (bfu*)(ws + OFF_WODOUT), 1, 1024, 1024, 0, tl);
  transpose_job(p.w_gate_up, (bfu*)(ws + OFF_WGU), 32, 1024, 512, 256, tl);
  transpose_job(p.w_down, (bfu*)(ws + OFF_WDN), 32, 256, 1024, 0, tl);
  {
    uint4* xb = (uint4*)(ws + OFF_XB);
    const size_t n8 = (size_t)T * 1024 / 8;
    for (size_t i = (size_t)blockIdx.x * 256 + my_tid(); i < n8; i += (size_t)gridDim.x * 256) xb[i] = ld8_f32(p.x + i * 8);
  }
}

DEV void phase_proj(const bfu* __restrict__ X, const bfu* __restrict__ Wt, bfu* __restrict__ P, int N, bfu* __restrict__ VT, int layer, unsigned char* smem) {
  const int ntn = N >> 7;
  const int total = (T >> 7) * ntn;
  const int r0 = my_tid() >> 3;
  GemmPipe gp;
  bool first = true;
  for (int it = blockIdx.x; it < total; it += gridDim.x) {
    const int mt = it / ntn, nt = it - mt * ntn;
    const int itn = it + gridDim.x;
    const bool hasNext = itn < total;
    const int itq = hasNext ? itn : it;
    const int mtn = itq / ntn, ntq = itq - mtn * ntn;
    const RowLoader al{X, (unsigned)(mt * 128 + r0) * 1024u, 32768u}, bl{Wt, (unsigned)(nt * 128 + r0) * 1024u, 32768u};
    const RowLoader aln{X, (unsigned)(mtn * 128 + r0) * 1024u, 32768u}, bln{Wt, (unsigned)(ntq * 128 + r0) * 1024u, 32768u};
    auto epi = [&](f32x4(&acc)[4][4], int wm, int wn, int l15, int lq) {
#pragma unroll
      for (int ai = 0; ai < 4; ++ai)
#pragma unroll
        for (int bi = 0; bi < 4; ++bi) {
          const int row = mt * 128 + wm * 64 + bi * 16 + l15, col = nt * 128 + wn * 64 + ai * 16 + lq * 4;
          *(uint2*)(P + (size_t)row * N + col) = make_uint2(pack2(acc[ai][bi][0], acc[ai][bi][1]), pack2(acc[ai][bi][2], acc[ai][bi][3]));
        }
    };
    const bool vt_tile = layer == 0 ? (nt >= 8 && nt <= 11) : (nt == 5 || nt == 11);
    auto epi2 = [&](f32x4(&acc)[4][4], int wm, int wn, int l15, int lq) {
      if (vt_tile) {
        bfu* Ct = (bfu*)(smem + 40960);
        __syncthreads();
#pragma unroll
        for (int ai = 0; ai < 4; ++ai)
#pragma unroll
          for (int bi = 0; bi < 4; ++bi)
#pragma unroll
            for (int j = 0; j < 4; ++j)
              Ct[(wn * 64 + ai * 16 + lq * 4 + j) * 136 + wm * 64 + bi * 16 + l15] = f2bf(acc[ai][bi][j]);
        __syncthreads();
        const int which = nt == 11 ? 1 : 0;
        const int m0 = mt * 128;
        const int b = m0 >> 14, t0 = m0 & (L - 1);
        const int tid = my_tid();
#pragma unroll
        for (int i = 0; i < 8; ++i) {
          const int idx = tid + 256 * i, n = idx >> 4, c = idx & 15;
          const size_t vrow = layer == 0 ? (size_t)((b * 4 + (nt - 8)) * 128 + n) : (size_t)(((which * 2 + b) * 2 + (n >> 6)) * 64 + (n & 63));
          *(uint4*)(VT + vrow * L + t0 + c * 8) = *(const uint4*)(Ct + n * 136 + c * 8);
        }
      } else {
        epi(acc, wm, wn, l15, lq);
      }
    };
    gemm128(true, 1024, first, hasNext, al, bl, aln, bln, epi2, gp, smem);
    first = false;
  }
}

DEV void phase_glu(const Params& p, unsigned char* smem) {
  const bfu* A = (const bfu*)(p.ws + OFF_YS5);
  const bfu* Wt = (const bfu*)(p.ws + OFF_WGLU);
  bfu* Y = (bfu*)(p.ws + OFF_Y);
  const int r0 = my_tid() >> 3;
  const int total = (T >> 7) * 8;
  GemmPipe gp;
  bool first = true;
  for (int it = blockIdx.x; it < total; it += gridDim.x) {
    const int mt = it >> 3, nt = it & 7;
    const int itn = it + gridDim.x;
    const bool hasNext = itn < total;
    const int itq = hasNext ? itn : it;
    const RowLoader al{A, (unsigned)(mt * 128 + r0) * 512u, 16384u}, bl{Wt, (unsigned)(nt * 128 + r0) * 512u, 16384u};
    const RowLoader aln{A, (unsigned)((itq >> 3) * 128 + r0) * 512u, 16384u}, bln{Wt, (unsigned)((itq & 7) * 128 + r0) * 512u, 16384u};
    auto epi = [&](f32x4(&acc)[4][4], int wm, int wn, int l15, int lq) {
      const int q = nt * 2 + wn;
#pragma unroll
      for (int ai = 0; ai < 2; ++ai)
#pragma unroll
        for (int bi = 0; bi < 4; ++bi) {
          const int row = mt * 128 + wm * 64 + bi * 16 + l15, col = q * 32 + ai * 16 + lq * 4;
          float o[4];
#pragma unroll
          for (int j = 0; j < 4; ++j) o[j] = acc[ai][bi][j] * sigm(acc[ai + 2][bi][j]);
          *(uint2*)(Y + (size_t)row * 1024 + 512 + col) = make_uint2(pack2(o[0], o[1]), pack2(o[2], o[3]));
        }
    };
    gemm128(true, 512, first, hasNext, al, bl, aln, bln, epi, gp, smem);
    first = false;
  }
}

DEV void phase_outproj(const Params& p, const bfu* __restrict__ Wt, unsigned char* smem) {
  const bfu* A = (const bfu*)(p.ws + OFF_Y);
  bfu* MIX = (bfu*)(p.ws + OFF_MIX);
  const int r0 = my_tid() >> 3;
  const int total = (T >> 7) * 8;
  GemmPipe gp;
  bool first = true;
  for (int it = blockIdx.x; it < total; it += gridDim.x) {
    const int mt = it >> 3, nt = it & 7;
    const int itn = it + gridDim.x;
    const bool hasNext = itn < total;
    const int itq = hasNext ? itn : it;
    const RowLoader al{A, (unsigned)(mt * 128 + r0) * 1024u, 32768u}, bl{Wt, (unsigned)(nt * 128 + r0) * 1024u, 32768u};
    const RowLoader aln{A, (unsigned)((itq >> 3) * 128 + r0) * 1024u, 32768u}, bln{Wt, (unsigned)((itq & 7) * 128 + r0) * 1024u, 32768u};
    auto epi = [&](f32x4(&acc)[4][4], int wm, int wn, int l15, int lq) {
#pragma unroll
      for (int ai = 0; ai < 4; ++ai)
#pragma unroll
        for (int bi = 0; bi < 4; ++bi) {
          const int row = mt * 128 + wm * 64 + bi * 16 + l15, col = nt * 128 + wn * 64 + ai * 16 + lq * 4;
          *(uint2*)(MIX + (size_t)row * 1024 + col) = make_uint2(pack2(acc[ai][bi][0], acc[ai][bi][1]), pack2(acc[ai][bi][2], acc[ai][bi][3]));
        }
    };
    gemm128(true, 1024, first, hasNext, al, bl, aln, bln, epi, gp, smem);
    first = false;
  }
}


DEV void stage_tile64x128(const bfu* __restrict__ src, int ld, bfu* dst, int ls) {
#pragma unroll
  for (int i = 0; i < 4; ++i) {
    const int idx = my_tid() + 256 * i, row = idx >> 4, sg = idx & 15;
    *(uint4*)(dst + row * ls + sg * 8) = *(const uint4*)(src + (size_t)row * ld + sg * 8);
  }
}
DEV void stage_tile64x128_T(const bfu* __restrict__ src, int ld, bfu* dst, int ls) {
#pragma unroll
  for (int i = 0; i < 4; ++i) {
    const int idx = my_tid() + 256 * i, row = idx >> 4, sg = idx & 15;
    uint4 v = *(const uint4*)(src + (size_t)row * ld + sg * 8);
    unsigned uu[4] = {v.x, v.y, v.z, v.w};
#pragma unroll
    for (int e = 0; e < 4; ++e) {
      dst[(sg * 8 + 2 * e) * ls + row] = (bfu)(uu[e] & 0xffffu);
      dst[(sg * 8 + 2 * e + 1) * ls + row] = (bfu)(uu[e] >> 16);
    }
  }
}


DEV void stage_vt(const bfu* __restrict__ vt0, int bh, int tl0, bfu* dst, int ls) {
#pragma unroll
  for (int i = 0; i < 4; ++i) {
    const int idx = my_tid() + 256 * i, v = idx >> 3, c = idx & 7;
    *(uint4*)(dst + v * ls + c * 8) = *(const uint4*)(vt0 + ((size_t)(bh * 128 + v)) * L + tl0 + c * 8);
  }
}

DEV void hgrn_dstate_item(const Params& p, int ch, unsigned char* smem) {
  const int bh = ch >> 8, n = ch & 255, b = bh >> 2, h = bh & 3;
  const size_t t0 = (size_t)b * L + (size_t)n * 64;
  const bfu* P = (const bfu*)(p.ws + OFF_P);
  bfu* As = (bfu*)smem;
  bfu* Bs = As + 128 * 80;
  bfu* Fr = Bs + 128 * 80;
  const int tid = my_tid(), k = tid & 127, half = tid >> 7;
  const float lb = ((const float*)(p.ws + S_LB))[h * 128 + k];
  __syncthreads();
  stage_tile64x128(P + t0 * 2560 + 512 + h * 128, 2560, Fr, 128);
  stage_vt((const bfu*)p.out, bh, n * 64, As, 80);
  __syncthreads();
  float* tot = (float*)(Fr + 64 * 128);
  float fv[32], cum[32];
  float run = 0.f;
#pragma unroll
  for (int i = 0; i < 32; ++i) {
    const float f = lb + (1.f - lb) * sigm(bf2f(Fr[(half * 32 + i) * 128 + k]));
    run += __logf(f);
    fv[i] = f; cum[i] = run;
  }
  tot[half * 128 + k] = run;
  __syncthreads();
  const float t0s = tot[k], t1s = tot[128 + k];
  const float btot = t0s + t1s;
  const float boff = half ? t0s : 0.f;
#pragma unroll
  for (int i = 0; i < 32; ++i) Bs[k * 80 + half * 32 + i] = f2bf((1.f - fv[i]) * __expf(btot - (boff + cum[i])));
  if (half == 0) ((float*)(p.ws + OFF_DEC))[(size_t)ch * 128 + k] = __expf(btot);
  __syncthreads();
  const int lane = tid & 63, w = tid >> 6, wm = w >> 1, wn = w & 1, l15 = lane & 15, lq = lane >> 4;
  f32x4 acc[4][4];
#pragma unroll
  for (int mi = 0; mi < 4; ++mi)
#pragma unroll
    for (int ni = 0; ni < 4; ++ni) acc[mi][ni] = f32x4{0.f, 0.f, 0.f, 0.f};
  mma_tile<true>(As, Bs, wm, wn, l15, lq, acc);
  bfu* DS = (bfu*)(p.ws + OFF_DS) + (size_t)ch * 16384;
#pragma unroll
  for (int ai = 0; ai < 4; ++ai)
#pragma unroll
    for (int bi = 0; bi < 4; ++bi) {
      const int v = wm * 64 + bi * 16 + l15, kk = wn * 64 + ai * 16 + lq * 4;
      *(uint2*)(DS + v * 128 + kk) = make_uint2(pack2(acc[ai][bi][0], acc[ai][bi][1]), pack2(acc[ai][bi][2], acc[ai][bi][3]));
    }
}

DEV void s5_load_bfrag(const Params& p, int g, int l15, int lq, uint4 (&bf)[8]) {
#pragma unroll
  for (int ni = 0; ni < 8; ++ni) {
    bf[ni] = make_uint4(0u, 0u, 0u, 0u);
    if (lq < 2) {
      const int col = ni * 16 + l15, pp = col & 63, part = col >> 6;
      const float* s = (const float*)(p.ws + S_BBAR) + (size_t)(g * 64 + pp) * 32 + part * 16 + lq * 8;
      const float4 u = ((const float4*)s)[0], v = ((const float4*)s)[1];
      bf[ni] = make_uint4(pack2(u.x, u.y), pack2(u.z, u.w), pack2(v.x, v.y), pack2(v.z, v.w));
    }
  }
}
DEV void s5_drive16(const uint4 a, const uint4 (&bf)[8], float* Dr, int l15, int lq) {
#pragma unroll
  for (int ni = 0; ni < 8; ++ni) {
    f32x4 acc = mfma16(a, bf[ni], f32x4{0.f, 0.f, 0.f, 0.f});
#pragma unroll
    for (int j = 0; j < 4; ++j) Dr[(lq * 4 + j) * 132 + ni * 16 + l15] = acc[j];
  }
}

struct S5Const { uint4 bf[8]; uint4 cf[4]; float2 ab; float dsk; };

DEV void s5_pass1_item(const Params& p, int it, const uint4 (&bf)[8], const float2 ab, unsigned char* smem) {
  const int gq = it & 7, bc = it >> 3;
  const size_t t0 = (size_t)(bc >> 8) * L + (size_t)(bc & 255) * 64;
  const int tid = my_tid(), lane = tid & 63, w = tid >> 6, l15 = lane & 15, lq = lane >> 4;
  float* Dr = (float*)smem + w * (16 * 132);
  const int g = gq * 4 + w;
  const int gp = g * 64 + lane;
  const bfu* P = (const bfu*)(p.ws + OFF_P);
  uint4 af[4];
#pragma unroll
  for (int sub = 0; sub < 4; ++sub) {
    af[sub] = make_uint4(0u, 0u, 0u, 0u);
    if (lq < 2) af[sub] = *(const uint4*)(P + (t0 + sub * 16 + l15) * 2560 + 2048 + g * 16 + lq * 8);
  }
  float hr = 0.f, hi = 0.f;
#pragma unroll
  for (int sub = 0; sub < 4; ++sub) {
    __syncthreads();
    s5_drive16(af[sub], bf, Dr, l15, lq);
    __syncthreads();
#pragma unroll 4
    for (int tt = 0; tt < 16; ++tt) {
      const float dr = Dr[tt * 132 + lane], di = Dr[tt * 132 + 64 + lane];
      const float nr = ab.x * hr - ab.y * hi + dr;
      const float ni = ab.x * hi + ab.y * hr + di;
      hr = nr; hi = ni;
    }
  }
  ((float2*)(p.ws + OFF_HEND))[(size_t)bc * 2048 + gp] = make_float2(hr, hi);
}

DEV void s5_pass2_item(const Params& p, int it, const uint4 (&bf)[8], const uint4 (&cf)[4], const float2 ab, const float dsk, unsigned char* smem) {
  const int gq = it & 7, bc = it >> 3;
  const size_t t0 = (size_t)(bc >> 8) * L + (size_t)(bc & 255) * 64;
  const int tid = my_tid(), lane = tid & 63, w = tid >> 6, l15 = lane & 15, lq = lane >> 4;
  float* Dr = (float*)smem + w * (16 * 132);
  bfu* Hs = (bfu*)(smem + 4 * 16 * 132 * 4) + w * (16 * 144);
  const int g = gq * 4 + w;
  const int gp = g * 64 + lane;
  const bfu* P = (const bfu*)(p.ws + OFF_P);
  uint4 af[4];
#pragma unroll
  for (int sub = 0; sub < 4; ++sub) {
    af[sub] = make_uint4(0u, 0u, 0u, 0u);
    if (lq < 2) af[sub] = *(const uint4*)(P + (t0 + sub * 16 + l15) * 2560 + 2048 + g * 16 + lq * 8);
  }
  float2 hc = ((const float2*)(p.ws + OFF_CARRY))[(size_t)bc * 2048 + gp];
  float hr = hc.x, hi = hc.y;
  bfu* YS = (bfu*)(p.ws + OFF_YS5);
#pragma unroll
  for (int sub = 0; sub < 4; ++sub) {
    float us[4];
#pragma unroll
    for (int j = 0; j < 4; ++j) us[j] = bf2f(P[(t0 + sub * 16 + lq * 4 + j) * 2560 + 2048 + g * 16 + l15]);
    __syncthreads();
    s5_drive16(af[sub], bf, Dr, l15, lq);
    __syncthreads();
#pragma unroll 4
    for (int tt = 0; tt < 16; ++tt) {
      const float dr = Dr[tt * 132 + lane], di = Dr[tt * 132 + 64 + lane];
      const float nr = ab.x * hr - ab.y * hi + dr;
      const float ni = ab.x * hi + ab.y * hr + di;
      hr = nr; hi = ni;
      Hs[tt * 144 + lane] = f2bf(hr);
      Hs[tt * 144 + 64 + lane] = f2bf(hi);
    }
    __syncthreads();
    f32x4 acc = f32x4{0.f, 0.f, 0.f, 0.f};
#pragma unroll
    for (int ks = 0; ks < 4; ++ks) acc = mfma16(lds128(Hs + l15 * 144 + ks * 32 + lq * 8), cf[ks], acc);
#pragma unroll
    for (int j = 0; j < 4; ++j) {
      const int t = sub * 16 + lq * 4 + j;
      const float y = acc[j] + dsk * us[j];
      YS[(t0 + t) * 512 + g * 16 + l15] = f2bf(gelu_tanh(y));
    }
  }
}


DEV void s5_load_consts(const Params& p, int g, int lane, uint4 (&bf)[8], uint4 (&cf)[4], float2& ab, float& dsk) {
  const int l15 = lane & 15, lq = lane >> 4;
  s5_load_bfrag(p, g, l15, lq, bf);
  ab = ((const float2*)(p.ws + S_ABAR))[g * 64 + lane];
#pragma unroll
  for (int ks = 0; ks < 4; ++ks) {
    const float* src = (ks < 2 ? p.c_re : p.c_im) + ((size_t)g * 16 + l15) * 64 + (ks & 1) * 32 + lq * 8;
    float4 u = ((const float4*)src)[0], v = ((const float4*)src)[1];
    float sgn = ks < 2 ? 1.f : -1.f;
    cf[ks] = make_uint4(pack2(sgn * u.x, sgn * u.y), pack2(sgn * u.z, sgn * u.w), pack2(sgn * v.x, sgn * v.y), pack2(sgn * v.z, sgn * v.w));
  }
  dsk = p.s5_d[g * 16 + l15];
}

DEV void hgrn_scan_item(const Params& p, int it) {
  const int bh = it >> 3, vs = it & 7;
  const int tid = my_tid(), v = vs * 16 + (tid >> 4), k8 = tid & 15;
  const bfu* DS = (const bfu*)(p.ws + OFF_DS);
  bfu* SP = (bfu*)(p.ws + OFF_SP);
  const float* DEC = (const float*)(p.ws + OFF_DEC);
  float S[8];
#pragma unroll
  for (int i = 0; i < 8; ++i) S[i] = 0.f;
  uint4 dsr[8];
  float4 dca[8], dcb[8];
  const size_t base0 = ((size_t)(bh * 256) * 128 + v) * 128 + k8 * 8;
  const size_t dbase0 = (size_t)(bh * 256) * 128 + k8 * 8;
#pragma unroll
  for (int s = 0; s < 8; ++s) {
    dsr[s] = *(const uint4*)(DS + base0 + (size_t)s * 16384);
    dca[s] = *(const float4*)(DEC + dbase0 + (size_t)s * 128);
    dcb[s] = *(const float4*)(DEC + dbase0 + (size_t)s * 128 + 4);
  }
  for (int n0 = 0; n0 < 256; n0 += 8) {
#pragma unroll
    for (int s = 0; s < 8; ++s) {
      const int n = n0 + s;
      *(uint4*)(SP + base0 + (size_t)n * 16384) = make_uint4(pack2(S[0], S[1]), pack2(S[2], S[3]), pack2(S[4], S[5]), pack2(S[6], S[7]));
      const uint4 d = dsr[s];
      const float4 a = dca[s], c = dcb[s];
      S[0] = a.x * S[0] + __uint_as_float(d.x << 16); S[1] = a.y * S[1] + __uint_as_float(d.x & 0xffff0000u);
      S[2] = a.z * S[2] + __uint_as_float(d.y << 16); S[3] = a.w * S[3] + __uint_as_float(d.y & 0xffff0000u);
      S[4] = c.x * S[4] + __uint_as_float(d.z << 16); S[5] = c.y * S[5] + __uint_as_float(d.z & 0xffff0000u);
      S[6] = c.z * S[6] + __uint_as_float(d.w << 16); S[7] = c.w * S[7] + __uint_as_float(d.w & 0xffff0000u);
      if (n + 8 < 256) {
        dsr[s] = *(const uint4*)(DS + base0 + (size_t)(n + 8) * 16384);
        dca[s] = *(const float4*)(DEC + dbase0 + (size_t)(n + 8) * 128);
        dcb[s] = *(const float4*)(DEC + dbase0 + (size_t)(n + 8) * 128 + 4);
      }
    }
  }
}

DEV void s5_carry_item(const Params& p, int it) {
  const int id = it * 256 + my_tid();
  const int b = id >> 11, gp = id & 2047;
  const float2 ap = ((const float2*)(p.ws + S_APOW))[gp];
  const float2* HE = (const float2*)(p.ws + OFF_HEND) + (size_t)b * 256 * 2048 + gp;
  float2* CA = (float2*)(p.ws + OFF_CARRY) + (size_t)b * 256 * 2048 + gp;
  float cr = 0.f, ci = 0.f;
  float2 ring[8];
#pragma unroll
  for (int s = 0; s < 8; ++s) ring[s] = HE[(size_t)s * 2048];
  for (int c0 = 0; c0 < 256; c0 += 8) {
#pragma unroll
    for (int s = 0; s < 8; ++s) {
      const int c = c0 + s;
      CA[(size_t)c * 2048] = make_float2(cr, ci);
      float nr = ap.x * cr - ap.y * ci + ring[s].x;
      float ni = ap.x * ci + ap.y * cr + ring[s].y;
      cr = nr; ci = ni;
      if (c + 8 < 256) ring[s] = HE[(size_t)(c + 8) * 2048];
    }
  }
}

DEV void hgrn_out_item(const Params& p, int ch, unsigned char* smem) {
  const int bh = ch >> 8, n = ch & 255, b = bh >> 2, h = bh & 3;
  const size_t t0 = (size_t)b * L + (size_t)n * 64;
  const bfu* P = (const bfu*)(p.ws + OFF_P);
  bfu* Qs = (bfu*)smem;
  bfu* RB = Qs + 64 * 144;
  bfu* Ks = RB;
  bfu* ATT = RB;
  bfu* Vt = RB + 64 * 80;
  bfu* St = RB;
  bfu* Fr = RB + 64 * 144;
  float* tot = (float*)(Fr + 64 * 128);
  bfu* Gs = (bfu*)(smem + 55296);
  const int tid = my_tid(), lane = tid & 63, w = tid >> 6, l15 = lane & 15, lq = lane >> 4;
  uint4 rq0, rq1, rq2, rq3, rf0, rf1, rf2, rf3, rv0, rv1, rv2, rv3, rg0, rg1, rg2, rg3, rs0, rs1, rs2, rs3, rs4, rs5, rs6, rs7;
  {
    const bfu* qsrc = P + t0 * 2560 + h * 128;
    const bfu* vt0 = (const bfu*)p.out;
    const bfu* SPc = (const bfu*)(p.ws + OFF_SP) + (size_t)ch * 16384;
#define HG_LD(i) { const int idx = tid + 256 * i, row = idx >> 4, sg = idx & 15; \
      rq##i = *(const uint4*)(qsrc + (size_t)row * 2560 + sg * 8); \
      rf##i = *(const uint4*)(qsrc + 512 + (size_t)row * 2560 + sg * 8); \
      rg##i = *(const uint4*)(qsrc + 1536 + (size_t)row * 2560 + sg * 8); \
      const int v = idx >> 3, c = idx & 7; \
      rv##i = *(const uint4*)(vt0 + ((size_t)(bh * 128 + v)) * L + n * 64 + c * 8); }
    HG_LD(0) HG_LD(1) HG_LD(2) HG_LD(3)
#undef HG_LD
#define HG_LS(i) { const int idx = tid + 256 * i, v = idx >> 4, sg = idx & 15; rs##i = *(const uint4*)(SPc + v * 128 + sg * 8); }
    HG_LS(0) HG_LS(1) HG_LS(2) HG_LS(3) HG_LS(4) HG_LS(5) HG_LS(6) HG_LS(7)
#undef HG_LS
  }
  float ng[8];
#pragma unroll
  for (int ni = 0; ni < 8; ++ni) ng[ni] = p.ev_a_norm[h * 128 + ni * 16 + l15];
  __syncthreads();
#define HG_ST(i) { const int idx = tid + 256 * i, row = idx >> 4, sg = idx & 15; \
    *(uint4*)(Qs + row * 144 + sg * 8) = rq##i; *(uint4*)(Fr + row * 128 + sg * 8) = rf##i; *(uint4*)(Gs + row * 144 + sg * 8) = rg##i; }
  HG_ST(0) HG_ST(1) HG_ST(2) HG_ST(3)
#undef HG_ST
  __syncthreads();
  {
    const int k = tid & 127, half = tid >> 7;
    const float lb = ((const float*)(p.ws + S_LB))[h * 128 + k];
    float fv[32], cum[32];
    float run = 0.f;
#pragma unroll
    for (int i = 0; i < 32; ++i) {
      const float f = lb + (1.f - lb) * sigm(bf2f(Fr[(half * 32 + i) * 128 + k]));
      run += __logf(f);
      fv[i] = f; cum[i] = run;
    }
    tot[half * 128 + k] = run;
    __syncthreads();
    const float boff = half ? tot[k] : 0.f;
#pragma unroll
    for (int i = 0; i < 32; ++i) {
      const int s = half * 32 + i;
      const float eb = __expf(boff + cum[i]);
      const float q = siluf(bf2f(Qs[s * 144 + k]));
      Qs[s * 144 + k] = f2bf(q * eb);
      Ks[s * 144 + k] = f2bf((1.f - fv[i]) * frcp(eb));
    }
  }
  __syncthreads();
  f32x4 at[4];
#pragma unroll
  for (int ni = 0; ni < 4; ++ni) at[ni] = f32x4{0.f, 0.f, 0.f, 0.f};
#pragma unroll
  for (int ks = 0; ks < 4; ++ks) {
    uint4 a = lds128(Qs + (16 * w + l15) * 144 + ks * 32 + lq * 8);
#pragma unroll
    for (int ni = 0; ni < 4; ++ni) at[ni] = mfma16(a, lds128(Ks + (ni * 16 + l15) * 144 + ks * 32 + lq * 8), at[ni]);
  }
  __syncthreads();
#pragma unroll
  for (int ni = 0; ni < 4; ++ni)
#pragma unroll
    for (int j = 0; j < 4; ++j) {
      int c = 16 * w + lq * 4 + j, s = ni * 16 + l15;
      ATT[c * 80 + s] = f2bf(s <= c ? at[ni][j] : 0.f);
    }
#define HG_SV(i) { const int idx = tid + 256 * i, v = idx >> 3, c = idx & 7; *(uint4*)(Vt + v * 80 + c * 8) = rv##i; }
  HG_SV(0) HG_SV(1) HG_SV(2) HG_SV(3)
#undef HG_SV
  __syncthreads();
  f32x4 o[8];
#pragma unroll
  for (int ni = 0; ni < 8; ++ni) o[ni] = f32x4{0.f, 0.f, 0.f, 0.f};
#pragma unroll
  for (int ks = 0; ks < 2; ++ks) {
    uint4 a = lds128(ATT + (16 * w + l15) * 80 + ks * 32 + lq * 8);
#pragma unroll
    for (int ni = 0; ni < 8; ++ni) o[ni] = mfma16(a, lds128(Vt + (ni * 16 + l15) * 80 + ks * 32 + lq * 8), o[ni]);
  }
  __syncthreads();
#define HG_SS(i) { const int idx = tid + 256 * i, v = idx >> 4, sg = idx & 15; *(uint4*)(St + v * 144 + sg * 8) = rs##i; }
  HG_SS(0) HG_SS(1) HG_SS(2) HG_SS(3) HG_SS(4) HG_SS(5) HG_SS(6) HG_SS(7)
#undef HG_SS
  __syncthreads();
#pragma unroll
  for (int ks = 0; ks < 4; ++ks) {
    uint4 a = lds128(Qs + (16 * w + l15) * 144 + ks * 32 + lq * 8);
#pragma unroll
    for (int ni = 0; ni < 8; ++ni) o[ni] = mfma16(a, lds128(St + (ni * 16 + l15) * 144 + ks * 32 + lq * 8), o[ni]);
  }
#pragma unroll
  for (int j = 0; j < 4; ++j) {
    float ss = 0.f;
#pragma unroll
    for (int ni = 0; ni < 8; ++ni) ss += o[ni][j] * o[ni][j];
    ss = sum16(ss);
    const float rsn = rsqrtf(ss * (1.f / 128.f) + 1e-6f);
    const int c = 16 * w + lq * 4 + j;
#pragma unroll
    for (int ni = 0; ni < 8; ++ni) {
      const int v = ni * 16 + l15;
      const float gate = bf2f(Gs[c * 144 + v]);
      Gs[c * 144 + v] = f2bf(o[ni][j] * rsn * ng[ni] * siluf(gate));
    }
  }
  __syncthreads();
  bfu* Y = (bfu*)(p.ws + OFF_Y);
#pragma unroll
  for (int i = 0; i < 4; ++i) {
    const int idx = tid + 256 * i, row = idx >> 4, sg = idx & 15;
    *(uint4*)(Y + (t0 + row) * 1024 + h * 128 + sg * 8) = *(const uint4*)(Gs + row * 144 + sg * 8);
  }
}

DEV void phase_ln1_router(const Params& p, const float* __restrict__ Xin, int layer, unsigned char* smem) {
  const bfu* MIX = (const bfu*)(p.ws + OFF_MIX);
  float* X1 = (float*)(p.ws + OFF_X1);
  bfu* X1b = (bfu*)(p.ws + OFF_X1B);
  const float* g1 = p.ln1_g + layer * 1024;
  const float* b1 = p.ln1_b + layer * 1024;
  const float* wg = p.w_group + (size_t)layer * 1024 * 4;
  const float* we = p.w_expert + (size_t)layer * 1024 * 16;
  const float* bg = p.b_group + layer * 4;
  const float* be = p.b_expert + layer * 16;
  float* tokw = (float*)(p.ws + S_TOKW);
  int* list = (int*)(p.ws + S_LIST);
  int* gcnt = (int*)(p.ws + S_CNT) + layer * 32;
  float* Wes = (float*)smem;
  int* tokb = (int*)(smem + 65536);
  int* lcnt = tokb + 64;
  int* lbase = lcnt + 32;
  int* lpos = lbase + 32;
  const int tid = my_tid(), lane = tid & 63, w = tid >> 6;
  __syncthreads();
  {
    float4 wv[16];
#pragma unroll
    for (int i = 0; i < 16; ++i) wv[i] = *(const float4*)(we + (size_t)(tid + 256 * i) * 4);
#pragma unroll
    for (int i = 0; i < 16; ++i) {
      const int idx = tid + 256 * i, d = idx >> 2, c4 = idx & 3;
      Wes[(c4 * 4 + 0) * 1024 + d] = wv[i].x; Wes[(c4 * 4 + 1) * 1024 + d] = wv[i].y;
      Wes[(c4 * 4 + 2) * 1024 + d] = wv[i].z; Wes[(c4 * 4 + 3) * 1024 + d] = wv[i].w;
    }
  }
  __syncthreads();
  for (int it = blockIdx.x; it < T / 64; it += gridDim.x) {
    const int tb = it * 64;
    __syncthreads();
    if (tid < 24) lcnt[tid] = 0;
    float4 nxa[4]; uint2 nxm[4];
    {
      const size_t tn = (size_t)tb + w * 16;
#pragma unroll
      for (int i = 0; i < 4; ++i) {
        nxa[i] = *(const float4*)(Xin + tn * 1024 + i * 256 + lane * 4);
        nxm[i] = *(const uint2*)(MIX + tn * 1024 + i * 256 + lane * 4);
      }
    }
    for (int tk = 0; tk < 16; ++tk) {
      const size_t t = (size_t)tb + w * 16 + tk;
      float4 cxa[4]; uint2 cxm[4];
#pragma unroll
      for (int i = 0; i < 4; ++i) { cxa[i] = nxa[i]; cxm[i] = nxm[i]; }
      {
        const size_t tn = (size_t)tb + w * 16 + (tk < 15 ? tk + 1 : 15);
#pragma unroll
        for (int i = 0; i < 4; ++i) {
          nxa[i] = *(const float4*)(Xin + tn * 1024 + i * 256 + lane * 4);
          nxm[i] = *(const uint2*)(MIX + tn * 1024 + i * 256 + lane * 4);
        }
      }
      float xv[16];
      float s = 0.f;
#pragma unroll
      for (int i = 0; i < 4; ++i) {
        const float4 a = cxa[i];
        const float4 m = make_float4(__uint_as_float(cxm[i].x << 16), __uint_as_float(cxm[i].x & 0xffff0000u), __uint_as_float(cxm[i].y << 16), __uint_as_float(cxm[i].y & 0xffff0000u));
        xv[4 * i] = ALPHA * a.x + m.x; xv[4 * i + 1] = ALPHA * a.y + m.y;
        xv[4 * i + 2] = ALPHA * a.z + m.z; xv[4 * i + 3] = ALPHA * a.w + m.w;
        s += xv[4 * i] + xv[4 * i + 1] + xv[4 * i + 2] + xv[4 * i + 3];
      }
      const float mu = wave_sum(s) * (1.f / 1024.f);
      float vs = 0.f;
#pragma unroll
      for (int e = 0; e < 16; ++e) { float d = xv[e] - mu; vs += d * d; }
      const float rstd = rsqrtf(wave_sum(vs) * (1.f / 1024.f) + 1e-5f);
      float acc[20];
#pragma unroll
      for (int c = 0; c < 20; ++c) acc[c] = 0.f;
#pragma unroll
      for (int i = 0; i < 4; ++i) {
        float4 gg = *(const float4*)(g1 + i * 256 + lane * 4);
        float4 bb = *(const float4*)(b1 + i * 256 + lane * 4);
        const float o0 = (xv[4 * i] - mu) * rstd * gg.x + bb.x;
        const float o1 = (xv[4 * i + 1] - mu) * rstd * gg.y + bb.y;
        const float o2 = (xv[4 * i + 2] - mu) * rstd * gg.z + bb.z;
        const float o3 = (xv[4 * i + 3] - mu) * rstd * gg.w + bb.w;
        *(uint2*)(X1b + t * 1024 + i * 256 + lane * 4) = make_uint2(pack2(o0, o1), pack2(o2, o3));
#pragma unroll
        for (int c = 0; c < 16; ++c) {
          float4 wv = *(const float4*)(Wes + c * 1024 + i * 256 + lane * 4);
          acc[4 + c] += o0 * wv.x + o1 * wv.y + o2 * wv.z + o3 * wv.w;
        }
        const float* wgp = wg + (size_t)(i * 256 + lane * 4) * 4;
        float4 q0 = *(const float4*)(wgp), q1 = *(const float4*)(wgp + 4), q2 = *(const float4*)(wgp + 8), q3 = *(const float4*)(wgp + 12);
        acc[0] += o0 * q0.x + o1 * q1.x + o2 * q2.x + o3 * q3.x;
        acc[1] += o0 * q0.y + o1 * q1.y + o2 * q2.y + o3 * q3.y;
        acc[2] += o0 * q0.z + o1 * q1.z + o2 * q2.z + o3 * q3.z;
        acc[3] += o0 * q0.w + o1 * q1.w + o2 * q2.w + o3 * q3.w;
      }
#pragma unroll
      for (int c = 0; c < 20; ++c) acc[c] = wave_sum(acc[c]);
      float lg[4];
#pragma unroll
      for (int c = 0; c < 4; ++c) lg[c] = acc[c] + bg[c];
      int gi = 0; float gm = lg[0];
#pragma unroll
      for (int c = 1; c < 4; ++c) if (lg[c] > gm) { gm = lg[c]; gi = c; }
      float gs = 0.f;
#pragma unroll
      for (int c = 0; c < 4; ++c) gs += __expf(lg[c] - gm);
      const float gtop = 1.f / gs;
      float ev[4] = {0.f, 0.f, 0.f, 0.f};
#pragma unroll
      for (int gg = 0; gg < 4; ++gg)
#pragma unroll
        for (int c = 0; c < 4; ++c) if (gi == gg) ev[c] = acc[4 + gg * 4 + c] + be[gg * 4 + c];
      int i1 = 0; float v1 = ev[0];
#pragma unroll
      for (int c = 1; c < 4; ++c) if (ev[c] > v1) { v1 = ev[c]; i1 = c; }
      int i2 = -1; float v2 = -3e38f;
#pragma unroll
      for (int c = 0; c < 4; ++c) if (c != i1 && ev[c] > v2) { v2 = ev[c]; i2 = c; }
      const float ex = __expf(v2 - v1);
      const float w1 = gtop / (1.f + ex), w2 = gtop * ex / (1.f + ex);
      const int lo = min(i1, i2), hi = max(i1, i2);
      const float wlo = (i1 < i2) ? w1 : w2, whi = (i1 < i2) ? w2 : w1;
      const int pi = (lo == 0) ? (hi - 1) : ((lo == 1) ? (hi + 1) : 5);
      if (lane == 0) {
        const int tl = w * 16 + tk;
        tokb[tl] = gi * 6 + pi;
        tokw[(size_t)(tb + tl) * 2] = wlo;
        tokw[(size_t)(tb + tl) * 2 + 1] = whi;
      }
    }
    __syncthreads();
    int myb = 0;
    if (tid < 64) { myb = tokb[tid]; lpos[tid] = atomicAdd(&lcnt[myb], 1); }
    __syncthreads();
    if (tid < 24) { int c = lcnt[tid]; lbase[tid] = c ? atomicAdd(&gcnt[tid], c) : 0; }
    __syncthreads();
    if (tid < 64) list[(size_t)myb * T + lbase[myb] + lpos[tid]] = tb + tid;
  }
}

struct MoeTile { int bk, r0, cnt, srow0, elo, ehi; };
DEV int moe_total_tiles(const int* gcnt) {
  int tot = 0;
  for (int b = 0; b < 24; ++b) tot += (gcnt[b] + 127) >> 7;
  return tot;
}
DEV MoeTile moe_find(const int* gcnt, int tile) {
  MoeTile r; int acc = 0, srow = 0; r.bk = 0; r.r0 = 0; r.cnt = 0; r.srow0 = 0;
  for (int b = 0; b < 24; ++b) {
    int c = gcnt[b]; int nt = (c + 127) >> 7;
    if (tile >= acc && tile < acc + nt) { r.bk = b; r.r0 = (tile - acc) * 128; r.cnt = c; r.srow0 = srow; }
    acc += nt; srow += c;
  }
  int g = r.bk / 6, pi = r.bk - g * 6;
  int lo = (pi < 3) ? 0 : ((pi < 5) ? 1 : 2);
  int hi = (pi < 3) ? pi + 1 : ((pi < 5) ? pi - 1 : 3);
  r.elo = g * 4 + lo; r.ehi = g * 4 + hi;
  return r;
}

DEV void phase_moe1(const Params& p, int layer, unsigned char* smem) {
  const int* gcnt = (const int*)(p.ws + S_CNT) + layer * 32;
  const int* list = (const int*)(p.ws + S_LIST);
  const float* tokw = (const float*)(p.ws + S_TOKW);
  const bfu* X1b = (const bfu*)(p.ws + OFF_X1B);
  const bfu* Wgu = (const bfu*)(p.ws + OFF_WGU) + (size_t)layer * 16 * 512 * 1024;
  bfu* H = (bfu*)(p.ws + OFF_H);
  const int total = moe_total_tiles(gcnt) * 8;
  const int r0 = my_tid() >> 3;
  auto mkA = [&](const MoeTile& mt) {
    GatherLoader g;
    g.base = X1b;
#pragma unroll
    for (int i = 0; i < 4; ++i) {
      const int r = mt.r0 + r0 + 32 * i;
      const int tok = list[(size_t)mt.bk * T + (r < mt.cnt ? r : 0)];
      g.off[i] = (unsigned)tok * 1024u;
    }
    return g;
  };
  auto mkB = [&](const MoeTile& mt, int nt) {
    const int ex = (nt < 4) ? mt.elo : mt.ehi;
    return RowLoader{Wgu, (unsigned)(ex * 512 + (nt & 3) * 128 + r0) * 1024u, 32768u};
  };
  GemmPipe gp;
  bool first = true;
  int it = blockIdx.x;
  if (it >= total) return;
  MoeTile mt = moe_find(gcnt, it >> 3);
  GatherLoader al = mkA(mt);
  RowLoader bl = mkB(mt, it & 7);
  for (;;) {
    const int nt = it & 7;
    const int itn = it + gridDim.x;
    const bool hasNext = itn < total;
    const int itq = hasNext ? itn : it;
    const MoeTile mtn = moe_find(gcnt, itq >> 3);
    const GatherLoader aln = mkA(mtn);
    const RowLoader bln = mkB(mtn, itq & 7);
    auto epi = [&](f32x4(&acc)[4][4], int wm, int wn, int l15, int lq) {
      const int q = (nt & 3) * 2 + wn;
#pragma unroll
      for (int bi = 0; bi < 4; ++bi) {
        const int r = mt.r0 + wm * 64 + bi * 16 + l15;
        if (r < mt.cnt) {
          const int tok = list[(size_t)mt.bk * T + r];
          const float gw = tokw[(size_t)tok * 2 + (nt >> 2)];
#pragma unroll
          for (int ai = 0; ai < 2; ++ai) {
            float o[4];
#pragma unroll
            for (int j = 0; j < 4; ++j) o[j] = siluf(acc[ai][bi][j]) * acc[ai + 2][bi][j] * gw;
            *(uint2*)(H + (size_t)(mt.srow0 + r) * 512 + (nt >> 2) * 256 + q * 32 + ai * 16 + lq * 4) =
                make_uint2(pack2(o[0], o[1]), pack2(o[2], o[3]));
          }
        }
      }
    };
    gemm128(true, 1024, first, hasNext, al, bl, aln, bln, epi, gp, smem);
    first = false;
    if (!hasNext) break;
    it = itn; mt = mtn; al = aln; bl = bln;
  }
}

DEV void phase_moe2(const Params& p, int layer, unsigned char* smem) {
  const int* gcnt = (const int*)(p.ws + S_CNT) + layer * 32;
  const int* list = (const int*)(p.ws + S_LIST);
  const bfu* H = (const bfu*)(p.ws + OFF_H);
  const bfu* Wdn = (const bfu*)(p.ws + OFF_WDN) + (size_t)layer * 16 * 1024 * 256;
  bfu* FF = (bfu*)(p.ws + OFF_MIX);
  const int total = moe_total_tiles(gcnt) * 8;
  const int r0 = my_tid() >> 3;
  auto mkA = [&](const MoeTile& mt) { return RowLoader{H, (unsigned)(mt.srow0 + mt.r0 + r0) * 512u, 16384u}; };
  auto mkB = [&](const MoeTile& mt, int nt) {
    return SplitKLoader{Wdn, (unsigned)(mt.elo * 1024 + nt * 128 + r0) * 256u, (unsigned)((mt.ehi - mt.elo) * 1024) * 256u};
  };
  GemmPipe gp;
  bool first = true;
  int it = blockIdx.x;
  if (it >= total) return;
  MoeTile mt = moe_find(gcnt, it >> 3);
  RowLoader al = mkA(mt);
  SplitKLoader bl = mkB(mt, it & 7);
  for (;;) {
    const int nt = it & 7;
    const int itn = it + gridDim.x;
    const bool hasNext = itn < total;
    const int itq = hasNext ? itn : it;
    const MoeTile mtn = moe_find(gcnt, itq >> 3);
    const RowLoader aln = mkA(mtn);
    const SplitKLoader bln = mkB(mtn, itq & 7);
    auto epi = [&](f32x4(&acc)[4][4], int wm, int wn, int l15, int lq) {
#pragma unroll
      for (int bi = 0; bi < 4; ++bi) {
        const int r = mt.r0 + wm * 64 + bi * 16 + l15;
        if (r < mt.cnt) {
          const int tok = list[(size_t)mt.bk * T + r];
#pragma unroll
          for (int ai = 0; ai < 4; ++ai)
            *(uint2*)(FF + (size_t)tok * 1024 + nt * 128 + wn * 64 + ai * 16 + lq * 4) =
                make_uint2(pack2(acc[ai][bi][0], acc[ai][bi][1]), pack2(acc[ai][bi][2], acc[ai][bi][3]));
        }
      }
    };
    gemm128(true, 512, first, hasNext, al, bl, aln, bln, epi, gp, smem);
    first = false;
    if (!hasNext) break;
    it = itn; mt = mtn; al = aln; bl = bln;
  }
}

DEV void phase_ln2(const Params& p, int layer, float* __restrict__ outp, bfu* __restrict__ outb) {
  const bfu* X1b = (const bfu*)(p.ws + OFF_X1B);
  const bfu* FF = (const bfu*)(p.ws + OFF_MIX);
  const float* g2 = p.ln2_g + layer * 1024;
  const float* b2 = p.ln2_b + layer * 1024;
  const int lane = my_tid() & 63, w = my_tid() >> 6;
  const int stride = gridDim.x * 4;
  int t = blockIdx.x * 4 + w;
  if (t >= T) return;
  uint2 nxa[4]; uint2 nxm[4];
#pragma unroll
  for (int i = 0; i < 4; ++i) {
    nxa[i] = *(const uint2*)(X1b + (size_t)t * 1024 + i * 256 + lane * 4);
    nxm[i] = *(const uint2*)(FF + (size_t)t * 1024 + i * 256 + lane * 4);
  }
  for (; t < T; t += stride) {
    uint2 cxa[4]; uint2 cxm[4];
#pragma unroll
    for (int i = 0; i < 4; ++i) { cxa[i] = nxa[i]; cxm[i] = nxm[i]; }
    {
      const int tn = (t + stride < T) ? t + stride : t;
#pragma unroll
      for (int i = 0; i < 4; ++i) {
        nxa[i] = *(const uint2*)(X1b + (size_t)tn * 1024 + i * 256 + lane * 4);
        nxm[i] = *(const uint2*)(FF + (size_t)tn * 1024 + i * 256 + lane * 4);
      }
    }
    float xv[16];
    float s = 0.f;
#pragma unroll
    for (int i = 0; i < 4; ++i) {
      const uint2 ab_ = cxa[i];
      const float4 a = make_float4(__uint_as_float(ab_.x << 16), __uint_as_float(ab_.x & 0xffff0000u), __uint_as_float(ab_.y << 16), __uint_as_float(ab_.y & 0xffff0000u));
      const uint2 mb = cxm[i];
      const float4 m = make_float4(__uint_as_float(mb.x << 16), __uint_as_float(mb.x & 0xffff0000u), __uint_as_float(mb.y << 16), __uint_as_float(mb.y & 0xffff0000u));
      xv[4 * i] = ALPHA * a.x + m.x; xv[4 * i + 1] = ALPHA * a.y + m.y;
      xv[4 * i + 2] = ALPHA * a.z + m.z; xv[4 * i + 3] = ALPHA * a.w + m.w;
      s += xv[4 * i] + xv[4 * i + 1] + xv[4 * i + 2] + xv[4 * i + 3];
    }
    const float mu = wave_sum(s) * (1.f / 1024.f);
    float vs = 0.f;
#pragma unroll
    for (int e = 0; e < 16; ++e) { float d = xv[e] - mu; vs += d * d; }
    const float rstd = rsqrtf(wave_sum(vs) * (1.f / 1024.f) + 1e-5f);
#pragma unroll
    for (int i = 0; i < 4; ++i) {
      float4 gg = *(const float4*)(g2 + i * 256 + lane * 4);
      float4 bb = *(const float4*)(b2 + i * 256 + lane * 4);
      const float o0 = (xv[4 * i] - mu) * rstd * gg.x + bb.x, o1 = (xv[4 * i + 1] - mu) * rstd * gg.y + bb.y;
      const float o2 = (xv[4 * i + 2] - mu) * rstd * gg.z + bb.z, o3 = (xv[4 * i + 3] - mu) * rstd * gg.w + bb.w;
      *(float4*)(outp + (size_t)t * 1024 + i * 256 + lane * 4) = make_float4(o0, o1, o2, o3);
      if (outb) *(uint2*)(outb + (size_t)t * 1024 + i * 256 + lane * 4) = make_uint2(pack2(o0, o1), pack2(o2, o3));
    }
  }
}

template <int NK, bool SINK, typename KP, typename VP, typename MK, typename OUT>
DEV void attn_core(const bfu* qptr, KP kptr, VP vptr, MK maskf, float sink, OUT outf, unsigned char* smem) {
  constexpr int NT = NK / 16;
  constexpr int VS = NK + 16;
  constexpr int KS = 80;
  bfu* Ks = (bfu*)smem;
  bfu* Ps = Ks;
  bfu* Vt = Ks + NK * KS;
  const int tid = my_tid(), lane = tid & 63, w = tid >> 6, l15 = lane & 15, lq = lane >> 4;
  uint4 k0, k1, k2, k3, k4, k5, k6, k7, v0, v1, v2, v3, v4, v5, v6, v7;
#define ATT_LD(i) if constexpr (i < NK / 32) { const int idx = tid + 256 * i; const int kk = idx >> 3, sg = idx & 7; \
    k##i = *(const uint4*)(kptr(kk) + sg * 8); const int d = idx / (NK / 8), k8 = idx - d * (NK / 8); v##i = *(const uint4*)(vptr(d, k8)); }
  ATT_LD(0) ATT_LD(1) ATT_LD(2) ATT_LD(3) ATT_LD(4) ATT_LD(5) ATT_LD(6) ATT_LD(7)
#undef ATT_LD
  const uint4 qf0 = *(const uint4*)(qptr + lq * 8), qf1 = *(const uint4*)(qptr + 32 + lq * 8);
  __syncthreads();
#define ATT_ST(i) if constexpr (i < NK / 32) { const int idx = tid + 256 * i; const int kk = idx >> 3, sg = idx & 7; \
    *(uint4*)(Ks + kk * KS + sg * 8) = k##i; const int d = idx / (NK / 8), k8 = idx - d * (NK / 8); *(uint4*)(Vt + d * VS + k8 * 8) = v##i; }
  ATT_ST(0) ATT_ST(1) ATT_ST(2) ATT_ST(3) ATT_ST(4) ATT_ST(5) ATT_ST(6) ATT_ST(7)
#undef ATT_ST
  __syncthreads();
  f32x4 s[NT];
#pragma unroll
  for (int ni = 0; ni < NT; ++ni) {
    f32x4 a = f32x4{0.f, 0.f, 0.f, 0.f};
    a = mfma16(lds128(Ks + (ni * 16 + l15) * KS + lq * 8), qf0, a);
    a = mfma16(lds128(Ks + (ni * 16 + l15) * KS + 32 + lq * 8), qf1, a);
    s[ni] = a;
  }
  const int row = 16 * w + l15;
  float mx = NEGF;
#pragma unroll
  for (int ni = 0; ni < NT; ++ni)
#pragma unroll
    for (int j = 0; j < 4; ++j) {
      const int kk = ni * 16 + lq * 4 + j;
      float v = maskf(row, kk) ? s[ni][j] * 0.125f : NEGF;
      s[ni][j] = v;
      mx = fmaxf(mx, v);
    }
  mx = fmaxf(mx, __shfl_xor(mx, 16));
  mx = fmaxf(mx, __shfl_xor(mx, 32));
  if (SINK) mx = fmaxf(mx, sink);
  float ls = 0.f;
#pragma unroll
  for (int ni = 0; ni < NT; ++ni)
#pragma unroll
    for (int j = 0; j < 4; ++j) {
      float pv = __expf(s[ni][j] - mx);
      ls += pv;
      s[ni][j] = pv;
    }
  ls += __shfl_xor(ls, 16);
  ls += __shfl_xor(ls, 32);
  if (SINK) ls += __expf(sink - mx);
  __syncthreads();
#pragma unroll
  for (int ni = 0; ni < NT; ++ni)
    *(uint2*)(Ps + row * VS + ni * 16 + lq * 4) = make_uint2(pack2(s[ni][0], s[ni][1]), pack2(s[ni][2], s[ni][3]));
  __syncthreads();
  f32x4 o[4];
#pragma unroll
  for (int ni = 0; ni < 4; ++ni) o[ni] = f32x4{0.f, 0.f, 0.f, 0.f};
#pragma unroll
  for (int ks = 0; ks < NK / 32; ++ks) {
    uint4 pb = lds128(Ps + row * VS + ks * 32 + lq * 8);
#pragma unroll
    for (int ni = 0; ni < 4; ++ni) o[ni] = mfma16(lds128(Vt + (ni * 16 + l15) * VS + ks * 32 + lq * 8), pb, o[ni]);
  }
#pragma unroll
  for (int ni = 0; ni < 4; ++ni) outf(row, ni * 16 + lq * 4, o[ni], mx, ls);
}

DEV void swa_item(const Params& p, int it, unsigned char* smem) {
  const int h = it & 7, qt = (it >> 3) & 255, b = it >> 11;
  const int hk = h >> 2;
  const int t0 = qt * 64, kstart = t0 - 128;
  const bfu* P = (const bfu*)(p.ws + OFF_P);
  bfu* Y = (bfu*)(p.ws + OFF_Y);
  const int lane = my_tid() & 63, w = my_tid() >> 6, l15 = lane & 15;
  const bfu* qptr = P + ((size_t)b * L + t0 + 16 * w + l15) * 1536 + h * 64;
  const bfu* kb = P + (size_t)b * L * 1536 + 512 + hk * 64;
  auto kptr = [&](int kk) -> const bfu* { int pos = kstart + kk; pos = pos < 0 ? 0 : pos; return kb + (size_t)pos * 1536; };
  const bfu* vtb = (const bfu*)(p.ws + OFF_VT) + (size_t)((0 * 2 + b) * 2 + hk) * 64 * L;
  auto vptr = [&](int d, int k8) -> const bfu* { int pos = kstart + k8 * 8; pos = pos < 0 ? 0 : pos; return vtb + (size_t)d * L + pos; };
  auto maskf = [&](int row, int kk) -> bool { int pos = kstart + kk, t = t0 + row; return pos >= 0 && pos <= t && (t - pos) < 128; };
  auto outf = [&](int row, int d0, f32x4 o, float m, float l) {
    const float inv = 1.f / l;
    *(uint2*)(Y + ((size_t)b * L + t0 + row) * 1024 + h * 64 + d0) = make_uint2(pack2(o[0] * inv, o[1] * inv), pack2(o[2] * inv, o[3] * inv));
  };
  attn_core<192, true>(qptr, kptr, vptr, maskf, p.od_sinks[h], outf, smem);
}

DEV void kmean_item(const Params& p, int it, unsigned char* smem) {
  const int j = it & 63, bhk = it >> 6, b = bhk >> 1, hk = bhk & 1;
  const bfu* P = (const bfu*)(p.ws + OFF_P);
  float* red = (float*)smem;
  const int tid = my_tid(), d = tid & 63, part = tid >> 6;
  const bfu* kb = P + ((size_t)b * L + j * 256 + part * 64) * 1536 + 1280 + hk * 64 + d;
  float s = 0.f;
  for (int i = 0; i < 64; ++i) s += bf2f(kb[(size_t)i * 1536]);
  __syncthreads();
  red[part * 64 + d] = s;
  __syncthreads();
  if (tid < 64) {
    float tot = red[tid] + red[64 + tid] + red[128 + tid] + red[192 + tid];
    ((bfu*)(p.ws + S_KMEAN))[(size_t)it * 64 + tid] = f2bf(tot * (1.f / 256.f));
  }
}

DEV int cap_off(int j) { return 1024 * (63 * j - (j * (j - 1)) / 2); }

DEV void moba_own_item(const Params& p, int it, unsigned char* smem) {
  const int h = it & 7, o4 = (it >> 3) & 3, c = (it >> 5) & 63, b = it >> 11;
  const int hk = h >> 2, g = h & 3;
  const int t0 = c * 256 + o4 * 64;
  const bfu* P = (const bfu*)(p.ws + OFF_P);
  bfu* PO = (bfu*)(p.ws + OFF_PO);
  float* PM = (float*)(p.ws + OFF_PM);
  float* PL = (float*)(p.ws + OFF_PL);
  const int tid = my_tid(), lane = tid & 63, w = tid >> 6, l15 = lane & 15, lq = lane >> 4;
  const bfu* qptr = P + ((size_t)b * L + t0 + 16 * w + l15) * 1536 + 768 + h * 64;
  const bfu* kb = P + ((size_t)b * L + c * 256) * 1536 + 1280 + hk * 64;
  auto kptr = [&](int kk) -> const bfu* { return kb + (size_t)kk * 1536; };
  const bfu* vtb = (const bfu*)(p.ws + OFF_VT) + (size_t)((1 * 2 + b) * 2 + hk) * 64 * L + c * 256;
  auto vptr = [&](int d, int k8) -> const bfu* { return vtb + (size_t)d * L + k8 * 8; };
  auto maskf = [&](int row, int kk) -> bool { return kk <= o4 * 64 + row; };
  auto outf = [&](int row, int d0, f32x4 o, float m, float l) {
    const size_t idx = (((size_t)b * L + t0 + row) * 8 + h) * 4;
    const float inv = 1.f / l;
    *(uint2*)(PO + idx * 64 + d0) = make_uint2(pack2(o[0] * inv, o[1] * inv), pack2(o[2] * inv, o[3] * inv));
    if (d0 == 0) { PM[idx] = m; PL[idx] = l; }
  };
  attn_core<256, false>(qptr, kptr, vptr, maskf, 0.f, outf, smem);
  int* lcnt = (int*)(smem + SM_AUX);
  int* lbase = lcnt + 64;
  int* sel = lbase + 64;
  if (tid < 64) lcnt[tid] = 0;
  __syncthreads();
  const uint4 qf0 = *(const uint4*)(qptr + lq * 8), qf1 = *(const uint4*)(qptr + 32 + lq * 8);
  const bfu* km = (const bfu*)(p.ws + S_KMEAN) + (size_t)(b * 2 + hk) * 64 * 64;
  float cand[4][4];
#pragma unroll
  for (int ni = 0; ni < 4; ++ni) {
    f32x4 a = f32x4{0.f, 0.f, 0.f, 0.f};
    a = mfma16(qf0, *(const uint4*)(km + (ni * 16 + l15) * 64 + lq * 8), a);
    a = mfma16(qf1, *(const uint4*)(km + (ni * 16 + l15) * 64 + 32 + lq * 8), a);
#pragma unroll
    for (int j = 0; j < 4; ++j) cand[ni][j] = (ni * 16 + l15 < c) ? a[j] : -3e38f;
  }
#pragma unroll
  for (int j = 0; j < 4; ++j) {
    const int row = 16 * w + lq * 4 + j;
#pragma unroll
    for (int sl = 0; sl < 3; ++sl) {
      float bv = cand[0][j]; int bi = l15;
#pragma unroll
      for (int ni = 1; ni < 4; ++ni) if (cand[ni][j] > bv) { bv = cand[ni][j]; bi = ni * 16 + l15; }
#pragma unroll
      for (int off = 8; off >= 1; off >>= 1) {
        float ov = __shfl_xor(bv, off); int oi = __shfl_xor(bi, off);
        if (ov > bv || (ov == bv && oi < bi)) { bv = ov; bi = oi; }
      }
      const bool valid = bv > -1e38f;
#pragma unroll
      for (int ni = 0; ni < 4; ++ni) if (ni * 16 + l15 == bi) cand[ni][j] = -3e38f;
      if (l15 == 0) {
        const size_t idx = (((size_t)b * L + t0 + row) * 8 + h) * 4 + 1 + sl;
        if (valid) {
          int lp = atomicAdd(&lcnt[bi], 1);
          sel[row * 3 + sl] = bi | (lp << 8);
        } else {
          sel[row * 3 + sl] = -1;
          PM[idx] = NEGF; PL[idx] = 0.f;
        }
      }
    }
  }
  __syncthreads();
  int* gcnt = (int*)(p.ws + S_CNT) + 64 + (b * 2 + hk) * 64;
  if (tid < 64) { int cc = lcnt[tid]; lbase[tid] = cc ? atomicAdd(&gcnt[tid], cc) : 0; }
  __syncthreads();
  if (tid < 192) {
    const int row = tid / 3, sl = tid - row * 3;
    const int sv = sel[tid];
    if (sv >= 0) {
      const int bi = sv & 255, lp = sv >> 8;
      int* bucket = (int*)(p.ws + OFF_BUCK) + (size_t)(b * 2 + hk) * BUCK_PER_BH + cap_off(bi);
      bucket[lbase[bi] + lp] = ((t0 + row) << 4) | (g << 2) | (sl + 1);
    }
  }
}

DEV void phase_moba_bucket(const Params& p, unsigned char* smem) {
  int* pref = (int*)(smem + SM_AUX);
  const int* gcnt = (const int*)(p.ws + S_CNT) + 64;
  const int tid = my_tid(), lane = tid & 63, w = tid >> 6, l15 = lane & 15;
  {
    int nt = (gcnt[tid] + 63) >> 6;
    __syncthreads();
    pref[tid] = nt;
    __syncthreads();
    for (int off = 1; off < 256; off <<= 1) {
      int v = pref[tid];
      if (tid >= off) v += pref[tid - off];
      __syncthreads();
      pref[tid] = v;
      __syncthreads();
    }
  }
  const int total = pref[255];
  const bfu* P = (const bfu*)(p.ws + OFF_P);
  bfu* PO = (bfu*)(p.ws + OFF_PO);
  float* PM = (float*)(p.ws + OFF_PM);
  float* PL = (float*)(p.ws + OFF_PL);
  const int lq = lane >> 4;
  struct Item { int bk, cnt, rbase; };
  auto decode = [&](int it) -> Item {
    int lo = 0, hi = 255;
    while (lo < hi) { int mid = (lo + hi) >> 1; if (pref[mid] > it) hi = mid; else lo = mid + 1; }
    Item r; r.bk = lo; r.cnt = gcnt[lo];
    const int ntb = (r.cnt + 63) >> 6;
    r.rbase = (it - (pref[lo] - ntb)) * 64;
    return r;
  };
  auto bucket_of = [&](int bk) -> const int* {
    return (const int*)(p.ws + OFF_BUCK) + (size_t)(bk >> 6) * BUCK_PER_BH + cap_off(bk & 63);
  };
  auto load_entries = [&](const Item& im, int& e, int (&en)[4]) {
    const int* bucket = bucket_of(im.bk);
    const int rr = im.rbase + 16 * w + l15;
    e = bucket[rr < im.cnt ? rr : 0];
#pragma unroll
    for (int j = 0; j < 4; ++j) { const int r = im.rbase + 16 * w + lq * 4 + j; en[j] = bucket[r < im.cnt ? r : 0]; }
  };
  int it = blockIdx.x;
  if (it >= total) return;
  Item cur = decode(it);
  int e, en[4];
  load_entries(cur, e, en);
  for (;;) {
    const int itn = it + gridDim.x;
    const bool hasNext = itn < total;
    Item nxt = cur; int e2 = e, en2[4] = {en[0], en[1], en[2], en[3]};
    if (hasNext) { nxt = decode(itn); load_entries(nxt, e2, en2); }
    const int bk = cur.bk, cnt = cur.cnt, rbase = cur.rbase;
    const int j = bk & 63, bhk = bk >> 6, b = bhk >> 1, hk = bhk & 1;
    const bfu* qptr = P + ((size_t)b * L + (e >> 4)) * 1536 + 768 + (hk * 4 + ((e >> 2) & 3)) * 64;
    const bfu* kb = P + ((size_t)b * L + j * 256) * 1536 + 1280 + hk * 64;
    auto kptr = [&](int kk) -> const bfu* { return kb + (size_t)kk * 1536; };
    const bfu* vtb = (const bfu*)(p.ws + OFF_VT) + (size_t)((1 * 2 + b) * 2 + hk) * 64 * L + j * 256;
    auto vptr = [&](int d, int k8) -> const bfu* { return vtb + (size_t)d * L + k8 * 8; };
    auto maskf = [&](int row, int kk) -> bool { return true; };
    auto outf = [&](int row, int d0, f32x4 o, float m, float l) {
      if (rbase + row < cnt) {
        const size_t idx = (((size_t)b * L + (e >> 4)) * 8 + hk * 4 + ((e >> 2) & 3)) * 4 + (e & 3);
        const float inv = 1.f / l;
        *(uint2*)(PO + idx * 64 + d0) = make_uint2(pack2(o[0] * inv, o[1] * inv), pack2(o[2] * inv, o[3] * inv));
        if (d0 == 0) { PM[idx] = m; PL[idx] = l; }
      }
    };
    attn_core<256, false>(qptr, kptr, vptr, maskf, 0.f, outf, smem);
    if (!hasNext) break;
    it = itn; cur = nxt; e = e2;
#pragma unroll
    for (int q = 0; q < 4; ++q) en[q] = en2[q];
  }
}

DEV void phase_moba_merge(const Params& p) {
  const bfu* PO = (const bfu*)(p.ws + OFF_PO);
  const float* PM = (const float*)(p.ws + OFF_PM);
  const float* PL = (const float*)(p.ws + OFF_PL);
  bfu* Y = (bfu*)(p.ws + OFF_Y);
  const size_t total = (size_t)T * 8 * 8;
  for (size_t id = (size_t)blockIdx.x * 256 + my_tid(); id < total; id += (size_t)gridDim.x * 256) {
    const int ds = (int)(id & 7);
    const size_t th = id >> 3;
    const float4 m4 = *(const float4*)(PM + th * 4);
    const float4 l4 = *(const float4*)(PL + th * 4);
    float mm[4] = {m4.x, m4.y, m4.z, m4.w}, ll[4] = {l4.x, l4.y, l4.z, l4.w};
    float M = mm[0];
#pragma unroll
    for (int s = 1; s < 4; ++s) if (ll[s] > 0.f) M = fmaxf(M, mm[s]);
    float wsum = 0.f;
    float acc[8] = {0.f, 0.f, 0.f, 0.f, 0.f, 0.f, 0.f, 0.f};
#pragma unroll
    for (int s = 0; s < 4; ++s) {
      if (s == 0 || ll[s] > 0.f) {
        const float wgt = ll[s] * __expf(mm[s] - M);
        wsum += wgt;
        uint4 ov = *(const uint4*)(PO + (th * 4 + s) * 64 + ds * 8);
        unsigned uu[4] = {ov.x, ov.y, ov.z, ov.w};
#pragma unroll
        for (int e = 0; e < 4; ++e) {
          acc[2 * e] += wgt * __uint_as_float(uu[e] << 16);
          acc[2 * e + 1] += wgt * __uint_as_float(uu[e] & 0xffff0000u);
        }
      }
    }
    const float inv = 1.f / wsum;
    const size_t t = th >> 3; const int h = (int)(th & 7);
    *(uint4*)(Y + t * 1024 + 512 + h * 64 + ds * 8) =
        make_uint4(pack2(acc[0] * inv, acc[1] * inv), pack2(acc[2] * inv, acc[3] * inv),
                   pack2(acc[4] * inv, acc[5] * inv), pack2(acc[6] * inv, acc[7] * inv));
  }
}


#define XB_TMO      128
#define XB_XCNT(j)  (256  + 64 * (j))
#define XB_XSUB(j)  (1280 + 64 * (j))
#define XB_XGEN(j)  (2304 + 64 * (j))
#define XB_TOP      3328
#define XB_TOPGEN   3392
#define XCD_BAR_WORDS 3456
#define XB_SPIN_CAP (1u << 22)
#define LAS __attribute__((address_space(3)))
DEV unsigned xb_ld(unsigned* p) { return __hip_atomic_load(p, __ATOMIC_RELAXED, __HIP_MEMORY_SCOPE_AGENT); }
DEV unsigned xb_add(unsigned* p, unsigned v) { return __hip_atomic_fetch_add(p, v, __ATOMIC_RELAXED, __HIP_MEMORY_SCOPE_AGENT); }
DEV unsigned xb_xcc_id() { return (unsigned)__builtin_amdgcn_s_getreg((3 << 11) | 20) & 0xFu; }
#define XB_SPIN(cond, bar) do { unsigned _sp = 0; while (cond) { __builtin_amdgcn_s_sleep(1); \
    if ((++_sp & 255u) == 0u) { if (xb_ld(&(bar)[XB_TMO])) break; if (_sp > XB_SPIN_CAP) { atomicAdd(&(bar)[XB_TMO], 1u); break; } } } } while (0)
struct XcdBarrier { unsigned* bar; unsigned x; volatile LAS unsigned* st; };
DEV XcdBarrier xcd_barrier_post(unsigned* bar, volatile LAS unsigned* st) {
  XcdBarrier b; b.bar = bar; b.x = xb_xcc_id(); b.st = st;
  if (threadIdx.x == 0) (void)xb_add(&bar[XB_XCNT(b.x)], 1u);
  return b;
}
DEV void xcd_barrier_complete(unsigned* bar, unsigned x, unsigned& nloc, unsigned& nx) {
  const unsigned G = gridDim.x * gridDim.y * gridDim.z;
  unsigned sum, cnt, mine, sp = 0u;
  for (;;) {
    sum = 0u; cnt = 0u; mine = 0u;
#pragma unroll
    for (unsigned j = 0; j < 16; ++j) { const unsigned c = xb_ld(&bar[XB_XCNT(j)]); sum += c; cnt += (c > 0u) ? 1u : 0u; mine = (j == x) ? c : mine; }
    if (sum == G) break;
    __builtin_amdgcn_s_sleep(1);
    if ((++sp & 255u) == 0u) { if (xb_ld(&bar[XB_TMO])) break; if (sp > XB_SPIN_CAP) { atomicAdd(&bar[XB_TMO], 1u); break; } }
  }
  nloc = mine > 0u ? mine : 1u; nx = cnt > 0u ? cnt : 1u;
}
DEV void xcd_barrier(const XcdBarrier& b) {
  asm volatile("s_waitcnt vmcnt(0)" ::: "memory");
  __syncthreads();
  if (threadIdx.x == 0) {
    unsigned* bar = b.bar;
    __builtin_amdgcn_s_waitcnt(0);
    unsigned nloc = b.st[0], nx = b.st[1];
    if (nloc == 0u) { xcd_barrier_complete(bar, b.x, nloc, nx); b.st[0] = nloc; b.st[1] = nx; }
    const unsigned old = xb_add(&bar[XB_XSUB(b.x)], 1u);
    const unsigned gen = old / nloc;
    if (old + 1u == (gen + 1u) * nloc) {
      __builtin_amdgcn_fence(__ATOMIC_RELEASE, "agent");
      asm volatile("s_waitcnt vmcnt(0)" ::: "memory");
      const unsigned og = xb_add(&bar[XB_TOP], 1u);
      const unsigned tg = og / nx;
      if (og + 1u == (tg + 1u) * nx) xb_add(&bar[XB_TOPGEN], 1u);
      else XB_SPIN(xb_ld(&bar[XB_TOPGEN]) == tg, bar);
      __builtin_amdgcn_fence(__ATOMIC_ACQUIRE, "agent");
      xb_add(&bar[XB_XGEN(b.x)], 1u);
      asm volatile("s_waitcnt vmcnt(0)" ::: "memory");
    } else {
      XB_SPIN(xb_ld(&bar[XB_XGEN(b.x)]) == gen, bar);
      __builtin_amdgcn_fence(__ATOMIC_ACQUIRE, "agent");
      asm volatile("s_waitcnt vmcnt(0)" ::: "memory");
    }
  }
  __syncthreads();
}

__global__ void __launch_bounds__(256, 2) mega(Params p) {
  __shared__ __attribute__((aligned(16))) unsigned char smem[SMEM_BYTES];
  cg::grid_group grid = cg::this_grid();
  unsigned char* ws = p.ws;
  unsigned* barw = (unsigned*)(ws + S_BAR);
  volatile LAS unsigned* xbst = (volatile LAS unsigned*)(smem + SMEM_BYTES - 16);
  if (threadIdx.x == 0) { xbst[0] = 0u; xbst[1] = 0u; }
  if (blockIdx.x == 0) for (int i = threadIdx.x; i < XCD_BAR_WORDS; i += 256) barw[i] = 0u;

#if XSYNC
  for (int i = 0; i < 20; ++i) grid.sync();
#endif
  phase_prep(p, smem);
#if (DUPMASK >> 0) & 1
  grid.sync();
  phase_prep(p, smem);
#endif
  grid.sync();
  XcdBarrier xb = xcd_barrier_post(barw, xbst);
  phase_proj((const bfu*)(ws + OFF_XB), (const bfu*)(ws + OFF_WEVIN), (bfu*)(ws + OFF_P), 2560, (bfu*)p.out, 0, smem);
#if (DUPMASK >> 1) & 1
  GSYNC;
  phase_proj((const bfu*)(ws + OFF_XB), (const bfu*)(ws + OFF_WEVIN), (bfu*)(ws + OFF_P), 2560, (bfu*)p.out, 0, smem);
#endif
  GSYNC;
  for (int it = blockIdx.x; it < 2048; it += gridDim.x) hgrn_dstate_item(p, it, smem);
  {
    uint4 bf[8], cf[4]; float2 ab; float dsk;
    s5_load_consts(p, (blockIdx.x & 7) * 4 + (my_tid() >> 6), my_tid() & 63, bf, cf, ab, dsk);
    for (int it = blockIdx.x; it < 4096; it += gridDim.x) s5_pass1_item(p, it, bf, ab, smem);
  }
#if (DUPMASK >> 2) & 1
  GSYNC;
  for (int it = blockIdx.x; it < 2048; it += gridDim.x) hgrn_dstate_item(p, it, smem);
  {
    uint4 bf[8], cf[4]; float2 ab; float dsk;
    s5_load_consts(p, (blockIdx.x & 7) * 4 + (my_tid() >> 6), my_tid() & 63, bf, cf, ab, dsk);
    for (int it = blockIdx.x; it < 4096; it += gridDim.x) s5_pass1_item(p, it, bf, ab, smem);
  }
#endif
  GSYNC;
  if (blockIdx.x < 64) hgrn_scan_item(p, blockIdx.x);
  else if (blockIdx.x < 80) s5_carry_item(p, blockIdx.x - 64);
#if (DUPMASK >> 3) & 1
  GSYNC;
  if (blockIdx.x < 64) hgrn_scan_item(p, blockIdx.x);
  else if (blockIdx.x < 80) s5_carry_item(p, blockIdx.x - 64);
#endif
  GSYNC;
  for (int it = blockIdx.x; it < 2048; it += gridDim.x) hgrn_out_item(p, it, smem);
  {
    uint4 bf[8], cf[4]; float2 ab; float dsk;
    s5_load_consts(p, (blockIdx.x & 7) * 4 + (my_tid() >> 6), my_tid() & 63, bf, cf, ab, dsk);
    for (int it = blockIdx.x; it < 4096; it += gridDim.x) s5_pass2_item(p, it, bf, cf, ab, dsk, smem);
  }
#if (DUPMASK >> 4) & 1
  GSYNC;
  for (int it = blockIdx.x; it < 2048; it += gridDim.x) hgrn_out_item(p, it, smem);
  {
    uint4 bf[8], cf[4]; float2 ab; float dsk;
    s5_load_consts(p, (blockIdx.x & 7) * 4 + (my_tid() >> 6), my_tid() & 63, bf, cf, ab, dsk);
    for (int it = blockIdx.x; it < 4096; it += gridDim.x) s5_pass2_item(p, it, bf, cf, ab, dsk, smem);
  }
#endif
  GSYNC;
  phase_glu(p, smem);
#if (DUPMASK >> 5) & 1
  GSYNC;
  phase_glu(p, smem);
#endif
  GSYNC;
  phase_outproj(p, (const bfu*)(ws + OFF_WEVOUT), smem);
#if (DUPMASK >> 6) & 1
  GSYNC;
  phase_outproj(p, (const bfu*)(ws + OFF_WEVOUT), smem);
#endif
  GSYNC;
  phase_ln1_router(p, p.x, 0, smem);
#if (DUPMASK >> 7) & 1
  GSYNC;
  if (blockIdx.x == 0 && my_tid() < 24) ((int*)(ws + S_CNT))[my_tid()] = 0;
  GSYNC;
  phase_ln1_router(p, p.x, 0, smem);
#endif
  GSYNC;
  phase_moe1(p, 0, smem);
#if (DUPMASK >> 8) & 1
  GSYNC;
  phase_moe1(p, 0, smem);
#endif
  GSYNC;
  phase_moe2(p, 0, smem);
#if (DUPMASK >> 9) & 1
  GSYNC;
  phase_moe2(p, 0, smem);
#endif
  GSYNC;
  phase_ln2(p, 0, p.out, (bfu*)(ws + OFF_X2B));
#if (DUPMASK >> 10) & 1
  GSYNC;
  phase_ln2(p, 0, p.out, (bfu*)(ws + OFF_X2B));
#endif
  GSYNC;
  phase_proj((const bfu*)(ws + OFF_X2B), (const bfu*)(ws + OFF_WODIN), (bfu*)(ws + OFF_P), 1536, (bfu*)(ws + OFF_VT), 1, smem);
#if (DUPMASK >> 11) & 1
  GSYNC;
  phase_proj((const bfu*)(ws + OFF_X2B), (const bfu*)(ws + OFF_WODIN), (bfu*)(ws + OFF_P), 1536, (bfu*)(ws + OFF_VT), 1, smem);
#endif
  GSYNC;
  for (int it = blockIdx.x; it < 4096 + 256; it += gridDim.x) {
    if (it < 4096) swa_item(p, it, smem); else kmean_item(p, it - 4096, smem);
  }
#if (DUPMASK >> 12) & 1
  GSYNC;
  for (int it = blockIdx.x; it < 4096 + 256; it += gridDim.x) {
    if (it < 4096) swa_item(p, it, smem); else kmean_item(p, it - 4096, smem);
  }
#endif
  GSYNC;
  for (int it = blockIdx.x; it < 4096; it += gridDim.x) moba_own_item(p, it, smem);
#if (DUPMASK >> 13) & 1
  GSYNC;
  if (blockIdx.x == 0) ((int*)(ws + S_CNT))[64 + my_tid()] = 0;
  GSYNC;
  for (int it = blockIdx.x; it < 4096; it += gridDim.x) moba_own_item(p, it, smem);
#endif
  GSYNC;
  phase_moba_bucket(p, smem);
#if (DUPMASK >> 14) & 1
  GSYNC;
  phase_moba_bucket(p, smem);
#endif
  GSYNC;
  phase_moba_merge(p);
#if (DUPMASK >> 15) & 1
  GSYNC;
  phase_moba_merge(p);
#endif
  GSYNC;
  phase_outproj(p, (const bfu*)(ws + OFF_WODOUT), smem);
#if (DUPMASK >> 16) & 1
  GSYNC;
  phase_outproj(p, (const bfu*)(ws + OFF_WODOUT), smem);
#endif
  GSYNC;
  phase_ln1_router(p, p.out, 1, smem);
#if (DUPMASK >> 17) & 1
  GSYNC;
  phase_ln1_router(p, p.out, 1, smem);
#endif
  GSYNC;
  phase_moe1(p, 1, smem);
#if (DUPMASK >> 18) & 1
  GSYNC;
  phase_moe1(p, 1, smem);
#endif
  GSYNC;
  phase_moe2(p, 1, smem);
#if (DUPMASK >> 19) & 1
  GSYNC;
  phase_moe2(p, 1, smem);
#endif
  GSYNC;
  phase_ln2(p, 1, p.out, (bfu*)nullptr);
#if (DUPMASK >> 20) & 1
  GSYNC;
  phase_ln2(p, 1, p.out, (bfu*)nullptr);
#endif
}

extern "C" void kernel_launch(void* const* d_in, const int* in_sizes, int n_in, void* d_out, int out_size, void* d_ws,
                              size_t ws_size, hipStream_t stream) {
  static int grid_blocks = 0;
  if (!grid_blocks) {
    int dev = 0, cus = 0, per_cu = 0;
    hipGetDevice(&dev);
    hipDeviceGetAttribute(&cus, hipDeviceAttributeMultiprocessorCount, dev);
    hipOccupancyMaxActiveBlocksPerMultiprocessor(&per_cu, mega, 256, 0);
    if (per_cu < 1) per_cu = 1;
    if (per_cu > 2) per_cu = 2;
    grid_blocks = (cus * per_cu) & ~7;
    if (ws_size < WS_NEED) fprintf(stderr, "workspace too small: %zu < %zu\n", ws_size, (size_t)WS_NEED);
  }
  Params p{};
  const float** f = (const float**)&p;
  for (int i = 0; i < 27; ++i) f[i] = (const float*)d_in[i];
  p.out = (float*)d_out;
  p.ws = (unsigned char*)d_ws;
  void* args[] = {&p};
  hipError_t e = hipLaunchCooperativeKernel((void*)mega, dim3(grid_blocks), dim3(256), args, 0, stream);
  if (e != hipSuccess) fprintf(stderr, "cooperative launch failed: %s (grid %d)\n", hipGetErrorString(e), grid_blocks);
}
```

```cpp
#ifndef DUPMASK
#define DUPMASK 0
#endif
#ifndef GX
#define GX 0
#endif
#ifndef XSYNC
#define XSYNC 0
#endif
#define GSYNC xcd_barrier(xb)
#include <hip/hip_runtime.h>
#include <hip/hip_cooperative_groups.h>
#include <cstdio>
namespace cg = cooperative_groups;

typedef unsigned short bfu;
typedef __attribute__((ext_vector_type(8))) short bf16x8;
typedef __attribute__((ext_vector_type(4))) float f32x4;
typedef __attribute__((ext_vector_type(2))) float f32x2;

#define DEV __device__ __forceinline__

constexpr int T = 32768, L = 16384;
constexpr float ALPHA = 1.41421356237309515f;
constexpr float NEGF = -1e30f;

constexpr size_t MiB = 1u << 20;
constexpr size_t OFF_WEVIN = 0;
constexpr size_t OFF_WGLU = OFF_WEVIN + 5 * MiB;
constexpr size_t OFF_WEVOUT = OFF_WGLU + 1 * MiB;
constexpr size_t OFF_WODIN = OFF_WEVOUT + 2 * MiB;
constexpr size_t OFF_WODOUT = OFF_WODIN + 3 * MiB;
constexpr size_t OFF_WGU = OFF_WODOUT + 2 * MiB;
constexpr size_t OFF_WDN = OFF_WGU + 32 * MiB;
constexpr size_t OFF_SMALL = OFF_WDN + 16 * MiB;
constexpr size_t OFF_P = OFF_SMALL + 8 * MiB;
constexpr size_t OFF_A = OFF_P + 160 * MiB;
constexpr size_t OFF_X1 = OFF_A + 128 * MiB;
constexpr size_t WS_NEED = OFF_X1 + 128 * MiB;
constexpr size_t S_CNT = OFF_SMALL;
constexpr size_t S_LB = OFF_SMALL + 4096;
constexpr size_t S_ABAR = OFF_SMALL + 8192;
constexpr size_t S_APOW = OFF_SMALL + 24576;
constexpr size_t S_BBAR = OFF_SMALL + 40960;
constexpr size_t S_KMEAN = OFF_SMALL + 303104;
constexpr size_t S_TOKW = OFF_SMALL + 524288;
constexpr size_t S_LIST = OFF_SMALL + 1 * MiB;
constexpr size_t S_BAR = OFF_SMALL + 4 * MiB;
constexpr size_t OFF_BUCK = OFF_P + 96 * MiB;
constexpr size_t OFF_X1B = OFF_P;
constexpr size_t OFF_H = OFF_P + 64 * MiB;
constexpr size_t OFF_X2B = OFF_P + 96 * MiB;
constexpr size_t OFF_XB = OFF_A;
constexpr size_t OFF_DS = OFF_A;
constexpr size_t OFF_SP = OFF_A + 64 * MiB;
constexpr size_t OFF_MIX = OFF_A;
constexpr size_t OFF_PO = OFF_A;
constexpr size_t OFF_YS5 = OFF_X1;
constexpr size_t OFF_Y = OFF_X1 + 32 * MiB;
constexpr size_t OFF_HEND = OFF_X1 + 96 * MiB;
constexpr size_t OFF_CARRY = OFF_X1 + 104 * MiB;
constexpr size_t OFF_DEC = OFF_X1 + 112 * MiB;
constexpr size_t OFF_VT = OFF_X1;
constexpr size_t OFF_PM = OFF_X1 + 96 * MiB;
constexpr size_t OFF_PL = OFF_X1 + 100 * MiB;

constexpr int SMEM_BYTES = 80 * 1024;
constexpr int SM_AUX = 75 * 1024;
constexpr int BUCK_PER_BH = 2016 * 1024;

struct Params {
  const float *x, *lb_logits, *ev_w_in, *ev_a_norm, *a_re, *a_im, *log_dt, *b_re, *b_im, *c_re, *c_im, *s5_d,
      *w_glu, *ev_w_out, *od_w_in, *od_sinks, *od_w_out, *ln1_g, *ln1_b, *w_group, *b_group, *w_expert, *b_expert,
      *w_gate_up, *w_down, *ln2_g, *ln2_b;
  float* out;
  unsigned char* ws;
};

DEV int my_tid() { int t = threadIdx.x; asm volatile("" : "+v"(t)); return t; }
typedef __attribute__((ext_vector_type(2))) __bf16 bf16x2_t;
typedef __attribute__((ext_vector_type(2))) float f32x2c;
DEV bfu f2bf(float f) { __bf16 h = (__bf16)f; return __builtin_bit_cast(bfu, h); }
DEV float bf2f(bfu h) { return __uint_as_float(((unsigned)h) << 16); }
DEV unsigned pack2(float a, float b) { f32x2c v = {a, b}; bf16x2_t r = __builtin_convertvector(v, bf16x2_t); return __builtin_bit_cast(unsigned, r); }
DEV float frcp(float x) { return __builtin_amdgcn_rcpf(x); }
DEV float sigm(float x) { return frcp(1.f + __expf(-x)); }
DEV float siluf(float x) { return x * frcp(1.f + __expf(-x)); }
DEV float gelu_tanh(float x) {
  float u = 1.5957691216057308f * (x + 0.044715f * x * x * x);
  return x * frcp(1.f + __expf(-u));
}
DEV f32x4 mfma16(uint4 a, uint4 b, f32x4 c) {
  return __builtin_amdgcn_mfma_f32_16x16x32_bf16(__builtin_bit_cast(bf16x8, a), __builtin_bit_cast(bf16x8, b), c, 0, 0, 0);
}
DEV uint4 lds128(const bfu* p) { return *(const uint4*)p; }
template <int CTRL> DEV float dpp_f(float v) {
  return __int_as_float(__builtin_amdgcn_update_dpp(0, __float_as_int(v), CTRL, 0xF, 0xF, false));
}
DEV float sum16(float v) {
  v += dpp_f<0xB1>(v);
  v += dpp_f<0x4E>(v);
  v += dpp_f<0x141>(v);
  v += dpp_f<0x140>(v);
  return v;
}
DEV float wave_sum(float v) {
  v = sum16(v);
  const int iv = __float_as_int(v);
  const float s0 = __int_as_float(__builtin_amdgcn_readlane(iv, 0)), s1 = __int_as_float(__builtin_amdgcn_readlane(iv, 16));
  const float s2 = __int_as_float(__builtin_amdgcn_readlane(iv, 32)), s3 = __int_as_float(__builtin_amdgcn_readlane(iv, 48));
  return (s0 + s1) + (s2 + s3);
}
DEV float max16(float v) {
  v = fmaxf(v, __shfl_xor(v, 8)); v = fmaxf(v, __shfl_xor(v, 4));
  v = fmaxf(v, __shfl_xor(v, 2)); v = fmaxf(v, __shfl_xor(v, 1));
  return v;
}
DEV uint4 ld8_f32(const float* p) {
  float4 u = ((const float4*)p)[0], v = ((const float4*)p)[1];
  return make_uint4(pack2(u.x, u.y), pack2(u.z, u.w), pack2(v.x, v.y), pack2(v.z, v.w));
}
DEV uint4 ld8_bf(const bfu* p) { return *(const uint4*)p; }
DEV int perm_half(int c, int half) {
  if (half == 0) return c;
  int hi = c >= half ? 1 : 0;
  int cc = hi ? c - half : c;
  return (cc >> 5) * 64 + hi * 32 + (cc & 31);
}

template <bool SWAP>
DEV void mma_tile(const bfu* As, const bfu* Bs, int wm, int wn, int l15, int lq, f32x4 (&acc)[4][4]) {
#pragma unroll
  for (int ks = 0; ks < 2; ++ks) {
    uint4 af[4], bfr[4];
#pragma unroll
    for (int i = 0; i < 4; ++i) {
      af[i] = lds128(As + (wm * 64 + i * 16 + l15) * 80 + ks * 32 + lq * 8);
      bfr[i] = lds128(Bs + (wn * 64 + i * 16 + l15) * 80 + ks * 32 + lq * 8);
    }
#pragma unroll
    for (int i1 = 0; i1 < 4; ++i1)
#pragma unroll
      for (int i2 = 0; i2 < 4; ++i2)
        acc[i1][i2] = SWAP ? mfma16(bfr[i1], af[i2], acc[i1][i2]) : mfma16(af[i1], bfr[i2], acc[i1][i2]);
    if (ks == 0) __builtin_amdgcn_sched_barrier(0);
  }
}

template <int N> struct IC { static constexpr int v = N; };
template <int I, int N, typename F> DEV void static_for(F&& f) { if constexpr (I < N) { f(IC<I>{}); static_for<I + 1, N>(f); } }

DEV uint4 ld8_at(const bfu* base, unsigned o) { asm volatile("" : "+v"(o)); return ld8_bf(base + o); }
struct RowLoader {
  const bfu* base; unsigned off; unsigned stride32;
  DEV uint4 operator()(int i, int kb, int so) const { return ld8_at(base, off + (unsigned)i * stride32 + (unsigned)kb + (unsigned)so); }
};
struct GatherLoader {
  const bfu* base; unsigned off[4];
  DEV uint4 operator()(int i, int kb, int so) const { return ld8_at(base, off[i] + (unsigned)kb + (unsigned)so); }
};
struct SplitKLoader {
  const bfu* base; unsigned lo; unsigned dhi;
  DEV uint4 operator()(int i, int kb, int so) const {
    const unsigned u = (kb < 256) ? 0u : dhi;
    return ld8_at(base, lo + u + (unsigned)i * 8192u + (unsigned)(kb & 255) + (unsigned)so);
  }
};
struct GemmPipe { uint4 ra[2][4], rb[2][4]; };

template <typename AL, typename BL, typename EP>
DEV void gemm128(bool SWAP, int K, bool first, bool hasNext, const AL& aload, const BL& bload, const AL& aloadN, const BL& bloadN,
                 EP epi, GemmPipe& gp, unsigned char* smem) {
  const int tid = my_tid(), lane = tid & 63, w = tid >> 6, wm = w >> 1, wn = w & 1, l15 = lane & 15, lq = lane >> 4;
  const int seg = tid & 7, r0 = tid >> 3;
  const int nk = K >> 6;
  f32x4 acc[4][4];
#pragma unroll
  for (int mi = 0; mi < 4; ++mi)
#pragma unroll
    for (int ni = 0; ni < 4; ++ni) acc[mi][ni] = f32x4{0.f, 0.f, 0.f, 0.f};
  if (first) {
#pragma unroll
    for (int i = 0; i < 4; ++i) { gp.ra[0][i] = aload(i, 0, seg * 8); gp.rb[0][i] = bload(i, 0, seg * 8); }
#pragma unroll
    for (int i = 0; i < 4; ++i) { gp.ra[1][i] = aload(i, 64, seg * 8); gp.rb[1][i] = bload(i, 64, seg * 8); }
    __syncthreads();
    bfu* As = (bfu*)smem; bfu* Bs = As + 128 * 80;
#pragma unroll
    for (int i = 0; i < 4; ++i) {
      *(uint4*)(As + (r0 + 32 * i) * 80 + seg * 8) = gp.ra[0][i];
      *(uint4*)(Bs + (r0 + 32 * i) * 80 + seg * 8) = gp.rb[0][i];
    }
#pragma unroll
    for (int i = 0; i < 4; ++i) { gp.ra[0][i] = aload(i, 128, seg * 8); gp.rb[0][i] = bload(i, 128, seg * 8); }
  }
  auto body = [&](auto pc, int kt) {
    constexpr int PAR = decltype(pc)::v;
    constexpr int NXT = PAR ^ 1;
    __syncthreads();
    if (kt + 1 < nk || hasNext) {
      bfu* As = (bfu*)(smem + NXT * 40960); bfu* Bs = As + 128 * 80;
#pragma unroll
      for (int i = 0; i < 4; ++i) {
        *(uint4*)(As + (r0 + 32 * i) * 80 + seg * 8) = gp.ra[NXT][i];
        *(uint4*)(Bs + (r0 + 32 * i) * 80 + seg * 8) = gp.rb[NXT][i];
      }
    }
    if (kt + 3 < nk) {
      const int k = (kt + 3) * 64;
#pragma unroll
      for (int i = 0; i < 4; ++i) { gp.ra[NXT][i] = aload(i, k, seg * 8); gp.rb[NXT][i] = bload(i, k, seg * 8); }
    } else if (hasNext) {
      const int k = (kt + 3 - nk) * 64;
#pragma unroll
      for (int i = 0; i < 4; ++i) { gp.ra[NXT][i] = aloadN(i, k, seg * 8); gp.rb[NXT][i] = bloadN(i, k, seg * 8); }
    } else {
      const int k = (nk - 1) * 64;
#pragma unroll
      for (int i = 0; i < 4; ++i) { gp.ra[NXT][i] = aload(i, k, seg * 8); gp.rb[NXT][i] = bload(i, k, seg * 8); }
    }
    const bfu* Ac = (const bfu*)(smem + PAR * 40960);
    __builtin_amdgcn_s_setprio(1);
    mma_tile<true>(Ac, Ac + 128 * 80, wm, wn, l15, lq, acc);
    __builtin_amdgcn_s_setprio(0);
  };
  for (int kt = 0; kt < nk; kt += 2) {
    body(IC<0>{}, kt);
    body(IC<1>{}, kt + 1);
  }
  epi(acc, wm, wn, l15, lq);
}

DEV bool gemm_item(int iter, int MT, int NT, int& mt, int& nt) {
  const int nl = gridDim.x >> 3;
  const int x = blockIdx.x & 7, lw = blockIdx.x >> 3;
  const int mper = MT >> 3;
  const int li = lw + iter * nl;
  if (li >= mper * NT) return false;
  const int per_group = mper * 4;
  const int g = li / per_group, r = li - g * per_group;
  mt = x * mper + (r >> 2);
  nt = g * 4 + (r & 3);
  return true;
}
DEV int xcd_item(int iter, int total, int inner) {
  const int nl = gridDim.x >> 3;
  const int x = blockIdx.x & 7, lw = blockIdx.x >> 3;
  const int outer = total / inner;
  const int chunk = (outer + 7) >> 3;
  const int o0 = x * chunk;
  int o1 = o0 + chunk; if (o1 > outer) o1 = outer;
  const int li = lw + iter * nl;
  if (o0 >= o1 || li >= (o1 - o0) * inner) return -1;
  return o0 * inner + li;
}

DEV void transpose_job(const float* __restrict__ src, bfu* __restrict__ dst, int nmat, int K, int N, int half, bfu* tl) {
  const int tk = K >> 6, tn = N >> 6;
  const int per = tk * tn, total = nmat * per;
  const int tid = my_tid();
  const int c4 = tid & 15, r = tid >> 4;
  int it = blockIdx.x;
  if (it >= total) return;
  auto tile_src = [&](int itx) -> const float* {
    const int m = itx / per, rem = itx - m * per;
    const int kt = rem / tn, nt = rem - kt * tn;
    return src + (size_t)m * K * N + (size_t)(kt * 64) * N + nt * 64;
  };
  float4 nv[4];
  {
    const float* s = tile_src(it);
#pragma unroll
    for (int i = 0; i < 4; ++i) nv[i] = *(const float4*)(s + (size_t)(r + 16 * i) * N + c4 * 4);
  }
  for (; it < total; it += gridDim.x) {
    const int m = it / per, rem = it - m * per;
    const int kt = rem / tn, nt = rem - kt * tn;
    float4 v[4];
#pragma unroll
    for (int i = 0; i < 4; ++i) v[i] = nv[i];
    {
      const float* s = tile_src(it + gridDim.x < total ? it + gridDim.x : it);
#pragma unroll
      for (int i = 0; i < 4; ++i) nv[i] = *(const float4*)(s + (size_t)(r + 16 * i) * N + c4 * 4);
    }
    __syncthreads();
#pragma unroll
    for (int i = 0; i < 4; ++i) {
      tl[(c4 * 4 + 0) * 72 + r + 16 * i] = f2bf(v[i].x);
      tl[(c4 * 4 + 1) * 72 + r + 16 * i] = f2bf(v[i].y);
      tl[(c4 * 4 + 2) * 72 + r + 16 * i] = f2bf(v[i].z);
      tl[(c4 * 4 + 3) * 72 + r + 16 * i] = f2bf(v[i].w);
    }
    __syncthreads();
    bfu* d = dst + (size_t)m * K * N;
#pragma unroll
    for (int i = 0; i < 2; ++i) {
      const int idx = tid + 256 * i, n = idx >> 3, sg = idx & 7;
      const int pn = perm_half(nt * 64 + n, half);
      *(uint4*)(d + (size_t)pn * K + kt * 64 + sg * 8) = *(const uint4*)(tl + n * 72 + sg * 8);
    }
  }
}

DEV void phase_prep(const Params& p, unsigned char* smem) {
  bfu* tl = (bfu*)smem;
  unsigned char* ws = p.ws;
  const int gtid = blockIdx.x * 256 + my_tid();
  if (gtid < 512) ((int*)(ws + S_CNT))[gtid] = 0;
  if (gtid < 512) {
    float l0 = p.lb_logits[gtid], l1 = p.lb_logits[512 + gtid], l2 = p.lb_logits[1024 + gtid];
    float m = fmaxf(l0, fmaxf(l1, l2));
    float e0 = expf(l0 - m), e1 = expf(l1 - m), e2 = expf(l2 - m);
    ((float*)(ws + S_LB))[gtid] = e0 / (e0 + e1 + e2);
  }
  if (gtid < 2048) {
    int g = gtid >> 6;
    float dt = expf(p.log_dt[g]);
    float ar = p.a_re[gtid], ai = p.a_im[gtid];
    float mag = expf(dt * ar);
    float abr = mag * cosf(dt * ai), abi = mag * sinf(dt * ai);
    float den = ar * ar + ai * ai;
    float xr = abr - 1.f, xi = abi;
    float fr = (xr * ar + xi * ai) / den, fi = (xi * ar - xr * ai) / den;
    float* ab = (float*)(ws + S_ABAR);
    ab[gtid * 2] = abr; ab[gtid * 2 + 1] = abi;
    float pr = abr, pi = abi;
#pragma unroll
    for (int i = 0; i < 6; ++i) { float nr = pr * pr - pi * pi, ni = 2.f * pr * pi; pr = nr; pi = ni; }
    float* ap = (float*)(ws + S_APOW);
    ap[gtid * 2] = pr; ap[gtid * 2 + 1] = pi;
    float* bb = (float*)(ws + S_BBAR) + (size_t)gtid * 32;
    for (int m = 0; m < 16; ++m) {
      float br = p.b_re[gtid * 16 + m], bi = p.b_im[gtid * 16 + m];
      bb[m] = fr * br - fi * bi;
      bb[16 + m] = fr * bi + fi * br;
    }
  }
  transpose_job(p.ev_w_in, (bfu*)(ws + OFF_WEVIN), 1, 1024, 2560, 0, tl);
  transpose_job(p.w_glu, (bfu*)(ws + OFF_WGLU), 1, 512, 1024, 512, tl);
  transpose_job(p.ev_w_out, (bfu*)(ws + OFF_WEVOUT), 1, 1024, 1024, 0, tl);
  transpose_job(p.od_w_in, (bfu*)(ws + OFF_WODIN), 1, 1024, 1536, 0, tl);
  transpose_job(p.od_w_out, (bfu*)(ws + OFF_WODOUT), 1, 1024, 1024, 0, tl);
  transpose_job(p.w_gate_up, (bfu*)(ws + OFF_WGU), 32, 1024, 512, 256, tl);
  transpose_job(p.w_down, (bfu*)(ws + OFF_WDN), 32, 256, 1024, 0, tl);
  {
    uint4* xb = (uint4*)(ws + OFF_XB);
    const size_t n8 = (size_t)T * 1024 / 8;
    for (size_t i = (size_t)blockIdx.x * 256 + my_tid(); i < n8; i += (size_t)gridDim.x * 256) xb[i] = ld8_f32(p.x + i * 8);
  }
}

DEV void phase_proj(const bfu* __restrict__ X, const bfu* __restrict__ Wt, bfu* __restrict__ P, int N, bfu* __restrict__ VT, int layer, unsigned char* smem) {
  const int ntn = N >> 7;
  const int total = (T >> 7) * ntn;
  const int r0 = my_tid() >> 3;
  GemmPipe gp;
  bool first = true;
  for (int it = blockIdx.x; it < total; it += gridDim.x) {
    const int mt = it / ntn, nt = it - mt * ntn;
    const int itn = it + gridDim.x;
    const bool hasNext = itn < total;
    const int itq = hasNext ? itn : it;
    const int mtn = itq / ntn, ntq = itq - mtn * ntn;
    const RowLoader al{X, (unsigned)(mt * 128 + r0) * 1024u, 32768u}, bl{Wt, (unsigned)(nt * 128 + r0) * 1024u, 32768u};
    const RowLoader aln{X, (unsigned)(mtn * 128 + r0) * 1024u, 32768u}, bln{Wt, (unsigned)(ntq * 128 + r0) * 1024u, 32768u};
    auto epi = [&](f32x4(&acc)[4][4], int wm, int wn, int l15, int lq) {
#pragma unroll
      for (int ai = 0; ai < 4; ++ai)
#pragma unroll
        for (int bi = 0; bi < 4; ++bi) {
          const int row = mt * 128 + wm * 64 + bi * 16 + l15, col = nt * 128 + wn * 64 + ai * 16 + lq * 4;
          *(uint2*)(P + (size_t)row * N + col) = make_uint2(pack2(acc[ai][bi][0], acc[ai][bi][1]), pack2(acc[ai][bi][2], acc[ai][bi][3]));
        }
    };
    const bool vt_tile = layer == 0 ? (nt >= 8 && nt <= 11) : (nt == 5 || nt == 11);
    auto epi2 = [&](f32x4(&acc)[4][4], int wm, int wn, int l15, int lq) {
      if (vt_tile) {
        bfu* Ct = (bfu*)(smem + 40960);
        __syncthreads();
#pragma unroll
        for (int ai = 0; ai < 4; ++ai)
#pragma unroll
          for (int bi = 0; bi < 4; ++bi)
#pragma unroll
            for (int j = 0; j < 4; ++j)
              Ct[(wn * 64 + ai * 16 + lq * 4 + j) * 136 + wm * 64 + bi * 16 + l15] = f2bf(acc[ai][bi][j]);
        __syncthreads();
        const int which = nt == 11 ? 1 : 0;
        const int m0 = mt * 128;
        const int b = m0 >> 14, t0 = m0 & (L - 1);
        const int tid = my_tid();
#pragma unroll
        for (int i = 0; i < 8; ++i) {
          const int idx = tid + 256 * i, n = idx >> 4, c = idx & 15;
          const size_t vrow = layer == 0 ? (size_t)((b * 4 + (nt - 8)) * 128 + n) : (size_t)(((which * 2 + b) * 2 + (n >> 6)) * 64 + (n & 63));
          *(uint4*)(VT + vrow * L + t0 + c * 8) = *(const uint4*)(Ct + n * 136 + c * 8);
        }
      } else {
        epi(acc, wm, wn, l15, lq);
      }
    };
    gemm128(true, 1024, first, hasNext, al, bl, aln, bln, epi2, gp, smem);
    first = false;
  }
}

DEV void phase_glu(const Params& p, unsigned char* smem) {
  const bfu* A = (const bfu*)(p.ws + OFF_YS5);
  const bfu* Wt = (const bfu*)(p.ws + OFF_WGLU);
  bfu* Y = (bfu*)(p.ws + OFF_Y);
  const int r0 = my_tid() >> 3;
  const int total = (T >> 7) * 8;
  GemmPipe gp;
  bool first = true;
  for (int it = blockIdx.x; it < total; it += gridDim.x) {
    const int mt = it >> 3, nt = it & 7;
    const int itn = it + gridDim.x;
    const bool hasNext = itn < total;
    const int itq = hasNext ? itn : it;
    const RowLoader al{A, (unsigned)(mt * 128 + r0) * 512u, 16384u}, bl{Wt, (unsigned)(nt * 128 + r0) * 512u, 16384u};
    const RowLoader aln{A, (unsigned)((itq >> 3) * 128 + r0) * 512u, 16384u}, bln{Wt, (unsigned)((itq & 7) * 128 + r0) * 512u, 16384u};
    auto epi = [&](f32x4(&acc)[4][4], int wm, int wn, int l15, int lq) {
      const int q = nt * 2 + wn;
#pragma unroll
      for (int ai = 0; ai < 2; ++ai)
#pragma unroll
        for (int bi = 0; bi < 4; ++bi) {
          const int row = mt * 128 + wm * 64 + bi * 16 + l15, col = q * 32 + ai * 16 + lq * 4;
          float o[4];
#pragma unroll
          for (int j = 0; j < 4; ++j) o[j] = acc[ai][bi][j] * sigm(acc[ai + 2][bi][j]);
          *(uint2*)(Y + (size_t)row * 1024 + 512 + col) = make_uint2(pack2(o[0], o[1]), pack2(o[2], o[3]));
        }
    };
    gemm128(true, 512, first, hasNext, al, bl, aln, bln, epi, gp, smem);
    first = false;
  }
}

DEV void phase_outproj(const Params& p, const bfu* __restrict__ Wt, unsigned char* smem) {
  const bfu* A = (const bfu*)(p.ws + OFF_Y);
  bfu* MIX = (bfu*)(p.ws + OFF_MIX);
  const int r0 = my_tid() >> 3;
  const int total = (T >> 7) * 8;
  GemmPipe gp;
  bool first = true;
  for (int it = blockIdx.x; it < total; it += gridDim.x) {
    const int mt = it >> 3, nt = it & 7;
    const int itn = it + gridDim.x;
    const bool hasNext = itn < total;
    const int itq = hasNext ? itn : it;
    const RowLoader al{A, (unsigned)(mt * 128 + r0) * 1024u, 32768u}, bl{Wt, (unsigned)(nt * 128 + r0) * 1024u, 32768u};
    const RowLoader aln{A, (unsigned)((itq >> 3) * 128 + r0) * 1024u, 32768u}, bln{Wt, (unsigned)((itq & 7) * 128 + r0) * 1024u, 32768u};
    auto epi = [&](f32x4(&acc)[4][4], int wm, int wn, int l15, int lq) {
#pragma unroll
      for (int ai = 0; ai < 4; ++ai)
#pragma unroll
        for (int bi = 0; bi < 4; ++bi) {
          const int row = mt * 128 + wm * 64 + bi * 16 + l15, col = nt * 128 + wn * 64 + ai * 16 + lq * 4;
          *(uint2*)(MIX + (size_t)row * 1024 + col) = make_uint2(pack2(acc[ai][bi][0], acc[ai][bi][1]), pack2(acc[ai][bi][2], acc[ai][bi][3]));
        }
    };
    gemm128(true, 1024, first, hasNext, al, bl, aln, bln, epi, gp, smem);
    first = false;
  }
}


DEV void stage_tile64x128(const bfu* __restrict__ src, int ld, bfu* dst, int ls) {
#pragma unroll
  for (int i = 0; i < 4; ++i) {
    const int idx = my_tid() + 256 * i, row = idx >> 4, sg = idx & 15;
    *(uint4*)(dst + row * ls + sg * 8) = *(const uint4*)(src + (size_t)row * ld + sg * 8);
  }
}
DEV void stage_tile64x128_T(const bfu* __restrict__ src, int ld, bfu* dst, int ls) {
#pragma unroll
  for (int i = 0; i < 4; ++i) {
    const int idx = my_tid() + 256 * i, row = idx >> 4, sg = idx & 15;
    uint4 v = *(const uint4*)(src + (size_t)row * ld + sg * 8);
    unsigned uu[4] = {v.x, v.y, v.z, v.w};
#pragma unroll
    for (int e = 0; e < 4; ++e) {
      dst[(sg * 8 + 2 * e) * ls + row] = (bfu)(uu[e] & 0xffffu);
      dst[(sg * 8 + 2 * e + 1) * ls + row] = (bfu)(uu[e] >> 16);
    }
  }
}


DEV void stage_vt(const bfu* __restrict__ vt0, int bh, int tl0, bfu* dst, int ls) {
#pragma unroll
  for (int i = 0; i < 4; ++i) {
    const int idx = my_tid() + 256 * i, v = idx >> 3, c = idx & 7;
    *(uint4*)(dst + v * ls + c * 8) = *(const uint4*)(vt0 + ((size_t)(bh * 128 + v)) * L + tl0 + c * 8);
  }
}

DEV void hgrn_dstate_item(const Params& p, int ch, unsigned char* smem) {
  const int bh = ch >> 8, n = ch & 255, b = bh >> 2, h = bh & 3;
  const size_t t0 = (size_t)b * L + (size_t)n * 64;
  const bfu* P = (const bfu*)(p.ws + OFF_P);
  bfu* As = (bfu*)smem;
  bfu* Bs = As + 128 * 80;
  bfu* Fr = Bs + 128 * 80;
  const int tid = my_tid(), k = tid & 127, half = tid >> 7;
  const float lb = ((const float*)(p.ws + S_LB))[h * 128 + k];
  __syncthreads();
  stage_tile64x128(P + t0 * 2560 + 512 + h * 128, 2560, Fr, 128);
  stage_vt((const bfu*)p.out, bh, n * 64, As, 80);
  __syncthreads();
  float* tot = (float*)(Fr + 64 * 128);
  float fv[32], cum[32];
  float run = 0.f;
#pragma unroll
  for (int i = 0; i < 32; ++i) {
    const float f = lb + (1.f - lb) * sigm(bf2f(Fr[(half * 32 + i) * 128 + k]));
    run += __logf(f);
    fv[i] = f; cum[i] = run;
  }
  tot[half * 128 + k] = run;
  __syncthreads();
  const float t0s = tot[k], t1s = tot[128 + k];
  const float btot = t0s + t1s;
  const float boff = half ? t0s : 0.f;
#pragma unroll
  for (int i = 0; i < 32; ++i) Bs[k * 80 + half * 32 + i] = f2bf((1.f - fv[i]) * __expf(btot - (boff + cum[i])));
  if (half == 0) ((float*)(p.ws + OFF_DEC))[(size_t)ch * 128 + k] = __expf(btot);
  __syncthreads();
  const int lane = tid & 63, w = tid >> 6, wm = w >> 1, wn = w & 1, l15 = lane & 15, lq = lane >> 4;
  f32x4 acc[4][4];
#pragma unroll
  for (int mi = 0; mi < 4; ++mi)
#pragma unroll
    for (int ni = 0; ni < 4; ++ni) acc[mi][ni] = f32x4{0.f, 0.f, 0.f, 0.f};
  mma_tile<true>(As, Bs, wm, wn, l15, lq, acc);
  bfu* DS = (bfu*)(p.ws + OFF_DS) + (size_t)ch * 16384;
#pragma unroll
  for (int ai = 0; ai < 4; ++ai)
#pragma unroll
    for (int bi = 0; bi < 4; ++bi) {
      const int v = wm * 64 + bi * 16 + l15, kk = wn * 64 + ai * 16 + lq * 4;
      *(uint2*)(DS + v * 128 + kk) = make_uint2(pack2(acc[ai][bi][0], acc[ai][bi][1]), pack2(acc[ai][bi][2], acc[ai][bi][3]));
    }
}

DEV void s5_load_bfrag(const Params& p, int g, int l15, int lq, uint4 (&bf)[8]) {
#pragma unroll
  for (int ni = 0; ni < 8; ++ni) {
    bf[ni] = make_uint4(0u, 0u, 0u, 0u);
    if (lq < 2) {
      const int col = ni * 16 + l15, pp = col & 63, part = col >> 6;
      const float* s = (const float*)(p.ws + S_BBAR) + (size_t)(g * 64 + pp) * 32 + part * 16 + lq * 8;
      const float4 u = ((const float4*)s)[0], v = ((const float4*)s)[1];
      bf[ni] = make_uint4(pack2(u.x, u.y), pack2(u.z, u.w), pack2(v.x, v.y), pack2(v.z, v.w));
    }
  }
}
DEV void s5_drive16(const uint4 a, const uint4 (&bf)[8], float* Dr, int l15, int lq) {
#pragma unroll
  for (int ni = 0; ni < 8; ++ni) {
    f32x4 acc = mfma16(a, bf[ni], f32x4{0.f, 0.f, 0.f, 0.f});
#pragma unroll
    for (int j = 0; j < 4; ++j) Dr[(lq * 4 + j) * 132 + ni * 16 + l15] = acc[j];
  }
}

struct S5Const { uint4 bf[8]; uint4 cf[4]; float2 ab; float dsk; };

DEV void s5_pass1_item(const Params& p, int it, const uint4 (&bf)[8], const float2 ab, unsigned char* smem) {
  const int gq = it & 7, bc = it >> 3;
  const size_t t0 = (size_t)(bc >> 8) * L + (size_t)(bc & 255) * 64;
  const int tid = my_tid(), lane = tid & 63, w = tid >> 6, l15 = lane & 15, lq = lane >> 4;
  float* Dr = (float*)smem + w * (16 * 132);
  const int g = gq * 4 + w;
  const int gp = g * 64 + lane;
  const bfu* P = (const bfu*)(p.ws + OFF_P);
  uint4 af[4];
#pragma unroll
  for (int sub = 0; sub < 4; ++sub) {
    af[sub] = make_uint4(0u, 0u, 0u, 0u);
    if (lq < 2) af[sub] = *(const uint4*)(P + (t0 + sub * 16 + l15) * 2560 + 2048 + g * 16 + lq * 8);
  }
  float hr = 0.f, hi = 0.f;
#pragma unroll
  for (int sub = 0; sub < 4; ++sub) {
    __syncthreads();
    s5_drive16(af[sub], bf, Dr, l15, lq);
    __syncthreads();
#pragma unroll 4
    for (int tt = 0; tt < 16; ++tt) {
      const float dr = Dr[tt * 132 + lane], di = Dr[tt * 132 + 64 + lane];
      const float nr = ab.x * hr - ab.y * hi + dr;
      const float ni = ab.x * hi + ab.y * hr + di;
      hr = nr; hi = ni;
    }
  }
  ((float2*)(p.ws + OFF_HEND))[(size_t)bc * 2048 + gp] = make_float2(hr, hi);
}

DEV void s5_pass2_item(const Params& p, int it, const uint4 (&bf)[8], const uint4 (&cf)[4], const float2 ab, const float dsk, unsigned char* smem) {
  const int gq = it & 7, bc = it >> 3;
  const size_t t0 = (size_t)(bc >> 8) * L + (size_t)(bc & 255) * 64;
  const int tid = my_tid(), lane = tid & 63, w = tid >> 6, l15 = lane & 15, lq = lane >> 4;
  float* Dr = (float*)smem + w * (16 * 132);
  bfu* Hs = (bfu*)(smem + 4 * 16 * 132 * 4) + w * (16 * 144);
  const int g = gq * 4 + w;
  const int gp = g * 64 + lane;
  const bfu* P = (const bfu*)(p.ws + OFF_P);
  uint4 af[4];
#pragma unroll
  for (int sub = 0; sub < 4; ++sub) {
    af[sub] = make_uint4(0u, 0u, 0u, 0u);
    if (lq < 2) af[sub] = *(const uint4*)(P + (t0 + sub * 16 + l15) * 2560 + 2048 + g * 16 + lq * 8);
  }
  float2 hc = ((const float2*)(p.ws + OFF_CARRY))[(size_t)bc * 2048 + gp];
  float hr = hc.x, hi = hc.y;
  bfu* YS = (bfu*)(p.ws + OFF_YS5);
#pragma unroll
  for (int sub = 0; sub < 4; ++sub) {
    float us[4];
#pragma unroll
    for (int j = 0; j < 4; ++j) us[j] = bf2f(P[(t0 + sub * 16 + lq * 4 + j) * 2560 + 2048 + g * 16 + l15]);
    __syncthreads();
    s5_drive16(af[sub], bf, Dr, l15, lq);
    __syncthreads();
#pragma unroll 4
    for (int tt = 0; tt < 16; ++tt) {
      const float dr = Dr[tt * 132 + lane], di = Dr[tt * 132 + 64 + lane];
      const float nr = ab.x * hr - ab.y * hi + dr;
      const float ni = ab.x * hi + ab.y * hr + di;
      hr = nr; hi = ni;
      Hs[tt * 144 + lane] = f2bf(hr);
      Hs[tt * 144 + 64 + lane] = f2bf(hi);
    }
    __syncthreads();
    f32x4 acc = f32x4{0.f, 0.f, 0.f, 0.f};
#pragma unroll
    for (int ks = 0; ks < 4; ++ks) acc = mfma16(lds128(Hs + l15 * 144 + ks * 32 + lq * 8), cf[ks], acc);
#pragma unroll
    for (int j = 0; j < 4; ++j) {
      const int t = sub * 16 + lq * 4 + j;
      const float y = acc[j] + dsk * us[j];
      YS[(t0 + t) * 512 + g * 16 + l15] = f2bf(gelu_tanh(y));
    }
  }
}


DEV void s5_load_consts(const Params& p, int g, int lane, uint4 (&bf)[8], uint4 (&cf)[4], float2& ab, float& dsk) {
  const int l15 = lane & 15, lq = lane >> 4;
  s5_load_bfrag(p, g, l15, lq, bf);
  ab = ((const float2*)(p.ws + S_ABAR))[g * 64 + lane];
#pragma unroll
  for (int ks = 0; ks < 4; ++ks) {
    const float* src = (ks < 2 ? p.c_re : p.c_im) + ((size_t)g * 16 + l15) * 64 + (ks & 1) * 32 + lq * 8;
    float4 u = ((const float4*)src)[0], v = ((const float4*)src)[1];
    float sgn = ks < 2 ? 1.f : -1.f;
    cf[ks] = make_uint4(pack2(sgn * u.x, sgn * u.y), pack2(sgn * u.z, sgn * u.w), pack2(sgn * v.x, sgn * v.y), pack2(sgn * v.z, sgn * v.w));
  }
  dsk = p.s5_d[g * 16 + l15];
}

DEV void hgrn_scan_item(const Params& p, int it) {
  const int bh = it >> 3, vs = it & 7;
  const int tid = my_tid(), v = vs * 16 + (tid >> 4), k8 = tid & 15;
  const bfu* DS = (const bfu*)(p.ws + OFF_DS);
  bfu* SP = (bfu*)(p.ws + OFF_SP);
  const float* DEC = (const float*)(p.ws + OFF_DEC);
  float S[8];
#pragma unroll
  for (int i = 0; i < 8; ++i) S[i] = 0.f;
  uint4 dsr[8];
  float4 dca[8], dcb[8];
  const size_t base0 = ((size_t)(bh * 256) * 128 + v) * 128 + k8 * 8;
  const size_t dbase0 = (size_t)(bh * 256) * 128 + k8 * 8;
#pragma unroll
  for (int s = 0; s < 8; ++s) {
    dsr[s] = *(const uint4*)(DS + base0 + (size_t)s * 16384);
    dca[s] = *(const float4*)(DEC + dbase0 + (size_t)s * 128);
    dcb[s] = *(const float4*)(DEC + dbase0 + (size_t)s * 128 + 4);
  }
  for (int n0 = 0; n0 < 256; n0 += 8) {
#pragma unroll
    for (int s = 0; s < 8; ++s) {
      const int n = n0 + s;
      *(uint4*)(SP + base0 + (size_t)n * 16384) = make_uint4(pack2(S[0], S[1]), pack2(S[2], S[3]), pack2(S[4], S[5]), pack2(S[6], S[7]));
      const uint4 d = dsr[s];
      const float4 a = dca[s], c = dcb[s];
      S[0] = a.x * S[0] + __uint_as_float(d.x << 16); S[1] = a.y * S[1] + __uint_as_float(d.x & 0xffff0000u);
      S[2] = a.z * S[2] + __uint_as_float(d.y << 16); S[3] = a.w * S[3] + __uint_as_float(d.y & 0xffff0000u);
      S[4] = c.x * S[4] + __uint_as_float(d.z << 16); S[5] = c.y * S[5] + __uint_as_float(d.z & 0xffff0000u);
      S[6] = c.z * S[6] + __uint_as_float(d.w << 16); S[7] = c.w * S[7] + __uint_as_float(d.w & 0xffff0000u);
      if (n + 8 < 256) {
        dsr[s] = *(const uint4*)(DS + base0 + (size_t)(n + 8) * 16384);
        dca[s] = *(const float4*)(DEC + dbase0 + (size_t)(n + 8) * 128);
        dcb[s] = *(const float4*)(DEC + dbase0 + (size_t)(n + 8) * 128 + 4);
      }
    }
  }
}

DEV void s5_carry_item(const Params& p, int it) {
  const int id = it * 256 + my_tid();
  const int b = id >> 11, gp = id & 2047;
  const float2 ap = ((const float2*)(p.ws + S_APOW))[gp];
  const float2* HE = (const float2*)(p.ws + OFF_HEND) + (size_t)b * 256 * 2048 + gp;
  float2* CA = (float2*)(p.ws + OFF_CARRY) + (size_t)b * 256 * 2048 + gp;
  float cr = 0.f, ci = 0.f;
  float2 ring[8];
#pragma unroll
  for (int s = 0; s < 8; ++s) ring[s] = HE[(size_t)s * 2048];
  for (int c0 = 0; c0 < 256; c0 += 8) {
#pragma unroll
    for (int s = 0; s < 8; ++s) {
      const int c = c0 + s;
      CA[(size_t)c * 2048] = make_float2(cr, ci);
      float nr = ap.x * cr - ap.y * ci + ring[s].x;
      float ni = ap.x * ci + ap.y * cr + ring[s].y;
      cr = nr; ci = ni;
      if (c + 8 < 256) ring[s] = HE[(size_t)(c + 8) * 2048];
    }
  }
}

DEV void hgrn_out_item(const Params& p, int ch, unsigned char* smem) {
  const int bh = ch >> 8, n = ch & 255, b = bh >> 2, h = bh & 3;
  const size_t t0 = (size_t)b * L + (size_t)n * 64;
  const bfu* P = (const bfu*)(p.ws + OFF_P);
  bfu* Qs = (bfu*)smem;
  bfu* RB = Qs + 64 * 144;
  bfu* Ks = RB;
  bfu* ATT = RB;
  bfu* Vt = RB + 64 * 80;
  bfu* St = RB;
  bfu* Fr = RB + 64 * 144;
  float* tot = (float*)(Fr + 64 * 128);
  bfu* Gs = (bfu*)(smem + 55296);
  const int tid = my_tid(), lane = tid & 63, w = tid >> 6, l15 = lane & 15, lq = lane >> 4;
  uint4 rq0, rq1, rq2, rq3, rf0, rf1, rf2, rf3, rv0, rv1, rv2, rv3, rg0, rg1, rg2, rg3, rs0, rs1, rs2, rs3, rs4, rs5, rs6, rs7;
  {
    const bfu* qsrc = P + t0 * 2560 + h * 128;
    const bfu* vt0 = (const bfu*)p.out;
    const bfu* SPc = (const bfu*)(p.ws + OFF_SP) + (size_t)ch * 16384;
#define HG_LD(i) { const int idx = tid + 256 * i, row = idx >> 4, sg = idx & 15; \
      rq##i = *(const uint4*)(qsrc + (size_t)row * 2560 + sg * 8); \
      rf##i = *(const uint4*)(qsrc + 512 + (size_t)row * 2560 + sg * 8); \
      rg##i = *(const uint4*)(qsrc + 1536 + (size_t)row * 2560 + sg * 8); \
      const int v = idx >> 3, c = idx & 7; \
      rv##i = *(const uint4*)(vt0 + ((size_t)(bh * 128 + v)) * L + n * 64 + c * 8); }
    HG_LD(0) HG_LD(1) HG_LD(2) HG_LD(3)
#undef HG_LD
#define HG_LS(i) { const int idx = tid + 256 * i, v = idx >> 4, sg = idx & 15; rs##i = *(const uint4*)(SPc + v * 128 + sg * 8); }
    HG_LS(0) HG_LS(1) HG_LS(2) HG_LS(3) HG_LS(4) HG_LS(5) HG_LS(6) HG_LS(7)
#undef HG_LS
  }
  float ng[8];
#pragma unroll
  for (int ni = 0; ni < 8; ++ni) ng[ni] = p.ev_a_norm[h * 128 + ni * 16 + l15];
  __syncthreads();
#define HG_ST(i) { const int idx = tid + 256 * i, row = idx >> 4, sg = idx & 15; \
    *(uint4*)(Qs + row * 144 + sg * 8) = rq##i; *(uint4*)(Fr + row * 128 + sg * 8) = rf##i; *(uint4*)(Gs + row * 144 + sg * 8) = rg##i; }
  HG_ST(0) HG_ST(1) HG_ST(2) HG_ST(3)
#undef HG_ST
  __syncthreads();
  {
    const int k = tid & 127, half = tid >> 7;
    const float lb = ((const float*)(p.ws + S_LB))[h * 128 + k];
    float fv[32], cum[32];
    float run = 0.f;
#pragma unroll
    for (int i = 0; i < 32; ++i) {
      const float f = lb + (1.f - lb) * sigm(bf2f(Fr[(half * 32 + i) * 128 + k]));
      run += __logf(f);
      fv[i] = f; cum[i] = run;
    }
    tot[half * 128 + k] = run;
    __syncthreads();
    const float boff = half ? tot[k] : 0.f;
#pragma unroll
    for (int i = 0; i < 32; ++i) {
      const int s = half * 32 + i;
      const float eb = __expf(boff + cum[i]);
      const float q = siluf(bf2f(Qs[s * 144 + k]));
      Qs[s * 144 + k] = f2bf(q * eb);
      Ks[s * 144 + k] = f2bf((1.f - fv[i]) * frcp(eb));
    }
  }
  __syncthreads();
  f32x4 at[4];
#pragma unroll
  for (int ni = 0; ni < 4; ++ni) at[ni] = f32x4{0.f, 0.f, 0.f, 0.f};
#pragma unroll
  for (int ks = 0; ks < 4; ++ks) {
    uint4 a = lds128(Qs + (16 * w + l15) * 144 + ks * 32 + lq * 8);
#pragma unroll
    for (int ni = 0; ni < 4; ++ni) at[ni] = mfma16(a, lds128(Ks + (ni * 16 + l15) * 144 + ks * 32 + lq * 8), at[ni]);
  }
  __syncthreads();
#pragma unroll
  for (int ni = 0; ni < 4; ++ni)
#pragma unroll
    for (int j = 0; j < 4; ++j) {
      int c = 16 * w + lq * 4 + j, s = ni * 16 + l15;
      ATT[c * 80 + s] = f2bf(s <= c ? at[ni][j] : 0.f);
    }
#define HG_SV(i) { const int idx = tid + 256 * i, v = idx >> 3, c = idx & 7; *(uint4*)(Vt + v * 80 + c * 8) = rv##i; }
  HG_SV(0) HG_SV(1) HG_SV(2) HG_SV(3)
#undef HG_SV
  __syncthreads();
  f32x4 o[8];
#pragma unroll
  for (int ni = 0; ni < 8; ++ni) o[ni] = f32x4{0.f, 0.f, 0.f, 0.f};
#pragma unroll
  for (int ks = 0; ks < 2; ++ks) {
    uint4 a = lds128(ATT + (16 * w + l15) * 80 + ks * 32 + lq * 8);
#pragma unroll
    for (int ni = 0; ni < 8; ++ni) o[ni] = mfma16(a, lds128(Vt + (ni * 16 + l15) * 80 + ks * 32 + lq * 8), o[ni]);
  }
  __syncthreads();
#define HG_SS(i) { const int idx = tid + 256 * i, v = idx >> 4, sg = idx & 15; *(uint4*)(St + v * 144 + sg * 8) = rs##i; }
  HG_SS(0) HG_SS(1) HG_SS(2) HG_SS(3) HG_SS(4) HG_SS(5) HG_SS(6) HG_SS(7)
#undef HG_SS
  __syncthreads();
#pragma unroll
  for (int ks = 0; ks < 4; ++ks) {
    uint4 a = lds128(Qs + (16 * w + l15) * 144 + ks * 32 + lq * 8);
#pragma unroll
    for (int ni = 0; ni < 8; ++ni) o[ni] = mfma16(a, lds128(St + (ni * 16 + l15) * 144 + ks * 32 + lq * 8), o[ni]);
  }
#pragma unroll
  for (int j = 0; j < 4; ++j) {
    float ss = 0.f;
#pragma unroll
    for (int ni = 0; ni < 8; ++ni) ss += o[ni][j] * o[ni][j];
    ss = sum16(ss);
    const float rsn = rsqrtf(ss * (1.f / 128.f) + 1e-6f);
    const int c = 16 * w + lq * 4 + j;
#pragma unroll
    for (int ni = 0; ni < 8; ++ni) {
      const int v = ni * 16 + l15;
      const float gate = bf2f(Gs[c * 144 + v]);
      Gs[c * 144 + v] = f2bf(o[ni][j] * rsn * ng[ni] * siluf(gate));
    }
  }
  __syncthreads();
  bfu* Y = (bfu*)(p.ws + OFF_Y);
#pragma unroll
  for (int i = 0; i < 4; ++i) {
    const int idx = tid + 256 * i, row = idx >> 4, sg = idx & 15;
    *(uint4*)(Y + (t0 + row) * 1024 + h * 128 + sg * 8) = *(const uint4*)(Gs + row * 144 + sg * 8);
  }
}

DEV void phase_ln1_router(const Params& p, const float* __restrict__ Xin, int layer, unsigned char* smem) {
  const bfu* MIX = (const bfu*)(p.ws + OFF_MIX);
  float* X1 = (float*)(p.ws + OFF_X1);
  bfu* X1b = (bfu*)(p.ws + OFF_X1B);
  const float* g1 = p.ln1_g + layer * 1024;
  const float* b1 = p.ln1_b + layer * 1024;
  const float* wg = p.w_group + (size_t)layer * 1024 * 4;
  const float* we = p.w_expert + (size_t)layer * 1024 * 16;
  const float* bg = p.b_group + layer * 4;
  const float* be = p.b_expert + layer * 16;
  float* tokw = (float*)(p.ws + S_TOKW);
  int* list = (int*)(p.ws + S_LIST);
  int* gcnt = (int*)(p.ws + S_CNT) + layer * 32;
  float* Wes = (float*)smem;
  int* tokb = (int*)(smem + 65536);
  int* lcnt = tokb + 64;
  int* lbase = lcnt + 32;
  int* lpos = lbase + 32;
  const int tid = my_tid(), lane = tid & 63, w = tid >> 6;
  __syncthreads();
  {
    float4 wv[16];
#pragma unroll
    for (int i = 0; i < 16; ++i) wv[i] = *(const float4*)(we + (size_t)(tid + 256 * i) * 4);
#pragma unroll
    for (int i = 0; i < 16; ++i) {
      const int idx = tid + 256 * i, d = idx >> 2, c4 = idx & 3;
      Wes[(c4 * 4 + 0) * 1024 + d] = wv[i].x; Wes[(c4 * 4 + 1) * 1024 + d] = wv[i].y;
      Wes[(c4 * 4 + 2) * 1024 + d] = wv[i].z; Wes[(c4 * 4 + 3) * 1024 + d] = wv[i].w;
    }
  }
  __syncthreads();
  for (int it = blockIdx.x; it < T / 64; it += gridDim.x) {
    const int tb = it * 64;
    __syncthreads();
    if (tid < 24) lcnt[tid] = 0;
    float4 nxa[4]; uint2 nxm[4];
    {
      const size_t tn = (size_t)tb + w * 16;
#pragma unroll
      for (int i = 0; i < 4; ++i) {
        nxa[i] = *(const float4*)(Xin + tn * 1024 + i * 256 + lane * 4);
        nxm[i] = *(const uint2*)(MIX + tn * 1024 + i * 256 + lane * 4);
      }
    }
    for (int tk = 0; tk < 16; ++tk) {
      const size_t t = (size_t)tb + w * 16 + tk;
      float4 cxa[4]; uint2 cxm[4];
#pragma unroll
      for (int i = 0; i < 4; ++i) { cxa[i] = nxa[i]; cxm[i] = nxm[i]; }
      {
        const size_t tn = (size_t)tb + w * 16 + (tk < 15 ? tk + 1 : 15);
#pragma unroll
        for (int i = 0; i < 4; ++i) {
          nxa[i] = *(const float4*)(Xin + tn * 1024 + i * 256 + lane * 4);
          nxm[i] = *(const uint2*)(MIX + tn * 1024 + i * 256 + lane * 4);
        }
      }
      float xv[16];
      float s = 0.f;
#pragma unroll
      for (int i = 0; i < 4; ++i) {
        const float4 a = cxa[i];
        const float4 m = make_float4(__uint_as_float(cxm[i].x << 16), __uint_as_float(cxm[i].x & 0xffff0000u), __uint_as_float(cxm[i].y << 16), __uint_as_float(cxm[i].y & 0xffff0000u));
        xv[4 * i] = ALPHA * a.x + m.x; xv[4 * i + 1] = ALPHA * a.y + m.y;
        xv[4 * i + 2] = ALPHA * a.z + m.z; xv[4 * i + 3] = ALPHA * a.w + m.w;
        s += xv[4 * i] + xv[4 * i + 1] + xv[4 * i + 2] + xv[4 * i + 3];
      }
      const float mu = wave_sum(s) * (1.f / 1024.f);
      float vs = 0.f;
#pragma unroll
      for (int e = 0; e < 16; ++e) { float d = xv[e] - mu; vs += d * d; }
      const float rstd = rsqrtf(wave_sum(vs) * (1.f / 1024.f) + 1e-5f);
      float acc[20];
#pragma unroll
      for (int c = 0; c < 20; ++c) acc[c] = 0.f;
#pragma unroll
      for (int i = 0; i < 4; ++i) {
        float4 gg = *(const float4*)(g1 + i * 256 + lane * 4);
        float4 bb = *(const float4*)(b1 + i * 256 + lane * 4);
        const float o0 = (xv[4 * i] - mu) * rstd * gg.x + bb.x;
        const float o1 = (xv[4 * i + 1] - mu) * rstd * gg.y + bb.y;
        const float o2 = (xv[4 * i + 2] - mu) * rstd * gg.z + bb.z;
        const float o3 = (xv[4 * i + 3] - mu) * rstd * gg.w + bb.w;
        *(uint2*)(X1b + t * 1024 + i * 256 + lane * 4) = make_uint2(pack2(o0, o1), pack2(o2, o3));
#pragma unroll
        for (int c = 0; c < 16; ++c) {
          float4 wv = *(const float4*)(Wes + c * 1024 + i * 256 + lane * 4);
          acc[4 + c] += o0 * wv.x + o1 * wv.y + o2 * wv.z + o3 * wv.w;
        }
        const float* wgp = wg + (size_t)(i * 256 + lane * 4) * 4;
        float4 q0 = *(const float4*)(wgp), q1 = *(const float4*)(wgp + 4), q2 = *(const float4*)(wgp + 8), q3 = *(const float4*)(wgp + 12);
        acc[0] += o0 * q0.x + o1 * q1.x + o2 * q2.x + o3 * q3.x;
        acc[1] += o0 * q0.y + o1 * q1.y + o2 * q2.y + o3 * q3.y;
        acc[2] += o0 * q0.z + o1 * q1.z + o2 * q2.z + o3 * q3.z;
        acc[3] += o0 * q0.w + o1 * q1.w + o2 * q2.w + o3 * q3.w;
      }
#pragma unroll
      for (int c = 0; c < 20; ++c) acc[c] = wave_sum(acc[c]);
      float lg[4];
#pragma unroll
      for (int c = 0; c < 4; ++c) lg[c] = acc[c] + bg[c];
      int gi = 0; float gm = lg[0];
#pragma unroll
      for (int c = 1; c < 4; ++c) if (lg[c] > gm) { gm = lg[c]; gi = c; }
      float gs = 0.f;
#pragma unroll
      for (int c = 0; c < 4; ++c) gs += __expf(lg[c] - gm);
      const float gtop = 1.f / gs;
      float ev[4] = {0.f, 0.f, 0.f, 0.f};
#pragma unroll
      for (int gg = 0; gg < 4; ++gg)
#pragma unroll
        for (int c = 0; c < 4; ++c) if (gi == gg) ev[c] = acc[4 + gg * 4 + c] + be[gg * 4 + c];
      int i1 = 0; float v1 = ev[0];
#pragma unroll
      for (int c = 1; c < 4; ++c) if (ev[c] > v1) { v1 = ev[c]; i1 = c; }
      int i2 = -1; float v2 = -3e38f;
#pragma unroll
      for (int c = 0; c < 4; ++c) if (c != i1 && ev[c] > v2) { v2 = ev[c]; i2 = c; }
      const float ex = __expf(v2 - v1);
      const float w1 = gtop / (1.f + ex), w2 = gtop * ex / (1.f + ex);
      const int lo = min(i1, i2), hi = max(i1, i2);
      const float wlo = (i1 < i2) ? w1 : w2, whi = (i1 < i2) ? w2 : w1;
      const int pi = (lo == 0) ? (hi - 1) : ((lo == 1) ? (hi + 1) : 5);
      if (lane == 0) {
        const int tl = w * 16 + tk;
        tokb[tl] = gi * 6 + pi;
        tokw[(size_t)(tb + tl) * 2] = wlo;
        tokw[(size_t)(tb + tl) * 2 + 1] = whi;
      }
    }
    __syncthreads();
    int myb = 0;
    if (tid < 64) { myb = tokb[tid]; lpos[tid] = atomicAdd(&lcnt[myb], 1); }
    __syncthreads();
    if (tid < 24) { int c = lcnt[tid]; lbase[tid] = c ? atomicAdd(&gcnt[tid], c) : 0; }
    __syncthreads();
    if (tid < 64) list[(size_t)myb * T + lbase[myb] + lpos[tid]] = tb + tid;
  }
}

struct MoeTile { int bk, r0, cnt, srow0, elo, ehi; };
DEV int moe_total_tiles(const int* gcnt) {
  int tot = 0;
  for (int b = 0; b < 24; ++b) tot += (gcnt[b] + 127) >> 7;
  return tot;
}
DEV MoeTile moe_find(const int* gcnt, int tile) {
  MoeTile r; int acc = 0, srow = 0; r.bk = 0; r.r0 = 0; r.cnt = 0; r.srow0 = 0;
  for (int b = 0; b < 24; ++b) {
    int c = gcnt[b]; int nt = (c + 127) >> 7;
    if (tile >= acc && tile < acc + nt) { r.bk = b; r.r0 = (tile - acc) * 128; r.cnt = c; r.srow0 = srow; }
    acc += nt; srow += c;
  }
  int g = r.bk / 6, pi = r.bk - g * 6;
  int lo = (pi < 3) ? 0 : ((pi < 5) ? 1 : 2);
  int hi = (pi < 3) ? pi + 1 : ((pi < 5) ? pi - 1 : 3);
  r.elo = g * 4 + lo; r.ehi = g * 4 + hi;
  return r;
}

DEV void phase_moe1(const Params& p, int layer, unsigned char* smem) {
  const int* gcnt = (const int*)(p.ws + S_CNT) + layer * 32;
  const int* list = (const int*)(p.ws + S_LIST);
  const float* tokw = (const float*)(p.ws + S_TOKW);
  const bfu* X1b = (const bfu*)(p.ws + OFF_X1B);
  const bfu* Wgu = (const bfu*)(p.ws + OFF_WGU) + (size_t)layer * 16 * 512 * 1024;
  bfu* H = (bfu*)(p.ws + OFF_H);
  const int total = moe_total_tiles(gcnt) * 8;
  const int r0 = my_tid() >> 3;
  auto mkA = [&](const MoeTile& mt) {
    GatherLoader g;
    g.base = X1b;
#pragma unroll
    for (int i = 0; i < 4; ++i) {
      const int r = mt.r0 + r0 + 32 * i;
      const int tok = list[(size_t)mt.bk * T + (r < mt.cnt ? r : 0)];
      g.off[i] = (unsigned)tok * 1024u;
    }
    return g;
  };
  auto mkB = [&](const MoeTile& mt, int nt) {
    const int ex = (nt < 4) ? mt.elo : mt.ehi;
    return RowLoader{Wgu, (unsigned)(ex * 512 + (nt & 3) * 128 + r0) * 1024u, 32768u};
  };
  GemmPipe gp;
  bool first = true;
  int it = blockIdx.x;
  if (it >= total) return;
  MoeTile mt = moe_find(gcnt, it >> 3);
  GatherLoader al = mkA(mt);
  RowLoader bl = mkB(mt, it & 7);
  for (;;) {
    const int nt = it & 7;
    const int itn = it + gridDim.x;
    const bool hasNext = itn < total;
    const int itq = hasNext ? itn : it;
    const MoeTile mtn = moe_find(gcnt, itq >> 3);
    const GatherLoader aln = mkA(mtn);
    const RowLoader bln = mkB(mtn, itq & 7);
    auto epi = [&](f32x4(&acc)[4][4], int wm, int wn, int l15, int lq) {
      const int q = (nt & 3) * 2 + wn;
#pragma unroll
      for (int bi = 0; bi < 4; ++bi) {
        const int r = mt.r0 + wm * 64 + bi * 16 + l15;
        if (r < mt.cnt) {
          const int tok = list[(size_t)mt.bk * T + r];
          const float gw = tokw[(size_t)tok * 2 + (nt >> 2)];
#pragma unroll
          for (int ai = 0; ai < 2; ++ai) {
            float o[4];
#pragma unroll
            for (int j = 0; j < 4; ++j) o[j] = siluf(acc[ai][bi][j]) * acc[ai + 2][bi][j] * gw;
            *(uint2*)(H + (size_t)(mt.srow0 + r) * 512 + (nt >> 2) * 256 + q * 32 + ai * 16 + lq * 4) =
                make_uint2(pack2(o[0], o[1]), pack2(o[2], o[3]));
          }
        }
      }
    };
    gemm128(true, 1024, first, hasNext, al, bl, aln, bln, epi, gp, smem);
    first = false;
    if (!hasNext) break;
    it = itn; mt = mtn; al = aln; bl = bln;
  }
}

DEV void phase_moe2(const Params& p, int layer, unsigned char* smem) {
  const int* gcnt = (const int*)(p.ws + S_CNT) + layer * 32;
  const int* list = (const int*)(p.ws + S_LIST);
  const bfu* H = (const bfu*)(p.ws + OFF_H);
  const bfu* Wdn = (const bfu*)(p.ws + OFF_WDN) + (size_t)layer * 16 * 1024 * 256;
  bfu* FF = (bfu*)(p.ws + OFF_MIX);
  const int total = moe_total_tiles(gcnt) * 8;
  const int r0 = my_tid() >> 3;
  auto mkA = [&](const MoeTile& mt) { return RowLoader{H, (unsigned)(mt.srow0 + mt.r0 + r0) * 512u, 16384u}; };
  auto mkB = [&](const MoeTile& mt, int nt) {
    return SplitKLoader{Wdn, (unsigned)(mt.elo * 1024 + nt * 128 + r0) * 256u, (unsigned)((mt.ehi - mt.elo) * 1024) * 256u};
  };
  GemmPipe gp;
  bool first = true;
  int it = blockIdx.x;
  if (it >= total) return;
  MoeTile mt = moe_find(gcnt, it >> 3);
  RowLoader al = mkA(mt);
  SplitKLoader bl = mkB(mt, it & 7);
  for (;;) {
    const int nt = it & 7;
    const int itn = it + gridDim.x;
    const bool hasNext = itn < total;
    const int itq = hasNext ? itn : it;
    const MoeTile mtn = moe_find(gcnt, itq >> 3);
    const RowLoader aln = mkA(mtn);
    const SplitKLoader bln = mkB(mtn, itq & 7);
    auto epi = [&](f32x4(&acc)[4][4], int wm, int wn, int l15, int lq) {
#pragma unroll
      for (int bi = 0; bi < 4; ++bi) {
        const int r = mt.r0 + wm * 64 + bi * 16 + l15;
        if (r < mt.cnt) {
          const int tok = list[(size_t)mt.bk * T + r];
#pragma unroll
          for (int ai = 0; ai < 4; ++ai)
            *(uint2*)(FF + (size_t)tok * 1024 + nt * 128 + wn * 64 + ai * 16 + lq * 4) =
                make_uint2(pack2(acc[ai][bi][0], acc[ai][bi][1]), pack2(acc[ai][bi][2], acc[ai][bi][3]));
        }
      }
    };
    gemm128(true, 512, first, hasNext, al, bl, aln, bln, epi, gp, smem);
    first = false;
    if (!hasNext) break;
    it = itn; mt = mtn; al = aln; bl = bln;
  }
}

DEV void phase_ln2(const Params& p, int layer, float* __restrict__ outp, bfu* __restrict__ outb) {
  const bfu* X1b = (const bfu*)(p.ws + OFF_X1B);
  const bfu* FF = (const bfu*)(p.ws + OFF_MIX);
  const float* g2 = p.ln2_g + layer * 1024;
  const float* b2 = p.ln2_b + layer * 1024;
  const int lane = my_tid() & 63, w = my_tid() >> 6;
  const int stride = gridDim.x * 4;
  int t = blockIdx.x * 4 + w;
  if (t >= T) return;
  uint2 nxa[4]; uint2 nxm[4];
#pragma unroll
  for (int i = 0; i < 4; ++i) {
    nxa[i] = *(const uint2*)(X1b + (size_t)t * 1024 + i * 256 + lane * 4);
    nxm[i] = *(const uint2*)(FF + (size_t)t * 1024 + i * 256 + lane * 4);
  }
  for (; t < T; t += stride) {
    uint2 cxa[4]; uint2 cxm[4];
#pragma unroll
    for (int i = 0; i < 4; ++i) { cxa[i] = nxa[i]; cxm[i] = nxm[i]; }
    {
      const int tn = (t + stride < T) ? t + stride : t;
#pragma unroll
      for (int i = 0; i < 4; ++i) {
        nxa[i] = *(const uint2*)(X1b + (size_t)tn * 1024 + i * 256 + lane * 4);
        nxm[i] = *(const uint2*)(FF + (size_t)tn * 1024 + i * 256 + lane * 4);
      }
    }
    float xv[16];
    float s = 0.f;
#pragma unroll
    for (int i = 0; i < 4; ++i) {
      const uint2 ab_ = cxa[i];
      const float4 a = make_float4(__uint_as_float(ab_.x << 16), __uint_as_float(ab_.x & 0xffff0000u), __uint_as_float(ab_.y << 16), __uint_as_float(ab_.y & 0xffff0000u));
      const uint2 mb = cxm[i];
      const float4 m = make_float4(__uint_as_float(mb.x << 16), __uint_as_float(mb.x & 0xffff0000u), __uint_as_float(mb.y << 16), __uint_as_float(mb.y & 0xffff0000u));
      xv[4 * i] = ALPHA * a.x + m.x; xv[4 * i + 1] = ALPHA * a.y + m.y;
      xv[4 * i + 2] = ALPHA * a.z + m.z; xv[4 * i + 3] = ALPHA * a.w + m.w;
      s += xv[4 * i] + xv[4 * i + 1] + xv[4 * i + 2] + xv[4 * i + 3];
    }
    const float mu = wave_sum(s) * (1.f / 1024.f);
    float vs = 0.f;
#pragma unroll
    for (int e = 0; e < 16; ++e) { float d = xv[e] - mu; vs += d * d; }
    const float rstd = rsqrtf(wave_sum(vs) * (1.f / 1024.f) + 1e-5f);
#pragma unroll
    for (int i = 0; i < 4; ++i) {
      float4 gg = *(const float4*)(g2 + i * 256 + lane * 4);
      float4 bb = *(const float4*)(b2 + i * 256 + lane * 4);
      const float o0 = (xv[4 * i] - mu) * rstd * gg.x + bb.x, o1 = (xv[4 * i + 1] - mu) * rstd * gg.y + bb.y;
      const float o2 = (xv[4 * i + 2] - mu) * rstd * gg.z + bb.z, o3 = (xv[4 * i + 3] - mu) * rstd * gg.w + bb.w;
      *(float4*)(outp + (size_t)t * 1024 + i * 256 + lane * 4) = make_float4(o0, o1, o2, o3);
      if (outb) *(uint2*)(outb + (size_t)t * 1024 + i * 256 + lane * 4) = make_uint2(pack2(o0, o1), pack2(o2, o3));
    }
  }
}

template <int NK, bool SINK, typename KP, typename VP, typename MK, typename OUT>
DEV void attn_core(const bfu* qptr, KP kptr, VP vptr, MK maskf, float sink, OUT outf, unsigned char* smem) {
  constexpr int NT = NK / 16;
  constexpr int VS = NK + 16;
  constexpr int KS = 80;
  bfu* Ks = (bfu*)smem;
  bfu* Ps = Ks;
  bfu* Vt = Ks + NK * KS;
  const int tid = my_tid(), lane = tid & 63, w = tid >> 6, l15 = lane & 15, lq = lane >> 4;
  uint4 k0, k1, k2, k3, k4, k5, k6, k7, v0, v1, v2, v3, v4, v5, v6, v7;
#define ATT_LD(i) if constexpr (i < NK / 32) { const int idx = tid + 256 * i; const int kk = idx >> 3, sg = idx & 7; \
    k##i = *(const uint4*)(kptr(kk) + sg * 8); const int d = idx / (NK / 8), k8 = idx - d * (NK / 8); v##i = *(const uint4*)(vptr(d, k8)); }
  ATT_LD(0) ATT_LD(1) ATT_LD(2) ATT_LD(3) ATT_LD(4) ATT_LD(5) ATT_LD(6) ATT_LD(7)
#undef ATT_LD
  const uint4 qf0 = *(const uint4*)(qptr + lq * 8), qf1 = *(const uint4*)(qptr + 32 + lq * 8);
  __syncthreads();
#define ATT_ST(i) if constexpr (i < NK / 32) { const int idx = tid + 256 * i; const int kk = idx >> 3, sg = idx & 7; \
    *(uint4*)(Ks + kk * KS + sg * 8) = k##i; const int d = idx / (NK / 8), k8 = idx - d * (NK / 8); *(uint4*)(Vt + d * VS + k8 * 8) = v##i; }
  ATT_ST(0) ATT_ST(1) ATT_ST(2) ATT_ST(3) ATT_ST(4) ATT_ST(5) ATT_ST(6) ATT_ST(7)
#undef ATT_ST
  __syncthreads();
  f32x4 s[NT];
#pragma unroll
  for (int ni = 0; ni < NT; ++ni) {
    f32x4 a = f32x4{0.f, 0.f, 0.f, 0.f};
    a = mfma16(lds128(Ks + (ni * 16 + l15) * KS + lq * 8), qf0, a);
    a = mfma16(lds128(Ks + (ni * 16 + l15) * KS + 32 + lq * 8), qf1, a);
    s[ni] = a;
  }
  const int row = 16 * w + l15;
  float mx = NEGF;
#pragma unroll
  for (int ni = 0; ni < NT; ++ni)
#pragma unroll
    for (int j = 0; j < 4; ++j) {
      const int kk = ni * 16 + lq * 4 + j;
      float v = maskf(row, kk) ? s[ni][j] * 0.125f : NEGF;
      s[ni][j] = v;
      mx = fmaxf(mx, v);
    }
  mx = fmaxf(mx, __shfl_xor(mx, 16));
  mx = fmaxf(mx, __shfl_xor(mx, 32));
  if (SINK) mx = fmaxf(mx, sink);
  float ls = 0.f;
#pragma unroll
  for (int ni = 0; ni < NT; ++ni)
#pragma unroll
    for (int j = 0; j < 4; ++j) {
      float pv = __expf(s[ni][j] - mx);
      ls += pv;
      s[ni][j] = pv;
    }
  ls += __shfl_xor(ls, 16);
  ls += __shfl_xor(ls, 32);
  if (SINK) ls += __expf(sink - mx);
  __syncthreads();
#pragma unroll
  for (int ni = 0; ni < NT; ++ni)
    *(uint2*)(Ps + row * VS + ni * 16 + lq * 4) = make_uint2(pack2(s[ni][0], s[ni][1]), pack2(s[ni][2], s[ni][3]));
  __syncthreads();
  f32x4 o[4];
#pragma unroll
  for (int ni = 0; ni < 4; ++ni) o[ni] = f32x4{0.f, 0.f, 0.f, 0.f};
#pragma unroll
  for (int ks = 0; ks < NK / 32; ++ks) {
    uint4 pb = lds128(Ps + row * VS + ks * 32 + lq * 8);
#pragma unroll
    for (int ni = 0; ni < 4; ++ni) o[ni] = mfma16(lds128(Vt + (ni * 16 + l15) * VS + ks * 32 + lq * 8), pb, o[ni]);
  }
#pragma unroll
  for (int ni = 0; ni < 4; ++ni) outf(row, ni * 16 + lq * 4, o[ni], mx, ls);
}

DEV void swa_item(const Params& p, int it, unsigned char* smem) {
  const int h = it & 7, qt = (it >> 3) & 255, b = it >> 11;
  const int hk = h >> 2;
  const int t0 = qt * 64, kstart = t0 - 128;
  const bfu* P = (const bfu*)(p.ws + OFF_P);
  bfu* Y = (bfu*)(p.ws + OFF_Y);
  const int lane = my_tid() & 63, w = my_tid() >> 6, l15 = lane & 15;
  const bfu* qptr = P + ((size_t)b * L + t0 + 16 * w + l15) * 1536 + h * 64;
  const bfu* kb = P + (size_t)b * L * 1536 + 512 + hk * 64;
  auto kptr = [&](int kk) -> const bfu* { int pos = kstart + kk; pos = pos < 0 ? 0 : pos; return kb + (size_t)pos * 1536; };
  const bfu* vtb = (const bfu*)(p.ws + OFF_VT) + (size_t)((0 * 2 + b) * 2 + hk) * 64 * L;
  auto vptr = [&](int d, int k8) -> const bfu* { int pos = kstart + k8 * 8; pos = pos < 0 ? 0 : pos; return vtb + (size_t)d * L + pos; };
  auto maskf = [&](int row, int kk) -> bool { int pos = kstart + kk, t = t0 + row; return pos >= 0 && pos <= t && (t - pos) < 128; };
  auto outf = [&](int row, int d0, f32x4 o, float m, float l) {
    const float inv = 1.f / l;
    *(uint2*)(Y + ((size_t)b * L + t0 + row) * 1024 + h * 64 + d0) = make_uint2(pack2(o[0] * inv, o[1] * inv), pack2(o[2] * inv, o[3] * inv));
  };
  attn_core<192, true>(qptr, kptr, vptr, maskf, p.od_sinks[h], outf, smem);
}

DEV void kmean_item(const Params& p, int it, unsigned char* smem) {
  const int j = it & 63, bhk = it >> 6, b = bhk >> 1, hk = bhk & 1;
  const bfu* P = (const bfu*)(p.ws + OFF_P);
  float* red = (float*)smem;
  const int tid = my_tid(), d = tid & 63, part = tid >> 6;
  const bfu* kb = P + ((size_t)b * L + j * 256 + part * 64) * 1536 + 1280 + hk * 64 + d;
  float s = 0.f;
  for (int i = 0; i < 64; ++i) s += bf2f(kb[(size_t)i * 1536]);
  __syncthreads();
  red[part * 64 + d] = s;
  __syncthreads();
  if (tid < 64) {
    float tot = red[tid] + red[64 + tid] + red[128 + tid] + red[192 + tid];
    ((bfu*)(p.ws + S_KMEAN))[(size_t)it * 64 + tid] = f2bf(tot * (1.f / 256.f));
  }
}

DEV int cap_off(int j) { return 1024 * (63 * j - (j * (j - 1)) / 2); }

DEV void moba_own_item(const Params& p, int it, unsigned char* smem) {
  const int h = it & 7, o4 = (it >> 3) & 3, c = (it >> 5) & 63, b = it >> 11;
  const int hk = h >> 2, g = h & 3;
  const int t0 = c * 256 + o4 * 64;
  const bfu* P = (const bfu*)(p.ws + OFF_P);
  bfu* PO = (bfu*)(p.ws + OFF_PO);
  float* PM = (float*)(p.ws + OFF_PM);
  float* PL = (float*)(p.ws + OFF_PL);
  const int tid = my_tid(), lane = tid & 63, w = tid >> 6, l15 = lane & 15, lq = lane >> 4;
  const bfu* qptr = P + ((size_t)b * L + t0 + 16 * w + l15) * 1536 + 768 + h * 64;
  const bfu* kb = P + ((size_t)b * L + c * 256) * 1536 + 1280 + hk * 64;
  auto kptr = [&](int kk) -> const bfu* { return kb + (size_t)kk * 1536; };
  const bfu* vtb = (const bfu*)(p.ws + OFF_VT) + (size_t)((1 * 2 + b) * 2 + hk) * 64 * L + c * 256;
  auto vptr = [&](int d, int k8) -> const bfu* { return vtb + (size_t)d * L + k8 * 8; };
  auto maskf = [&](int row, int kk) -> bool { return kk <= o4 * 64 + row; };
  auto outf = [&](int row, int d0, f32x4 o, float m, float l) {
    const size_t idx = (((size_t)b * L + t0 + row) * 8 + h) * 4;
    const float inv = 1.f / l;
    *(uint2*)(PO + idx * 64 + d0) = make_uint2(pack2(o[0] * inv, o[1] * inv), pack2(o[2] * inv, o[3] * inv));
    if (d0 == 0) { PM[idx] = m; PL[idx] = l; }
  };
  attn_core<256, false>(qptr, kptr, vptr, maskf, 0.f, outf, smem);
  int* lcnt = (int*)(smem + SM_AUX);
  int* lbase = lcnt + 64;
  int* sel = lbase + 64;
  if (tid < 64) lcnt[tid] = 0;
  __syncthreads();
  const uint4 qf0 = *(const uint4*)(qptr + lq * 8), qf1 = *(const uint4*)(qptr + 32 + lq * 8);
  const bfu* km = (const bfu*)(p.ws + S_KMEAN) + (size_t)(b * 2 + hk) * 64 * 64;
  float cand[4][4];
#pragma unroll
  for (int ni = 0; ni < 4; ++ni) {
    f32x4 a = f32x4{0.f, 0.f, 0.f, 0.f};
    a = mfma16(qf0, *(const uint4*)(km + (ni * 16 + l15) * 64 + lq * 8), a);
    a = mfma16(qf1, *(const uint4*)(km + (ni * 16 + l15) * 64 + 32 + lq * 8), a);
#pragma unroll
    for (int j = 0; j < 4; ++j) cand[ni][j] = (ni * 16 + l15 < c) ? a[j] : -3e38f;
  }
#pragma unroll
  for (int j = 0; j < 4; ++j) {
    const int row = 16 * w + lq * 4 + j;
#pragma unroll
    for (int sl = 0; sl < 3; ++sl) {
      float bv = cand[0][j]; int bi = l15;
#pragma unroll
      for (int ni = 1; ni < 4; ++ni) if (cand[ni][j] > bv) { bv = cand[ni][j]; bi = ni * 16 + l15; }
#pragma unroll
      for (int off = 8; off >= 1; off >>= 1) {
        float ov = __shfl_xor(bv, off); int oi = __shfl_xor(bi, off);
        if (ov > bv || (ov == bv && oi < bi)) { bv = ov; bi = oi; }
      }
      const bool valid = bv > -1e38f;
#pragma unroll
      for (int ni = 0; ni < 4; ++ni) if (ni * 16 + l15 == bi) cand[ni][j] = -3e38f;
      if (l15 == 0) {
        const size_t idx = (((size_t)b * L + t0 + row) * 8 + h) * 4 + 1 + sl;
        if (valid) {
          int lp = atomicAdd(&lcnt[bi], 1);
          sel[row * 3 + sl] = bi | (lp << 8);
        } else {
          sel[row * 3 + sl] = -1;
          PM[idx] = NEGF; PL[idx] = 0.f;
        }
      }
    }
  }
  __syncthreads();
  int* gcnt = (int*)(p.ws + S_CNT) + 64 + (b * 2 + hk) * 64;
  if (tid < 64) { int cc = lcnt[tid]; lbase[tid] = cc ? atomicAdd(&gcnt[tid], cc) : 0; }
  __syncthreads();
  if (tid < 192) {
    const int row = tid / 3, sl = tid - row * 3;
    const int sv = sel[tid];
    if (sv >= 0) {
      const int bi = sv & 255, lp = sv >> 8;
      int* bucket = (int*)(p.ws + OFF_BUCK) + (size_t)(b * 2 + hk) * BUCK_PER_BH + cap_off(bi);
      bucket[lbase[bi] + lp] = ((t0 + row) << 4) | (g << 2) | (sl + 1);
    }
  }
}

DEV void phase_moba_bucket(const Params& p, unsigned char* smem) {
  int* pref = (int*)(smem + SM_AUX);
  const int* gcnt = (const int*)(p.ws + S_CNT) + 64;
  const int tid = my_tid(), lane = tid & 63, w = tid >> 6, l15 = lane & 15;
  {
    int nt = (gcnt[tid] + 63) >> 6;
    __syncthreads();
    pref[tid] = nt;
    __syncthreads();
    for (int off = 1; off < 256; off <<= 1) {
      int v = pref[tid];
      if (tid >= off) v += pref[tid - off];
      __syncthreads();
      pref[tid] = v;
      __syncthreads();
    }
  }
  const int total = pref[255];
  const bfu* P = (const bfu*)(p.ws + OFF_P);
  bfu* PO = (bfu*)(p.ws + OFF_PO);
  float* PM = (float*)(p.ws + OFF_PM);
  float* PL = (float*)(p.ws + OFF_PL);
  const int lq = lane >> 4;
  struct Item { int bk, cnt, rbase; };
  auto decode = [&](int it) -> Item {
    int lo = 0, hi = 255;
    while (lo < hi) { int mid = (lo + hi) >> 1; if (pref[mid] > it) hi = mid; else lo = mid + 1; }
    Item r; r.bk = lo; r.cnt = gcnt[lo];
    const int ntb = (r.cnt + 63) >> 6;
    r.rbase = (it - (pref[lo] - ntb)) * 64;
    return r;
  };
  auto bucket_of = [&](int bk) -> const int* {
    return (const int*)(p.ws + OFF_BUCK) + (size_t)(bk >> 6) * BUCK_PER_BH + cap_off(bk & 63);
  };
  auto load_entries = [&](const Item& im, int& e, int (&en)[4]) {
    const int* bucket = bucket_of(im.bk);
    const int rr = im.rbase + 16 * w + l15;
    e = bucket[rr < im.cnt ? rr : 0];
#pragma unroll
    for (int j = 0; j < 4; ++j) { const int r = im.rbase + 16 * w + lq * 4 + j; en[j] = bucket[r < im.cnt ? r : 0]; }
  };
  int it = blockIdx.x;
  if (it >= total) return;
  Item cur = decode(it);
  int e, en[4];
  load_entries(cur, e, en);
  for (;;) {
    const int itn = it + gridDim.x;
    const bool hasNext = itn < total;
    Item nxt = cur; int e2 = e, en2[4] = {en[0], en[1], en[2], en[3]};
    if (hasNext) { nxt = decode(itn); load_entries(nxt, e2, en2); }
    const int bk = cur.bk, cnt = cur.cnt, rbase = cur.rbase;
    const int j = bk & 63, bhk = bk >> 6, b = bhk >> 1, hk = bhk & 1;
    const bfu* qptr = P + ((size_t)b * L + (e >> 4)) * 1536 + 768 + (hk * 4 + ((e >> 2) & 3)) * 64;
    const bfu* kb = P + ((size_t)b * L + j * 256) * 1536 + 1280 + hk * 64;
    auto kptr = [&](int kk) -> const bfu* { return kb + (size_t)kk * 1536; };
    const bfu* vtb = (const bfu*)(p.ws + OFF_VT) + (size_t)((1 * 2 + b) * 2 + hk) * 64 * L + j * 256;
    auto vptr = [&](int d, int k8) -> const bfu* { return vtb + (size_t)d * L + k8 * 8; };
    auto maskf = [&](int row, int kk) -> bool { return true; };
    auto outf = [&](int row, int d0, f32x4 o, float m, float l) {
      if (rbase + row < cnt) {
        const size_t idx = (((size_t)b * L + (e >> 4)) * 8 + hk * 4 + ((e >> 2) & 3)) * 4 + (e & 3);
        const float inv = 1.f / l;
        *(uint2*)(PO + idx * 64 + d0) = make_uint2(pack2(o[0] * inv, o[1] * inv), pack2(o[2] * inv, o[3] * inv));
        if (d0 == 0) { PM[idx] = m; PL[idx] = l; }
      }
    };
    attn_core<256, false>(qptr, kptr, vptr, maskf, 0.f, outf, smem);
    if (!hasNext) break;
    it = itn; cur = nxt; e = e2;
#pragma unroll
    for (int q = 0; q < 4; ++q) en[q] = en2[q];
  }
}

DEV void phase_moba_merge(const Params& p) {
  const bfu* PO = (const bfu*)(p.ws + OFF_PO);
  const float* PM = (const float*)(p.ws + OFF_PM);
  const float* PL = (const float*)(p.ws + OFF_PL);
  bfu* Y = (bfu*)(p.ws + OFF_Y);
  const size_t total = (size_t)T * 8 * 8;
  for (size_t id = (size_t)blockIdx.x * 256 + my_tid(); id < total; id += (size_t)gridDim.x * 256) {
    const int ds = (int)(id & 7);
    const size_t th = id >> 3;
    const float4 m4 = *(const float4*)(PM + th * 4);
    const float4 l4 = *(const float4*)(PL + th * 4);
    float mm[4] = {m4.x, m4.y, m4.z, m4.w}, ll[4] = {l4.x, l4.y, l4.z, l4.w};
    float M = mm[0];
#pragma unroll
    for (int s = 1; s < 4; ++s) if (ll[s] > 0.f) M = fmaxf(M, mm[s]);
    float wsum = 0.f;
    float acc[8] = {0.f, 0.f, 0.f, 0.f, 0.f, 0.f, 0.f, 0.f};
#pragma unroll
    for (int s = 0; s < 4; ++s) {
      if (s == 0 || ll[s] > 0.f) {
        const float wgt = ll[s] * __expf(mm[s] - M);
        wsum += wgt;
        uint4 ov = *(const uint4*)(PO + (th * 4 + s) * 64 + ds * 8);
        unsigned uu[4] = {ov.x, ov.y, ov.z, ov.w};
#pragma unroll
        for (int e = 0; e < 4; ++e) {
          acc[2 * e] += wgt * __uint_as_float(uu[e] << 16);
          acc[2 * e + 1] += wgt * __uint_as_float(uu[e] & 0xffff0000u);
        }
      }
    }
    const float inv = 1.f / wsum;
    const size_t t = th >> 3; const int h = (int)(th & 7);
    *(uint4*)(Y + t * 1024 + 512 + h * 64 + ds * 8) =
        make_uint4(pack2(acc[0] * inv, acc[1] * inv), pack2(acc[2] * inv, acc[3] * inv),
                   pack2(acc[4] * inv, acc[5] * inv), pack2(acc[6] * inv, acc[7] * inv));
  }
}


#define XB_TMO      128
#define XB_XCNT(j)  (256  + 64 * (j))
#define XB_XSUB(j)  (1280 + 64 * (j))
#define XB_XGEN(j)  (2304 + 64 * (j))
#define XB_TOP      3328
#define XB_TOPGEN   3392
#define XCD_BAR_WORDS 3456
#define XB_SPIN_CAP (1u << 22)
#define LAS __attribute__((address_space(3)))
DEV unsigned xb_ld(unsigned* p) { return __hip_atomic_load(p, __ATOMIC_RELAXED, __HIP_MEMORY_SCOPE_AGENT); }
DEV unsigned xb_add(unsigned* p, unsigned v) { return __hip_atomic_fetch_add(p, v, __ATOMIC_RELAXED, __HIP_MEMORY_SCOPE_AGENT); }
DEV unsigned xb_xcc_id() { return (unsigned)__builtin_amdgcn_s_getreg((3 << 11) | 20) & 0xFu; }
#define XB_SPIN(cond, bar) do { unsigned _sp = 0; while (cond) { __builtin_amdgcn_s_sleep(1); \
    if ((++_sp & 255u) == 0u) { if (xb_ld(&(bar)[XB_TMO])) break; if (_sp > XB_SPIN_CAP) { atomicAdd(&(bar)[XB_TMO], 1u); break; } } } } while (0)
struct XcdBarrier { unsigned* bar; unsigned x; volatile LAS unsigned* st; };
DEV XcdBarrier xcd_barrier_post(unsigned* bar, volatile LAS unsigned* st) {
  XcdBarrier b; b.bar = bar; b.x = xb_xcc_id(); b.st = st;
  if (threadIdx.x == 0) (void)xb_add(&bar[XB_XCNT(b.x)], 1u);
  return b;
}
DEV void xcd_barrier_complete(unsigned* bar, unsigned x, unsigned& nloc, unsigned& nx) {
  const unsigned G = gridDim.x * gridDim.y * gridDim.z;
  unsigned sum, cnt, mine, sp = 0u;
  for (;;) {
    sum = 0u; cnt = 0u; mine = 0u;
#pragma unroll
    for (unsigned j = 0; j < 16; ++j) { const unsigned c = xb_ld(&bar[XB_XCNT(j)]); sum += c; cnt += (c > 0u) ? 1u : 0u; mine = (j == x) ? c : mine; }
    if (sum == G) break;
    __builtin_amdgcn_s_sleep(1);
    if ((++sp & 255u) == 0u) { if (xb_ld(&bar[XB_TMO])) break; if (sp > XB_SPIN_CAP) { atomicAdd(&bar[XB_TMO], 1u); break; } }
  }
  nloc = mine > 0u ? mine : 1u; nx = cnt > 0u ? cnt : 1u;
}
DEV void xcd_barrier(const XcdBarrier& b) {
  asm volatile("s_waitcnt vmcnt(0)" ::: "memory");
  __syncthreads();
  if (threadIdx.x == 0) {
    unsigned* bar = b.bar;
    __builtin_amdgcn_s_waitcnt(0);
    unsigned nloc = b.st[0], nx = b.st[1];
    if (nloc == 0u) { xcd_barrier_complete(bar, b.x, nloc, nx); b.st[0] = nloc; b.st[1] = nx; }
    const unsigned old = xb_add(&bar[XB_XSUB(b.x)], 1u);
    const unsigned gen = old / nloc;
    if (old + 1u == (gen + 1u) * nloc) {
      __builtin_amdgcn_fence(__ATOMIC_RELEASE, "agent");
      asm volatile("s_waitcnt vmcnt(0)" ::: "memory");
      const unsigned og = xb_add(&bar[XB_TOP], 1u);
      const unsigned tg = og / nx;
      if (og + 1u == (tg + 1u) * nx) xb_add(&bar[XB_TOPGEN], 1u);
      else XB_SPIN(xb_ld(&bar[XB_TOPGEN]) == tg, bar);
      __builtin_amdgcn_fence(__ATOMIC_ACQUIRE, "agent");
      xb_add(&bar[XB_XGEN(b.x)], 1u);
      asm volatile("s_waitcnt vmcnt(0)" ::: "memory");
    } else {
      XB_SPIN(xb_ld(&bar[XB_XGEN(b.x)]) == gen, bar);
      __builtin_amdgcn_fence(__ATOMIC_ACQUIRE, "agent");
      asm volatile("s_waitcnt vmcnt(0)" ::: "memory");
    }
  }
  __syncthreads();
}

__global__ void __launch_bounds__(256, 2) mega(Params p) {
  __shared__ __attribute__((aligned(16))) unsigned char smem[SMEM_BYTES];
  cg::grid_group grid = cg::this_grid();
  unsigned char* ws = p.ws;
  unsigned* barw = (unsigned*)(ws + S_BAR);
  volatile LAS unsigned* xbst = (volatile LAS unsigned*)(smem + SMEM_BYTES - 16);
  if (threadIdx.x == 0) { xbst[0] = 0u; xbst[1] = 0u; }
  if (blockIdx.x == 0) for (int i = threadIdx.x; i < XCD_BAR_WORDS; i += 256) barw[i] = 0u;

#if XSYNC
  for (int i = 0; i < 20; ++i) grid.sync();
#endif
  phase_prep(p, smem);
#if (DUPMASK >> 0) & 1
  grid.sync();
  phase_prep(p, smem);
#endif
  grid.sync();
  XcdBarrier xb = xcd_barrier_post(barw, xbst);
  phase_proj((const bfu*)(ws + OFF_XB), (const bfu*)(ws + OFF_WEVIN), (bfu*)(ws + OFF_P), 2560, (bfu*)p.out, 0, smem);
#if (DUPMASK >> 1) & 1
  GSYNC;
  phase_proj((const bfu*)(ws + OFF_XB), (const bfu*)(ws + OFF_WEVIN), (bfu*)(ws + OFF_P), 2560, (bfu*)p.out, 0, smem);
#endif
  GSYNC;
  for (int it = blockIdx.x; it < 2048; it += gridDim.x) hgrn_dstate_item(p, it, smem);
  {
    uint4 bf[8], cf[4]; float2 ab; float dsk;
    s5_load_consts(p, (blockIdx.x & 7) * 4 + (my_tid() >> 6), my_tid() & 63, bf, cf, ab, dsk);
    for (int it = blockIdx.x; it < 4096; it += gridDim.x) s5_pass1_item(p, it, bf, ab, smem);
  }
#if (DUPMASK >> 2) & 1
  GSYNC;
  for (int it = blockIdx.x; it < 2048; it += gridDim.x) hgrn_dstate_item(p, it, smem);
  {
    uint4 bf[8], cf[4]; float2 ab; float dsk;
    s5_load_consts(p, (blockIdx.x & 7) * 4 + (my_tid() >> 6), my_tid() & 63, bf, cf, ab, dsk);
    for (int it = blockIdx.x; it < 4096; it += gridDim.x) s5_pass1_item(p, it, bf, ab, smem);
  }
#endif
  GSYNC;
  if (blockIdx.x < 64) hgrn_scan_item(p, blockIdx.x);
  else if (blockIdx.x < 80) s5_carry_item(p, blockIdx.x - 64);
#if (DUPMASK >> 3) & 1
  GSYNC;
  if (blockIdx.x < 64) hgrn_scan_item(p, blockIdx.x);
  else if (blockIdx.x < 80) s5_carry_item(p, blockIdx.x - 64);
#endif
  GSYNC;
  for (int it = blockIdx.x; it < 2048; it += gridDim.x) hgrn_out_item(p, it, smem);
  {
    uint4 bf[8], cf[4]; float2 ab; float dsk;
    s5_load_consts(p, (blockIdx.x & 7) * 4 + (my_tid() >> 6), my_tid() & 63, bf, cf, ab, dsk);
    for (int it = blockIdx.x; it < 4096; it += gridDim.x) s5_pass2_item(p, it, bf, cf, ab, dsk, smem);
  }
#if (DUPMASK >> 4) & 1
  GSYNC;
  for (int it = blockIdx.x; it < 2048; it += gridDim.x) hgrn_out_item(p, it, smem);
  {
    uint4 bf[8], cf[4]; float2 ab; float dsk;
    s5_load_consts(p, (blockIdx.x & 7) * 4 + (my_tid() >> 6), my_tid() & 63, bf, cf, ab, dsk);
    for (int it = blockIdx.x; it < 4096; it += gridDim.x) s5_pass2_item(p, it, bf, cf, ab, dsk, smem);
  }
#endif
  GSYNC;
  phase_glu(p, smem);
#if (DUPMASK >> 5) & 1
  GSYNC;
  phase_glu(p, smem);
#endif
  GSYNC;
  phase_outproj(p, (const bfu*)(ws + OFF_WEVOUT), smem);
#if (DUPMASK >> 6) & 1
  GSYNC;
  phase_outproj(p, (const bfu*)(ws + OFF_WEVOUT), smem);
#endif
  GSYNC;
  phase_ln1_router(p, p.x, 0, smem);
#if (DUPMASK >> 7) & 1
  GSYNC;
  if (blockIdx.x == 0 && my_tid() < 24) ((int*)(ws + S_CNT))[my_tid()] = 0;
  GSYNC;
  phase_ln1_router(p, p.x, 0, smem);
#endif
  GSYNC;
  phase_moe1(p, 0, smem);
#if (DUPMASK >> 8) & 1
  GSYNC;
  phase_moe1(p, 0, smem);
#endif
  GSYNC;
  phase_moe2(p, 0, smem);
#if (DUPMASK >> 9) & 1
  GSYNC;
  phase_moe2(p, 0, smem);
#endif
  GSYNC;
  phase_ln2(p, 0, p.out, (bfu*)(ws + OFF_X2B));
#if (DUPMASK >> 10) & 1
  GSYNC;
  phase_ln2(p, 0, p.out, (bfu*)(ws + OFF_X2B));
#endif
  GSYNC;
  phase_proj((const bfu*)(ws + OFF_X2B), (const bfu*)(ws + OFF_WODIN), (bfu*)(ws + OFF_P), 1536, (bfu*)(ws + OFF_VT), 1, smem);
#if (DUPMASK >> 11) & 1
  GSYNC;
  phase_proj((const bfu*)(ws + OFF_X2B), (const bfu*)(ws + OFF_WODIN), (bfu*)(ws + OFF_P), 1536, (bfu*)(ws + OFF_VT), 1, smem);
#endif
  GSYNC;
  for (int it = blockIdx.x; it < 4096 + 256; it += gridDim.x) {
    if (it < 4096) swa_item(p, it, smem); else kmean_item(p, it - 4096, smem);
  }
#if (DUPMASK >> 12) & 1
  GSYNC;
  for (int it = blockIdx.x; it < 4096 + 256; it += gridDim.x) {
    if (it < 4096) swa_item(p, it, smem); else kmean_item(p, it - 4096, smem);
  }
#endif
  GSYNC;
  for (int it = blockIdx.x; it < 4096; it += gridDim.x) moba_own_item(p, it, smem);
#if (DUPMASK >> 13) & 1
  GSYNC;
  if (blockIdx.x == 0) ((int*)(ws + S_CNT))[64 + my_tid()] = 0;
  GSYNC;
  for (int it = blockIdx.x; it < 4096; it += gridDim.x) moba_own_item(p, it, smem);
#endif
  GSYNC;
  phase_moba_bucket(p, smem);
#if (DUPMASK >> 14) & 1
  GSYNC;
  phase_moba_bucket(p, smem);
#endif
  GSYNC;
  phase_moba_merge(p);
#if (DUPMASK >> 15) & 1
  GSYNC;
  phase_moba_merge(p);
#endif
  GSYNC;
  phase_outproj(p, (const bfu*)(ws + OFF_WODOUT), smem);
#if (DUPMASK >> 16) & 1
  GSYNC;
  phase_outproj(p, (const bfu*)(ws + OFF_WODOUT), smem);
#endif
  GSYNC;
  phase_ln1_router(p, p.out, 1, smem);
#if (DUPMASK >> 17) & 1
  GSYNC;
  phase_ln1_router(p, p.out, 1, smem);
#endif
  GSYNC;
  phase_moe1(p, 1, smem);
#if (DUPMASK >> 18) & 1
  GSYNC;
  phase_moe1(p, 1, smem);
#endif
  GSYNC;
  phase_moe2(p, 1, smem);
#if (DUPMASK >> 19) & 1
  GSYNC;
  phase_moe2(p, 1, smem);
#endif
  GSYNC;
  phase_ln2(p, 1, p.out, (bfu*)nullptr);
#if (DUPMASK >> 20) & 1
  GSYNC;
  phase_ln2(p, 1, p.out, (bfu*)nullptr);
#endif
}

extern "C" void kernel_launch(void* const* d_in, const int* in_sizes, int n_in, void* d_out, int out_size, void* d_ws,
                              size_t ws_size, hipStream_t stream) {
  static int grid_blocks = 0;
  if (!grid_blocks) {
    int dev = 0, cus = 0, per_cu = 0;
    hipGetDevice(&dev);
    hipDeviceGetAttribute(&cus, hipDeviceAttributeMultiprocessorCount, dev);
    hipOccupancyMaxActiveBlocksPerMultiprocessor(&per_cu, mega, 256, 0);
    if (per_cu < 1) per_cu = 1;
    if (per_cu > 2) per_cu = 2;
    grid_blocks = (cus * per_cu) & ~7;
    if (ws_size < WS_NEED) fprintf(stderr, "workspace too small: %zu < %zu\n", ws_size, (size_t)WS_NEED);
  }
  Params p{};
  const float** f = (const float**)&p;
  for (int i = 0; i < 27; ++i) f[i] = (const float*)d_in[i];
  p.out = (float*)d_out;
  p.ws = (unsigned char*)d_ws;
  void* args[] = {&p};
  hipError_t e = hipLaunchCooperativeKernel((void*)mega, dim3(grid_blocks), dim3(256), args, 0, stream);
  if (e != hipSuccess) fprintf(stderr, "cooperative launch failed: %s (grid %d)\n", hipGetErrorString(e), grid_blocks);
}
```

```cpp
#ifndef DUPMASK
#define DUPMASK 0
#endif
#ifndef GX
#define GX 0
#endif
#ifndef XSYNC
#define XSYNC 0
#endif
#define GSYNC xcd_barrier(xb)
#include <hip/hip_runtime.h>
#include <hip/hip_cooperative_groups.h>
#include <cstdio>
namespace cg = cooperative_groups;

typedef unsigned short bfu;
typedef __attribute__((ext_vector_type(8))) short bf16x8;
typedef __attribute__((ext_vector_type(4))) float f32x4;
typedef __attribute__((ext_vector_type(2))) float f32x2;

#define DEV __device__ __forceinline__

constexpr int T = 32768, L = 16384;
constexpr float ALPHA = 1.41421356237309515f;
constexpr float NEGF = -1e30f;

constexpr size_t MiB = 1u << 20;
constexpr size_t OFF_WEVIN = 0;
constexpr size_t OFF_WGLU = OFF_WEVIN + 5 * MiB;
constexpr size_t OFF_WEVOUT = OFF_WGLU + 1 * MiB;
constexpr size_t OFF_WODIN = OFF_WEVOUT + 2 * MiB;
constexpr size_t OFF_WODOUT = OFF_WODIN + 3 * MiB;
constexpr size_t OFF_WGU = OFF_WODOUT + 2 * MiB;
constexpr size_t OFF_WDN = OFF_WGU + 32 * MiB;
constexpr size_t OFF_SMALL = OFF_WDN + 16 * MiB;
constexpr size_t OFF_P = OFF_SMALL + 8 * MiB;
constexpr size_t OFF_A = OFF_P + 160 * MiB;
constexpr size_t OFF_X1 = OFF_A + 128 * MiB;
constexpr size_t WS_NEED = OFF_X1 + 128 * MiB;
constexpr size_t S_CNT = OFF_SMALL;
constexpr size_t S_LB = OFF_SMALL + 4096;
constexpr size_t S_ABAR = OFF_SMALL + 8192;
constexpr size_t S_APOW = OFF_SMALL + 24576;
constexpr size_t S_BBAR = OFF_SMALL + 40960;
constexpr size_t S_KMEAN = OFF_SMALL + 303104;
constexpr size_t S_TOKW = OFF_SMALL + 524288;
constexpr size_t S_LIST = OFF_SMALL + 1 * MiB;
constexpr size_t S_BAR = OFF_SMALL + 4 * MiB;
constexpr size_t OFF_BUCK = OFF_P + 96 * MiB;
constexpr size_t OFF_X1B = OFF_P;
constexpr size_t OFF_H = OFF_P + 64 * MiB;
constexpr size_t OFF_X2B = OFF_P + 96 * MiB;
constexpr size_t OFF_XB = OFF_A;
constexpr size_t OFF_DS = OFF_A;
constexpr size_t OFF_SP = OFF_A + 64 * MiB;
constexpr size_t OFF_MIX = OFF_A;
constexpr size_t OFF_PO = OFF_A;
constexpr size_t OFF_YS5 = OFF_X1;
constexpr size_t OFF_Y = OFF_X1 + 32 * MiB;
constexpr size_t OFF_HEND = OFF_X1 + 96 * MiB;
constexpr size_t OFF_CARRY = OFF_X1 + 104 * MiB;
constexpr size_t OFF_DEC = OFF_X1 + 112 * MiB;
constexpr size_t OFF_VT = OFF_X1;
constexpr size_t OFF_PM = OFF_X1 + 96 * MiB;
constexpr size_t OFF_PL = OFF_X1 + 100 * MiB;

constexpr int SMEM_BYTES = 80 * 1024;
constexpr int SM_AUX = 75 * 1024;
constexpr int BUCK_PER_BH = 2016 * 1024;

struct Params {
  const float *x, *lb_logits, *ev_w_in, *ev_a_norm, *a_re, *a_im, *log_dt, *b_re, *b_im, *c_re, *c_im, *s5_d,
      *w_glu, *ev_w_out, *od_w_in, *od_sinks, *od_w_out, *ln1_g, *ln1_b, *w_group, *b_group, *w_expert, *b_expert,
      *w_gate_up, *w_down, *ln2_g, *ln2_b;
  float* out;
  unsigned char* ws;
};

DEV int my_tid() { int t = threadIdx.x; asm volatile("" : "+v"(t)); return t; }
typedef __attribute__((ext_vector_type(2))) __bf16 bf16x2_t;
typedef __attribute__((ext_vector_type(2))) float f32x2c;
DEV bfu f2bf(float f) { __bf16 h = (__bf16)f; return __builtin_bit_cast(bfu, h); }
DEV float bf2f(bfu h) { return __uint_as_float(((unsigned)h) << 16); }
DEV unsigned pack2(float a, float b) { f32x2c v = {a, b}; bf16x2_t r = __builtin_convertvector(v, bf16x2_t); return __builtin_bit_cast(unsigned, r); }
DEV float frcp(float x) { return __builtin_amdgcn_rcpf(x); }
DEV float sigm(float x) { return frcp(1.f + __expf(-x)); }
DEV float siluf(float x) { return x * frcp(1.f + __expf(-x)); }
DEV float gelu_tanh(float x) {
  float u = 1.5957691216057308f * (x + 0.044715f * x * x * x);
  return x * frcp(1.f + __expf(-u));
}
DEV f32x4 mfma16(uint4 a, uint4 b, f32x4 c) {
  return __builtin_amdgcn_mfma_f32_16x16x32_bf16(__builtin_bit_cast(bf16x8, a), __builtin_bit_cast(bf16x8, b), c, 0, 0, 0);
}
DEV uint4 lds128(const bfu* p) { return *(const uint4*)p; }
template <int CTRL> DEV float dpp_f(float v) {
  return __int_as_float(__builtin_amdgcn_update_dpp(0, __float_as_int(v), CTRL, 0xF, 0xF, false));
}
DEV float sum16(float v) {
  v += dpp_f<0xB1>(v);
  v += dpp_f<0x4E>(v);
  v += dpp_f<0x141>(v);
  v += dpp_f<0x140>(v);
  return v;
}
DEV float wave_sum(float v) {
  v = sum16(v);
  const int iv = __float_as_int(v);
  const float s0 = __int_as_float(__builtin_amdgcn_readlane(iv, 0)), s1 = __int_as_float(__builtin_amdgcn_readlane(iv, 16));
  const float s2 = __int_as_float(__builtin_amdgcn_readlane(iv, 32)), s3 = __int_as_float(__builtin_amdgcn_readlane(iv, 48));
  return (s0 + s1) + (s2 + s3);
}
DEV float max16(float v) {
  v = fmaxf(v, __shfl_xor(v, 8)); v = fmaxf(v, __shfl_xor(v, 4));
  v = fmaxf(v, __shfl_xor(v, 2)); v = fmaxf(v, __shfl_xor(v, 1));
  return v;
}
DEV uint4 ld8_f32(const float* p) {
  float4 u = ((const float4*)p)[0], v = ((const float4*)p)[1];
  return make_uint4(pack2(u.x, u.y), pack2(u.z, u.w), pack2(v.x, v.y), pack2(v.z, v.w));
}
DEV uint4 ld8_bf(const bfu* p) { return *(const uint4*)p; }
DEV int perm_half(int c, int half) {
  if (half == 0) return c;
  int hi = c >= half ? 1 : 0;
  int cc = hi ? c - half : c;
  return (cc >> 5) * 64 + hi * 32 + (cc & 31);
}

template <bool SWAP>
DEV void mma_tile(const bfu* As, const bfu* Bs, int wm, int wn, int l15, int lq, f32x4 (&acc)[4][4]) {
#pragma unroll
  for (int ks = 0; ks < 2; ++ks) {
    uint4 af[4], bfr[4];
#pragma unroll
    for (int i = 0; i < 4; ++i) {
      af[i] = lds128(As + (wm * 64 + i * 16 + l15) * 80 + ks * 32 + lq * 8);
      bfr[i] = lds128(Bs + (wn * 64 + i * 16 + l15) * 80 + ks * 32 + lq * 8);
    }
    __builtin_amdgcn_s_setprio(1);
#pragma unroll
    for (int i1 = 0; i1 < 4; ++i1)
#pragma unroll
      for (int i2 = 0; i2 < 4; ++i2)
        acc[i1][i2] = SWAP ? mfma16(bfr[i1], af[i2], acc[i1][i2]) : mfma16(af[i1], bfr[i2], acc[i1][i2]);
    __builtin_amdgcn_s_setprio(0);
    if (ks == 0) __builtin_amdgcn_sched_barrier(0);
  }
}

template <int N> struct IC { static constexpr int v = N; };
template <int I, int N, typename F> DEV void static_for(F&& f) { if constexpr (I < N) { f(IC<I>{}); static_for<I + 1, N>(f); } }

DEV uint4 ld8_at(const bfu* base, unsigned o) { asm volatile("" : "+v"(o)); return ld8_bf(base + o); }
struct RowLoader {
  const bfu* base; unsigned off; unsigned stride32;
  DEV uint4 operator()(int i, int kb, int so) const { return ld8_at(base, off + (unsigned)i * stride32 + (unsigned)kb + (unsigned)so); }
};
struct GatherLoader {
  const bfu* base; unsigned off[4];
  DEV uint4 operator()(int i, int kb, int so) const { return ld8_at(base, off[i] + (unsigned)kb + (unsigned)so); }
};
struct SplitKLoader {
  const bfu* base; unsigned lo; unsigned dhi;
  DEV uint4 operator()(int i, int kb, int so) const {
    const unsigned u = (kb < 256) ? 0u : dhi;
    return ld8_at(base, lo + u + (unsigned)i * 8192u + (unsigned)(kb & 255) + (unsigned)so);
  }
};
struct GemmPipe { uint4 ra[2][4], rb[2][4]; };

template <typename AL, typename BL, typename EP>
DEV void gemm128(bool SWAP, int K, bool first, bool hasNext, const AL& aload, const BL& bload, const AL& aloadN, const BL& bloadN,
                 EP epi, GemmPipe& gp, unsigned char* smem) {
  const int tid = my_tid(), lane = tid & 63, w = tid >> 6, wm = w >> 1, wn = w & 1, l15 = lane & 15, lq = lane >> 4;
  const int seg = tid & 7, r0 = tid >> 3;
  const int nk = K >> 6;
  f32x4 acc[4][4];
#pragma unroll
  for (int mi = 0; mi < 4; ++mi)
#pragma unroll
    for (int ni = 0; ni < 4; ++ni) acc[mi][ni] = f32x4{0.f, 0.f, 0.f, 0.f};
  if (first) {
#pragma unroll
    for (int i = 0; i < 4; ++i) { gp.ra[0][i] = aload(i, 0, seg * 8); gp.rb[0][i] = bload(i, 0, seg * 8); }
#pragma unroll
    for (int i = 0; i < 4; ++i) { gp.ra[1][i] = aload(i, 64, seg * 8); gp.rb[1][i] = bload(i, 64, seg * 8); }
    __syncthreads();
    bfu* As = (bfu*)smem; bfu* Bs = As + 128 * 80;
#pragma unroll
    for (int i = 0; i < 4; ++i) {
      *(uint4*)(As + (r0 + 32 * i) * 80 + seg * 8) = gp.ra[0][i];
      *(uint4*)(Bs + (r0 + 32 * i) * 80 + seg * 8) = gp.rb[0][i];
    }
#pragma unroll
    for (int i = 0; i < 4; ++i) { gp.ra[0][i] = aload(i, 128, seg * 8); gp.rb[0][i] = bload(i, 128, seg * 8); }
  }
  auto body = [&](auto pc, int kt) {
    constexpr int PAR = decltype(pc)::v;
    constexpr int NXT = PAR ^ 1;
    __syncthreads();
    if (kt + 1 < nk || hasNext) {
      bfu* As = (bfu*)(smem + NXT * 40960); bfu* Bs = As + 128 * 80;
#pragma unroll
      for (int i = 0; i < 4; ++i) {
        *(uint4*)(As + (r0 + 32 * i) * 80 + seg * 8) = gp.ra[NXT][i];
        *(uint4*)(Bs + (r0 + 32 * i) * 80 + seg * 8) = gp.rb[NXT][i];
      }
    }
    if (kt + 3 < nk) {
      const int k = (kt + 3) * 64;
#pragma unroll
      for (int i = 0; i < 4; ++i) { gp.ra[NXT][i] = aload(i, k, seg * 8); gp.rb[NXT][i] = bload(i, k, seg * 8); }
    } else if (hasNext) {
      const int k = (kt + 3 - nk) * 64;
#pragma unroll
      for (int i = 0; i < 4; ++i) { gp.ra[NXT][i] = aloadN(i, k, seg * 8); gp.rb[NXT][i] = bloadN(i, k, seg * 8); }
    } else {
      const int k = (nk - 1) * 64;
#pragma unroll
      for (int i = 0; i < 4; ++i) { gp.ra[NXT][i] = aload(i, k, seg * 8); gp.rb[NXT][i] = bload(i, k, seg * 8); }
    }
    const bfu* Ac = (const bfu*)(smem + PAR * 40960);
    mma_tile<true>(Ac, Ac + 128 * 80, wm, wn, l15, lq, acc);
  };
  for (int kt = 0; kt < nk; kt += 2) {
    body(IC<0>{}, kt);
    body(IC<1>{}, kt + 1);
  }
  epi(acc, wm, wn, l15, lq);
}

DEV bool gemm_item(int iter, int MT, int NT, int& mt, int& nt) {
  const int nl = gridDim.x >> 3;
  const int x = blockIdx.x & 7, lw = blockIdx.x >> 3;
  const int mper = MT >> 3;
  const int li = lw + iter * nl;
  if (li >= mper * NT) return false;
  const int per_group = mper * 4;
  const int g = li / per_group, r = li - g * per_group;
  mt = x * mper + (r >> 2);
  nt = g * 4 + (r & 3);
  return true;
}
DEV int xcd_item(int iter, int total, int inner) {
  const int nl = gridDim.x >> 3;
  const int x = blockIdx.x & 7, lw = blockIdx.x >> 3;
  const int outer = total / inner;
  const int chunk = (outer + 7) >> 3;
  const int o0 = x * chunk;
  int o1 = o0 + chunk; if (o1 > outer) o1 = outer;
  const int li = lw + iter * nl;
  if (o0 >= o1 || li >= (o1 - o0) * inner) return -1;
  return o0 * inner + li;
}

DEV void transpose_job(const float* __restrict__ src, bfu* __restrict__ dst, int nmat, int K, int N, int half, bfu* tl) {
  const int tk = K >> 6, tn = N >> 6;
  const int per = tk * tn, total = nmat * per;
  const int tid = my_tid();
  const int c4 = tid & 15, r = tid >> 4;
  int it = blockIdx.x;
  if (it >= total) return;
  auto tile_src = [&](int itx) -> const float* {
    const int m = itx / per, rem = itx - m * per;
    const int kt = rem / tn, nt = rem - kt * tn;
    return src + (size_t)m * K * N + (size_t)(kt * 64) * N + nt * 64;
  };
  float4 nv[4];
  {
    const float* s = tile_src(it);
#pragma unroll
    for (int i = 0; i < 4; ++i) nv[i] = *(const float4*)(s + (size_t)(r + 16 * i) * N + c4 * 4);
  }
  for (; it < total; it += gridDim.x) {
    const int m = it / per, rem = it - m * per;
    const int kt = rem / tn, nt = rem - kt * tn;
    float4 v[4];
#pragma unroll
    for (int i = 0; i < 4; ++i) v[i] = nv[i];
    {
      const float* s = tile_src(it + gridDim.x < total ? it + gridDim.x : it);
#pragma unroll
      for (int i = 0; i < 4; ++i) nv[i] = *(const float4*)(s + (size_t)(r + 16 * i) * N + c4 * 4);
    }
    __syncthreads();
#pragma unroll
    for (int i = 0; i < 4; ++i) {
      tl[(c4 * 4 + 0) * 72 + r + 16 * i] = f2bf(v[i].x);
      tl[(c4 * 4 + 1) * 72 + r + 16 * i] = f2bf(v[i].y);
      tl[(c4 * 4 + 2) * 72 + r + 16 * i] = f2bf(v[i].z);
      tl[(c4 * 4 + 3) * 72 + r + 16 * i] = f2bf(v[i].w);
    }
    __syncthreads();
    bfu* d = dst + (size_t)m * K * N;
#pragma unroll
    for (int i = 0; i < 2; ++i) {
      const int idx = tid + 256 * i, n = idx >> 3, sg = idx & 7;
      const int pn = perm_half(nt * 64 + n, half);
      *(uint4*)(d + (size_t)pn * K + kt * 64 + sg * 8) = *(const uint4*)(tl + n * 72 + sg * 8);
    }
  }
}

DEV void phase_prep(const Params& p, unsigned char* smem) {
  bfu* tl = (bfu*)smem;
  unsigned char* ws = p.ws;
  const int gtid = blockIdx.x * 256 + my_tid();
  if (gtid < 512) ((int*)(ws + S_CNT))[gtid] = 0;
  if (gtid < 512) {
    float l0 = p.lb_logits[gtid], l1 = p.lb_logits[512 + gtid], l2 = p.lb_logits[1024 + gtid];
    float m = fmaxf(l0, fmaxf(l1, l2));
    float e0 = expf(l0 - m), e1 = expf(l1 - m), e2 = expf(l2 - m);
    ((float*)(ws + S_LB))[gtid] = e0 / (e0 + e1 + e2);
  }
  if (gtid < 2048) {
    int g = gtid >> 6;
    float dt = expf(p.log_dt[g]);
    float ar = p.a_re[gtid], ai = p.a_im[gtid];
    float mag = expf(dt * ar);
    float abr = mag * cosf(dt * ai), abi = mag * sinf(dt * ai);
    float den = ar * ar + ai * ai;
    float xr = abr - 1.f, xi = abi;
    float fr = (xr * ar + xi * ai) / den, fi = (xi * ar - xr * ai) / den;
    float* ab = (float*)(ws + S_ABAR);
    ab[gtid * 2] = abr; ab[gtid * 2 + 1] = abi;
    float pr = abr, pi = abi;
#pragma unroll
    for (int i = 0; i < 6; ++i) { float nr = pr * pr - pi * pi, ni = 2.f * pr * pi; pr = nr; pi = ni; }
    float* ap = (float*)(ws + S_APOW);
    ap[gtid * 2] = pr; ap[gtid * 2 + 1] = pi;
    float* bb = (float*)(ws + S_BBAR) + (size_t)gtid * 32;
    for (int m = 0; m < 16; ++m) {
      float br = p.b_re[gtid * 16 + m], bi = p.b_im[gtid * 16 + m];
      bb[m] = fr * br - fi * bi;
      bb[16 + m] = fr * bi + fi * br;
    }
  }
  transpose_job(p.ev_w_in, (bfu*)(ws + OFF_WEVIN), 1, 1024, 2560, 0, tl);
  transpose_job(p.w_glu, (bfu*)(ws + OFF_WGLU), 1, 512, 1024, 512, tl);
  transpose_job(p.ev_w_out, (bfu*)(ws + OFF_WEVOUT), 1, 1024, 1024, 0, tl);
  transpose_job(p.od_w_in, (bfu*)(ws + OFF_WODIN), 1, 1024, 1536, 0, tl);
  transpose_job(p.od_w_out, (bfu*)(ws + OFF_WODOUT), 1, 1024, 1024, 0, tl);
  transpose_job(p.w_gate_up, (bfu*)(ws + OFF_WGU), 32, 1024, 512, 256, tl);
  transpose_job(p.w_down, (bfu*)(ws + OFF_WDN), 32, 256, 1024, 0, tl);
  {
    uint4* xb = (uint4*)(ws + OFF_XB);
    const size_t n8 = (size_t)T * 1024 / 8;
    for (size_t i = (size_t)blockIdx.x * 256 + my_tid(); i < n8; i += (size_t)gridDim.x * 256) xb[i] = ld8_f32(p.x + i * 8);
  }
}

DEV void phase_proj(const bfu* __restrict__ X, const bfu* __restrict__ Wt, bfu* __restrict__ P, int N, bfu* __restrict__ VT, int layer, unsigned char* smem) {
  const int ntn = N >> 7;
  const int total = (T >> 7) * ntn;
  const int r0 = my_tid() >> 3;
  GemmPipe gp;
  bool first = true;
  for (int it = blockIdx.x; it < total; it += gridDim.x) {
    const int mt = it / ntn, nt = it - mt * ntn;
    const int itn = it + gridDim.x;
    const bool hasNext = itn < total;
    const int itq = hasNext ? itn : it;
    const int mtn = itq / ntn, ntq = itq - mtn * ntn;
    const RowLoader al{X, (unsigned)(mt * 128 + r0) * 1024u, 32768u}, bl{Wt, (unsigned)(nt * 128 + r0) * 1024u, 32768u};
    const RowLoader aln{X, (unsigned)(mtn * 128 + r0) * 1024u, 32768u}, bln{Wt, (unsigned)(ntq * 128 + r0) * 1024u, 32768u};
    auto epi = [&](f32x4(&acc)[4][4], int wm, int wn, int l15, int lq) {
#pragma unroll
      for (int ai = 0; ai < 4; ++ai)
#pragma unroll
        for (int bi = 0; bi < 4; ++bi) {
          const int row = mt * 128 + wm * 64 + bi * 16 + l15, col = nt * 128 + wn * 64 + ai * 16 + lq * 4;
          *(uint2*)(P + (size_t)row * N + col) = make_uint2(pack2(acc[ai][bi][0], acc[ai][bi][1]), pack2(acc[ai][bi][2], acc[ai][bi][3]));
        }
    };
    const bool vt_tile = layer == 0 ? (nt >= 8 && nt <= 11) : (nt == 5 || nt == 11);
    auto epi2 = [&](f32x4(&acc)[4][4], int wm, int wn, int l15, int lq) {
      if (vt_tile) {
        bfu* Ct = (bfu*)(smem + 40960);
        __syncthreads();
#pragma unroll
        for (int ai = 0; ai < 4; ++ai)
#pragma unroll
          for (int bi = 0; bi < 4; ++bi)
#pragma unroll
            for (int j = 0; j < 4; ++j)
              Ct[(wn * 64 + ai * 16 + lq * 4 + j) * 136 + wm * 64 + bi * 16 + l15] = f2bf(acc[ai][bi][j]);
        __syncthreads();
        const int which = nt == 11 ? 1 : 0;
        const int m0 = mt * 128;
        const int b = m0 >> 14, t0 = m0 & (L - 1);
        const int tid = my_tid();
#pragma unroll
        for (int i = 0; i < 8; ++i) {
          const int idx = tid + 256 * i, n = idx >> 4, c = idx & 15;
          const size_t vrow = layer == 0 ? (size_t)((b * 4 + (nt - 8)) * 128 + n) : (size_t)(((which * 2 + b) * 2 + (n >> 6)) * 64 + (n & 63));
          *(uint4*)(VT + vrow * L + t0 + c * 8) = *(const uint4*)(Ct + n * 136 + c * 8);
        }
      } else {
        epi(acc, wm, wn, l15, lq);
      }
    };
    gemm128(true, 1024, first, hasNext, al, bl, aln, bln, epi2, gp, smem);
    first = false;
  }
}

DEV void phase_glu(const Params& p, unsigned char* smem) {
  const bfu* A = (const bfu*)(p.ws + OFF_YS5);
  const bfu* Wt = (const bfu*)(p.ws + OFF_WGLU);
  bfu* Y = (bfu*)(p.ws + OFF_Y);
  const int r0 = my_tid() >> 3;
  const int total = (T >> 7) * 8;
  GemmPipe gp;
  bool first = true;
  for (int it = blockIdx.x; it < total; it += gridDim.x) {
    const int mt = it >> 3, nt = it & 7;
    const int itn = it + gridDim.x;
    const bool hasNext = itn < total;
    const int itq = hasNext ? itn : it;
    const RowLoader al{A, (unsigned)(mt * 128 + r0) * 512u, 16384u}, bl{Wt, (unsigned)(nt * 128 + r0) * 512u, 16384u};
    const RowLoader aln{A, (unsigned)((itq >> 3) * 128 + r0) * 512u, 16384u}, bln{Wt, (unsigned)((itq & 7) * 128 + r0) * 512u, 16384u};
    auto epi = [&](f32x4(&acc)[4][4], int wm, int wn, int l15, int lq) {
      const int q = nt * 2 + wn;
#pragma unroll
      for (int ai = 0; ai < 2; ++ai)
#pragma unroll
        for (int bi = 0; bi < 4; ++bi) {
          const int row = mt * 128 + wm * 64 + bi * 16 + l15, col = q * 32 + ai * 16 + lq * 4;
          float o[4];
#pragma unroll
          for (int j = 0; j < 4; ++j) o[j] = acc[ai][bi][j] * sigm(acc[ai + 2][bi][j]);
          *(uint2*)(Y + (size_t)row * 1024 + 512 + col) = make_uint2(pack2(o[0], o[1]), pack2(o[2], o[3]));
        }
    };
    gemm128(true, 512, first, hasNext, al, bl, aln, bln, epi, gp, smem);
    first = false;
  }
}

DEV void phase_outproj(const Params& p, const bfu* __restrict__ Wt, unsigned char* smem) {
  const bfu* A = (const bfu*)(p.ws + OFF_Y);
  bfu* MIX = (bfu*)(p.ws + OFF_MIX);
  const int r0 = my_tid() >> 3;
  const int total = (T >> 7) * 8;
  GemmPipe gp;
  bool first = true;
  for (int it = blockIdx.x; it < total; it += gridDim.x) {
    const int mt = it >> 3, nt = it & 7;
    const int itn = it + gridDim.x;
    const bool hasNext = itn < total;
    const int itq = hasNext ? itn : it;
    const RowLoader al{A, (unsigned)(mt * 128 + r0) * 1024u, 32768u}, bl{Wt, (unsigned)(nt * 128 + r0) * 1024u, 32768u};
    const RowLoader aln{A, (unsigned)((itq >> 3) * 128 + r0) * 1024u, 32768u}, bln{Wt, (unsigned)((itq & 7) * 128 + r0) * 1024u, 32768u};
    auto epi = [&](f32x4(&acc)[4][4], int wm, int wn, int l15, int lq) {
#pragma unroll
      for (int ai = 0; ai < 4; ++ai)
#pragma unroll
        for (int bi = 0; bi < 4; ++bi) {
          const int row = mt * 128 + wm * 64 + bi * 16 + l15, col = nt * 128 + wn * 64 + ai * 16 + lq * 4;
          *(uint2*)(MIX + (size_t)row * 1024 + col) = make_uint2(pack2(acc[ai][bi][0], acc[ai][bi][1]), pack2(acc[ai][bi][2], acc[ai][bi][3]));
        }
    };
    gemm128(true, 1024, first, hasNext, al, bl, aln, bln, epi, gp, smem);
    first = false;
  }
}


DEV void stage_tile64x128(const bfu* __restrict__ src, int ld, bfu* dst, int ls) {
#pragma unroll
  for (int i = 0; i < 4; ++i) {
    const int idx = my_tid() + 256 * i, row = idx >> 4, sg = idx & 15;
    *(uint4*)(dst + row * ls + sg * 8) = *(const uint4*)(src + (size_t)row * ld + sg * 8);
  }
}
DEV void stage_tile64x128_T(const bfu* __restrict__ src, int ld, bfu* dst, int ls) {
#pragma unroll
  for (int i = 0; i < 4; ++i) {
    const int idx = my_tid() + 256 * i, row = idx >> 4, sg = idx & 15;
    uint4 v = *(const uint4*)(src + (size_t)row * ld + sg * 8);
    unsigned uu[4] = {v.x, v.y, v.z, v.w};
#pragma unroll
    for (int e = 0; e < 4; ++e) {
      dst[(sg * 8 + 2 * e) * ls + row] = (bfu)(uu[e] & 0xffffu);
      dst[(sg * 8 + 2 * e + 1) * ls + row] = (bfu)(uu[e] >> 16);
    }
  }
}


DEV void stage_vt(const bfu* __restrict__ vt0, int bh, int tl0, bfu* dst, int ls) {
#pragma unroll
  for (int i = 0; i < 4; ++i) {
    const int idx = my_tid() + 256 * i, v = idx >> 3, c = idx & 7;
    *(uint4*)(dst + v * ls + c * 8) = *(const uint4*)(vt0 + ((size_t)(bh * 128 + v)) * L + tl0 + c * 8);
  }
}

DEV void hgrn_dstate_item(const Params& p, int ch, unsigned char* smem) {
  const int bh = ch >> 8, n = ch & 255, b = bh >> 2, h = bh & 3;
  const size_t t0 = (size_t)b * L + (size_t)n * 64;
  const bfu* P = (const bfu*)(p.ws + OFF_P);
  bfu* As = (bfu*)smem;
  bfu* Bs = As + 128 * 80;
  bfu* Fr = Bs + 128 * 80;
  const int tid = my_tid(), k = tid & 127, half = tid >> 7;
  const float lb = ((const float*)(p.ws + S_LB))[h * 128 + k];
  __syncthreads();
  stage_tile64x128(P + t0 * 2560 + 512 + h * 128, 2560, Fr, 128);
  stage_vt((const bfu*)p.out, bh, n * 64, As, 80);
  __syncthreads();
  float* tot = (float*)(Fr + 64 * 128);
  float fv[32], cum[32];
  float run = 0.f;
#pragma unroll
  for (int i = 0; i < 32; ++i) {
    const float f = lb + (1.f - lb) * sigm(bf2f(Fr[(half * 32 + i) * 128 + k]));
    run += __logf(f);
    fv[i] = f; cum[i] = run;
  }
  tot[half * 128 + k] = run;
  __syncthreads();
  const float t0s = tot[k], t1s = tot[128 + k];
  const float btot = t0s + t1s;
  const float boff = half ? t0s : 0.f;
#pragma unroll
  for (int i = 0; i < 32; ++i) Bs[k * 80 + half * 32 + i] = f2bf((1.f - fv[i]) * __expf(btot - (boff + cum[i])));
  if (half == 0) ((float*)(p.ws + OFF_DEC))[(size_t)ch * 128 + k] = __expf(btot);
  __syncthreads();
  const int lane = tid & 63, w = tid >> 6, wm = w >> 1, wn = w & 1, l15 = lane & 15, lq = lane >> 4;
  f32x4 acc[4][4];
#pragma unroll
  for (int mi = 0; mi < 4; ++mi)
#pragma unroll
    for (int ni = 0; ni < 4; ++ni) acc[mi][ni] = f32x4{0.f, 0.f, 0.f, 0.f};
  mma_tile<true>(As, Bs, wm, wn, l15, lq, acc);
  bfu* DS = (bfu*)(p.ws + OFF_DS) + (size_t)ch * 16384;
#pragma unroll
  for (int ai = 0; ai < 4; ++ai)
#pragma unroll
    for (int bi = 0; bi < 4; ++bi) {
      const int v = wm * 64 + bi * 16 + l15, kk = wn * 64 + ai * 16 + lq * 4;
      *(uint2*)(DS + v * 128 + kk) = make_uint2(pack2(acc[ai][bi][0], acc[ai][bi][1]), pack2(acc[ai][bi][2], acc[ai][bi][3]));
    }
}

DEV void s5_load_bfrag(const Params& p, int g, int l15, int lq, uint4 (&bf)[8]) {
#pragma unroll
  for (int ni = 0; ni < 8; ++ni) {
    bf[ni] = make_uint4(0u, 0u, 0u, 0u);
    if (lq < 2) {
      const int col = ni * 16 + l15, pp = col & 63, part = col >> 6;
      const float* s = (const float*)(p.ws + S_BBAR) + (size_t)(g * 64 + pp) * 32 + part * 16 + lq * 8;
      const float4 u = ((const float4*)s)[0], v = ((const float4*)s)[1];
      bf[ni] = make_uint4(pack2(u.x, u.y), pack2(u.z, u.w), pack2(v.x, v.y), pack2(v.z, v.w));
    }
  }
}
DEV void s5_drive16(const uint4 a, const uint4 (&bf)[8], float* Dr, int l15, int lq) {
#pragma unroll
  for (int ni = 0; ni < 8; ++ni) {
    f32x4 acc = mfma16(a, bf[ni], f32x4{0.f, 0.f, 0.f, 0.f});
#pragma unroll
    for (int j = 0; j < 4; ++j) Dr[(lq * 4 + j) * 132 + ni * 16 + l15] = acc[j];
  }
}

struct S5Const { uint4 bf[8]; uint4 cf[4]; float2 ab; float dsk; };

DEV void s5_pass1_item(const Params& p, int it, const uint4 (&bf)[8], const float2 ab, unsigned char* smem) {
  const int gq = it & 7, bc = it >> 3;
  const size_t t0 = (size_t)(bc >> 8) * L + (size_t)(bc & 255) * 64;
  const int tid = my_tid(), lane = tid & 63, w = tid >> 6, l15 = lane & 15, lq = lane >> 4;
  float* Dr = (float*)smem + w * (16 * 132);
  const int g = gq * 4 + w;
  const int gp = g * 64 + lane;
  const bfu* P = (const bfu*)(p.ws + OFF_P);
  uint4 af[4];
#pragma unroll
  for (int sub = 0; sub < 4; ++sub) {
    af[sub] = make_uint4(0u, 0u, 0u, 0u);
    if (lq < 2) af[sub] = *(const uint4*)(P + (t0 + sub * 16 + l15) * 2560 + 2048 + g * 16 + lq * 8);
  }
  float hr = 0.f, hi = 0.f;
#pragma unroll
  for (int sub = 0; sub < 4; ++sub) {
    __syncthreads();
    s5_drive16(af[sub], bf, Dr, l15, lq);
    __syncthreads();
#pragma unroll 4
    for (int tt = 0; tt < 16; ++tt) {
      const float dr = Dr[tt * 132 + lane], di = Dr[tt * 132 + 64 + lane];
      const float nr = ab.x * hr - ab.y * hi + dr;
      const float ni = ab.x * hi + ab.y * hr + di;
      hr = nr; hi = ni;
    }
  }
  ((float2*)(p.ws + OFF_HEND))[(size_t)bc * 2048 + gp] = make_float2(hr, hi);
}

DEV void s5_pass2_item(const Params& p, int it, const uint4 (&bf)[8], const uint4 (&cf)[4], const float2 ab, const float dsk, unsigned char* smem) {
  const int gq = it & 7, bc = it >> 3;
  const size_t t0 = (size_t)(bc >> 8) * L + (size_t)(bc & 255) * 64;
  const int tid = my_tid(), lane = tid & 63, w = tid >> 6, l15 = lane & 15, lq = lane >> 4;
  float* Dr = (float*)smem + w * (16 * 132);
  bfu* Hs = (bfu*)(smem + 4 * 16 * 132 * 4) + w * (16 * 144);
  const int g = gq * 4 + w;
  const int gp = g * 64 + lane;
  const bfu* P = (const bfu*)(p.ws + OFF_P);
  uint4 af[4];
#pragma unroll
  for (int sub = 0; sub < 4; ++sub) {
    af[sub] = make_uint4(0u, 0u, 0u, 0u);
    if (lq < 2) af[sub] = *(const uint4*)(P + (t0 + sub * 16 + l15) * 2560 + 2048 + g * 16 + lq * 8);
  }
  float2 hc = ((const float2*)(p.ws + OFF_CARRY))[(size_t)bc * 2048 + gp];
  float hr = hc.x, hi = hc.y;
  bfu* YS = (bfu*)(p.ws + OFF_YS5);
#pragma unroll
  for (int sub = 0; sub < 4; ++sub) {
    float us[4];
#pragma unroll
    for (int j = 0; j < 4; ++j) us[j] = bf2f(P[(t0 + sub * 16 + lq * 4 + j) * 2560 + 2048 + g * 16 + l15]);
    __syncthreads();
    s5_drive16(af[sub], bf, Dr, l15, lq);
    __syncthreads();
#pragma unroll 4
    for (int tt = 0; tt < 16; ++tt) {
      const float dr = Dr[tt * 132 + lane], di = Dr[tt * 132 + 64 + lane];
      const float nr = ab.x * hr - ab.y * hi + dr;
      const float ni = ab.x * hi + ab.y * hr + di;
      hr = nr; hi = ni;
      Hs[tt * 144 + lane] = f2bf(hr);
      Hs[tt * 144 + 64 + lane] = f2bf(hi);
    }
    __syncthreads();
    f32x4 acc = f32x4{0.f, 0.f, 0.f, 0.f};
#pragma unroll
    for (int ks = 0; ks < 4; ++ks) acc = mfma16(lds128(Hs + l15 * 144 + ks * 32 + lq * 8), cf[ks], acc);
#pragma unroll
    for (int j = 0; j < 4; ++j) {
      const int t = sub * 16 + lq * 4 + j;
      const float y = acc[j] + dsk * us[j];
      YS[(t0 + t) * 512 + g * 16 + l15] = f2bf(gelu_tanh(y));
    }
  }
}


DEV void s5_load_consts(const Params& p, int g, int lane, uint4 (&bf)[8], uint4 (&cf)[4], float2& ab, float& dsk) {
  const int l15 = lane & 15, lq = lane >> 4;
  s5_load_bfrag(p, g, l15, lq, bf);
  ab = ((const float2*)(p.ws + S_ABAR))[g * 64 + lane];
#pragma unroll
  for (int ks = 0; ks < 4; ++ks) {
    const float* src = (ks < 2 ? p.c_re : p.c_im) + ((size_t)g * 16 + l15) * 64 + (ks & 1) * 32 + lq * 8;
    float4 u = ((const float4*)src)[0], v = ((const float4*)src)[1];
    float sgn = ks < 2 ? 1.f : -1.f;
    cf[ks] = make_uint4(pack2(sgn * u.x, sgn * u.y), pack2(sgn * u.z, sgn * u.w), pack2(sgn * v.x, sgn * v.y), pack2(sgn * v.z, sgn * v.w));
  }
  dsk = p.s5_d[g * 16 + l15];
}

DEV void hgrn_scan_item(const Params& p, int it) {
  const int bh = it >> 3, vs = it & 7;
  const int tid = my_tid(), v = vs * 16 + (tid >> 4), k8 = tid & 15;
  const bfu* DS = (const bfu*)(p.ws + OFF_DS);
  bfu* SP = (bfu*)(p.ws + OFF_SP);
  const float* DEC = (const float*)(p.ws + OFF_DEC);
  float S[8];
#pragma unroll
  for (int i = 0; i < 8; ++i) S[i] = 0.f;
  uint4 dsr[8];
  float4 dca[8], dcb[8];
  const size_t base0 = ((size_t)(bh * 256) * 128 + v) * 128 + k8 * 8;
  const size_t dbase0 = (size_t)(bh * 256) * 128 + k8 * 8;
#pragma unroll
  for (int s = 0; s < 8; ++s) {
    dsr[s] = *(const uint4*)(DS + base0 + (size_t)s * 16384);
    dca[s] = *(const float4*)(DEC + dbase0 + (size_t)s * 128);
    dcb[s] = *(const float4*)(DEC + dbase0 + (size_t)s * 128 + 4);
  }
  for (int n0 = 0; n0 < 256; n0 += 8) {
#pragma unroll
    for (int s = 0; s < 8; ++s) {
      const int n = n0 + s;
      *(uint4*)(SP + base0 + (size_t)n * 16384) = make_uint4(pack2(S[0], S[1]), pack2(S[2], S[3]), pack2(S[4], S[5]), pack2(S[6], S[7]));
      const uint4 d = dsr[s];
      const float4 a = dca[s], c = dcb[s];
      S[0] = a.x * S[0] + __uint_as_float(d.x << 16); S[1] = a.y * S[1] + __uint_as_float(d.x & 0xffff0000u);
      S[2] = a.z * S[2] + __uint_as_float(d.y << 16); S[3] = a.w * S[3] + __uint_as_float(d.y & 0xffff0000u);
      S[4] = c.x * S[4] + __uint_as_float(d.z << 16); S[5] = c.y * S[5] + __uint_as_float(d.z & 0xffff0000u);
      S[6] = c.z * S[6] + __uint_as_float(d.w << 16); S[7] = c.w * S[7] + __uint_as_float(d.w & 0xffff0000u);
      if (n + 8 < 256) {
        dsr[s] = *(const uint4*)(DS + base0 + (size_t)(n + 8) * 16384);
        dca[s] = *(const float4*)(DEC + dbase0 + (size_t)(n + 8) * 128);
        dcb[s] = *(const float4*)(DEC + dbase0 + (size_t)(n + 8) * 128 + 4);
      }
    }
  }
}

DEV void s5_carry_item(const Params& p, int it) {
  const int id = it * 256 + my_tid();
  const int b = id >> 11, gp = id & 2047;
  const float2 ap = ((const float2*)(p.ws + S_APOW))[gp];
  const float2* HE = (const float2*)(p.ws + OFF_HEND) + (size_t)b * 256 * 2048 + gp;
  float2* CA = (float2*)(p.ws + OFF_CARRY) + (size_t)b * 256 * 2048 + gp;
  float cr = 0.f, ci = 0.f;
  float2 ring[8];
#pragma unroll
  for (int s = 0; s < 8; ++s) ring[s] = HE[(size_t)s * 2048];
  for (int c0 = 0; c0 < 256; c0 += 8) {
#pragma unroll
    for (int s = 0; s < 8; ++s) {
      const int c = c0 + s;
      CA[(size_t)c * 2048] = make_float2(cr, ci);
      float nr = ap.x * cr - ap.y * ci + ring[s].x;
      float ni = ap.x * ci + ap.y * cr + ring[s].y;
      cr = nr; ci = ni;
      if (c + 8 < 256) ring[s] = HE[(size_t)(c + 8) * 2048];
    }
  }
}

DEV void hgrn_out_item(const Params& p, int ch, unsigned char* smem) {
  const int bh = ch >> 8, n = ch & 255, b = bh >> 2, h = bh & 3;
  const size_t t0 = (size_t)b * L + (size_t)n * 64;
  const bfu* P = (const bfu*)(p.ws + OFF_P);
  bfu* Qs = (bfu*)smem;
  bfu* RB = Qs + 64 * 144;
  bfu* Ks = RB;
  bfu* ATT = RB;
  bfu* Vt = RB + 64 * 80;
  bfu* St = RB;
  bfu* Fr = RB + 64 * 144;
  float* tot = (float*)(Fr + 64 * 128);
  bfu* Gs = (bfu*)(smem + 55296);
  const int tid = my_tid(), lane = tid & 63, w = tid >> 6, l15 = lane & 15, lq = lane >> 4;
  uint4 rq0, rq1, rq2, rq3, rf0, rf1, rf2, rf3, rv0, rv1, rv2, rv3, rg0, rg1, rg2, rg3, rs0, rs1, rs2, rs3, rs4, rs5, rs6, rs7;
  {
    const bfu* qsrc = P + t0 * 2560 + h * 128;
    const bfu* vt0 = (const bfu*)p.out;
    const bfu* SPc = (const bfu*)(p.ws + OFF_SP) + (size_t)ch * 16384;
#define HG_LD(i) { const int idx = tid + 256 * i, row = idx >> 4, sg = idx & 15; \
      rq##i = *(const uint4*)(qsrc + (size_t)row * 2560 + sg * 8); \
      rf##i = *(const uint4*)(qsrc + 512 + (size_t)row * 2560 + sg * 8); \
      rg##i = *(const uint4*)(qsrc + 1536 + (size_t)row * 2560 + sg * 8); \
      const int v = idx >> 3, c = idx & 7; \
      rv##i = *(const uint4*)(vt0 + ((size_t)(bh * 128 + v)) * L + n * 64 + c * 8); }
    HG_LD(0) HG_LD(1) HG_LD(2) HG_LD(3)
#undef HG_LD
#define HG_LS(i) { const int idx = tid + 256 * i, v = idx >> 4, sg = idx & 15; rs##i = *(const uint4*)(SPc + v * 128 + sg * 8); }
    HG_LS(0) HG_LS(1) HG_LS(2) HG_LS(3) HG_LS(4) HG_LS(5) HG_LS(6) HG_LS(7)
#undef HG_LS
  }
  float ng[8];
#pragma unroll
  for (int ni = 0; ni < 8; ++ni) ng[ni] = p.ev_a_norm[h * 128 + ni * 16 + l15];
  __syncthreads();
#define HG_ST(i) { const int idx = tid + 256 * i, row = idx >> 4, sg = idx & 15; \
    *(uint4*)(Qs + row * 144 + sg * 8) = rq##i; *(uint4*)(Fr + row * 128 + sg * 8) = rf##i; *(uint4*)(Gs + row * 144 + sg * 8) = rg##i; }
  HG_ST(0) HG_ST(1) HG_ST(2) HG_ST(3)
#undef HG_ST
  __syncthreads();
  {
    const int k = tid & 127, half = tid >> 7;
    const float lb = ((const float*)(p.ws + S_LB))[h * 128 + k];
    float fv[32], cum[32];
    float run = 0.f;
#pragma unroll
    for (int i = 0; i < 32; ++i) {
      const float f = lb + (1.f - lb) * sigm(bf2f(Fr[(half * 32 + i) * 128 + k]));
      run += __logf(f);
      fv[i] = f; cum[i] = run;
    }
    tot[half * 128 + k] = run;
    __syncthreads();
    const float boff = half ? tot[k] : 0.f;
#pragma unroll
    for (int i = 0; i < 32; ++i) {
      const int s = half * 32 + i;
      const float eb = __expf(boff + cum[i]);
      const float q = siluf(bf2f(Qs[s * 144 + k]));
      Qs[s * 144 + k] = f2bf(q * eb);
      Ks[s * 144 + k] = f2bf((1.f - fv[i]) * frcp(eb));
    }
  }
  __syncthreads();
  f32x4 at[4];
#pragma unroll
  for (int ni = 0; ni < 4; ++ni) at[ni] = f32x4{0.f, 0.f, 0.f, 0.f};
#pragma unroll
  for (int ks = 0; ks < 4; ++ks) {
    uint4 a = lds128(Qs + (16 * w + l15) * 144 + ks * 32 + lq * 8);
#pragma unroll
    for (int ni = 0; ni < 4; ++ni) at[ni] = mfma16(a, lds128(Ks + (ni * 16 + l15) * 144 + ks * 32 + lq * 8), at[ni]);
  }
  __syncthreads();
#pragma unroll
  for (int ni = 0; ni < 4; ++ni)
#pragma unroll
    for (int j = 0; j < 4; ++j) {
      int c = 16 * w + lq * 4 + j, s = ni * 16 + l15;
      ATT[c * 80 + s] = f2bf(s <= c ? at[ni][j] : 0.f);
    }
#define HG_SV(i) { const int idx = tid + 256 * i, v = idx >> 3, c = idx & 7; *(uint4*)(Vt + v * 80 + c * 8) = rv##i; }
  HG_SV(0) HG_SV(1) HG_SV(2) HG_SV(3)
#undef HG_SV
  __syncthreads();
  f32x4 o[8];
#pragma unroll
  for (int ni = 0; ni < 8; ++ni) o[ni] = f32x4{0.f, 0.f, 0.f, 0.f};
#pragma unroll
  for (int ks = 0; ks < 2; ++ks) {
    uint4 a = lds128(ATT + (16 * w + l15) * 80 + ks * 32 + lq * 8);
#pragma unroll
    for (int ni = 0; ni < 8; ++ni) o[ni] = mfma16(a, lds128(Vt + (ni * 16 + l15) * 80 + ks * 32 + lq * 8), o[ni]);
  }
  __syncthreads();
#define HG_SS(i) { const int idx = tid + 256 * i, v = idx >> 4, sg = idx & 15; *(uint4*)(St + v * 144 + sg * 8) = rs##i; }
  HG_SS(0) HG_SS(1) HG_SS(2) HG_SS(3) HG_SS(4) HG_SS(5) HG_SS(6) HG_SS(7)
#undef HG_SS
  __syncthreads();
#pragma unroll
  for (int ks = 0; ks < 4; ++ks) {
    uint4 a = lds128(Qs + (16 * w + l15) * 144 + ks * 32 + lq * 8);
#pragma unroll
    for (int ni = 0; ni < 8; ++ni) o[ni] = mfma16(a, lds128(St + (ni * 16 + l15) * 144 + ks * 32 + lq * 8), o[ni]);
  }
#pragma unroll
  for (int j = 0; j < 4; ++j) {
    float ss = 0.f;
#pragma unroll
    for (int ni = 0; ni < 8; ++ni) ss += o[ni][j] * o[ni][j];
    ss = sum16(ss);
    const float rsn = rsqrtf(ss * (1.f / 128.f) + 1e-6f);
    const int c = 16 * w + lq * 4 + j;
#pragma unroll
    for (int ni = 0; ni < 8; ++ni) {
      const int v = ni * 16 + l15;
      const float gate = bf2f(Gs[c * 144 + v]);
      Gs[c * 144 + v] = f2bf(o[ni][j] * rsn * ng[ni] * siluf(gate));
    }
  }
  __syncthreads();
  bfu* Y = (bfu*)(p.ws + OFF_Y);
#pragma unroll
  for (int i = 0; i < 4; ++i) {
    const int idx = tid + 256 * i, row = idx >> 4, sg = idx & 15;
    *(uint4*)(Y + (t0 + row) * 1024 + h * 128 + sg * 8) = *(const uint4*)(Gs + row * 144 + sg * 8);
  }
}

DEV void phase_ln1_router(const Params& p, const float* __restrict__ Xin, int layer, unsigned char* smem) {
  const bfu* MIX = (const bfu*)(p.ws + OFF_MIX);
  float* X1 = (float*)(p.ws + OFF_X1);
  bfu* X1b = (bfu*)(p.ws + OFF_X1B);
  const float* g1 = p.ln1_g + layer * 1024;
  const float* b1 = p.ln1_b + layer * 1024;
  const float* wg = p.w_group + (size_t)layer * 1024 * 4;
  const float* we = p.w_expert + (size_t)layer * 1024 * 16;
  const float* bg = p.b_group + layer * 4;
  const float* be = p.b_expert + layer * 16;
  float* tokw = (float*)(p.ws + S_TOKW);
  int* list = (int*)(p.ws + S_LIST);
  int* gcnt = (int*)(p.ws + S_CNT) + layer * 32;
  float* Wes = (float*)smem;
  int* tokb = (int*)(smem + 65536);
  int* lcnt = tokb + 64;
  int* lbase = lcnt + 32;
  int* lpos = lbase + 32;
  const int tid = my_tid(), lane = tid & 63, w = tid >> 6;
  __syncthreads();
  {
    float4 wv[16];
#pragma unroll
    for (int i = 0; i < 16; ++i) wv[i] = *(const float4*)(we + (size_t)(tid + 256 * i) * 4);
#pragma unroll
    for (int i = 0; i < 16; ++i) {
      const int idx = tid + 256 * i, d = idx >> 2, c4 = idx & 3;
      Wes[(c4 * 4 + 0) * 1024 + d] = wv[i].x; Wes[(c4 * 4 + 1) * 1024 + d] = wv[i].y;
      Wes[(c4 * 4 + 2) * 1024 + d] = wv[i].z; Wes[(c4 * 4 + 3) * 1024 + d] = wv[i].w;
    }
  }
  __syncthreads();
  for (int it = blockIdx.x; it < T / 64; it += gridDim.x) {
    const int tb = it * 64;
    __syncthreads();
    if (tid < 24) lcnt[tid] = 0;
    float4 nxa[4]; uint2 nxm[4];
    {
      const size_t tn = (size_t)tb + w * 16;
#pragma unroll
      for (int i = 0; i < 4; ++i) {
        nxa[i] = *(const float4*)(Xin + tn * 1024 + i * 256 + lane * 4);
        nxm[i] = *(const uint2*)(MIX + tn * 1024 + i * 256 + lane * 4);
      }
    }
    for (int tk = 0; tk < 16; ++tk) {
      const size_t t = (size_t)tb + w * 16 + tk;
      float4 cxa[4]; uint2 cxm[4];
#pragma unroll
      for (int i = 0; i < 4; ++i) { cxa[i] = nxa[i]; cxm[i] = nxm[i]; }
      {
        const size_t tn = (size_t)tb + w * 16 + (tk < 15 ? tk + 1 : 15);
#pragma unroll
        for (int i = 0; i < 4; ++i) {
          nxa[i] = *(const float4*)(Xin + tn * 1024 + i * 256 + lane * 4);
          nxm[i] = *(const uint2*)(MIX + tn * 1024 + i * 256 + lane * 4);
        }
      }
      float xv[16];
      float s = 0.f;
#pragma unroll
      for (int i = 0; i < 4; ++i) {
        const float4 a = cxa[i];
        const float4 m = make_float4(__uint_as_float(cxm[i].x << 16), __uint_as_float(cxm[i].x & 0xffff0000u), __uint_as_float(cxm[i].y << 16), __uint_as_float(cxm[i].y & 0xffff0000u));
        xv[4 * i] = ALPHA * a.x + m.x; xv[4 * i + 1] = ALPHA * a.y + m.y;
        xv[4 * i + 2] = ALPHA * a.z + m.z; xv[4 * i + 3] = ALPHA * a.w + m.w;
        s += xv[4 * i] + xv[4 * i + 1] + xv[4 * i + 2] + xv[4 * i + 3];
      }
      const float mu = wave_sum(s) * (1.f / 1024.f);
      float vs = 0.f;
#pragma unroll
      for (int e = 0; e < 16; ++e) { float d = xv[e] - mu; vs += d * d; }
      const float rstd = rsqrtf(wave_sum(vs) * (1.f / 1024.f) + 1e-5f);
      float acc[20];
#pragma unroll
      for (int c = 0; c < 20; ++c) acc[c] = 0.f;
#pragma unroll
      for (int i = 0; i < 4; ++i) {
        float4 gg = *(const float4*)(g1 + i * 256 + lane * 4);
        float4 bb = *(const float4*)(b1 + i * 256 + lane * 4);
        const float o0 = (xv[4 * i] - mu) * rstd * gg.x + bb.x;
        const float o1 = (xv[4 * i + 1] - mu) * rstd * gg.y + bb.y;
        const float o2 = (xv[4 * i + 2] - mu) * rstd * gg.z + bb.z;
        const float o3 = (xv[4 * i + 3] - mu) * rstd * gg.w + bb.w;
        *(uint2*)(X1b + t * 1024 + i * 256 + lane * 4) = make_uint2(pack2(o0, o1), pack2(o2, o3));
#pragma unroll
        for (int c = 0; c < 16; ++c) {
          float4 wv = *(const float4*)(Wes + c * 1024 + i * 256 + lane * 4);
          acc[4 + c] += o0 * wv.x + o1 * wv.y + o2 * wv.z + o3 * wv.w;
        }
        const float* wgp = wg + (size_t)(i * 256 + lane * 4) * 4;
        float4 q0 = *(const float4*)(wgp), q1 = *(const float4*)(wgp + 4), q2 = *(const float4*)(wgp + 8), q3 = *(const float4*)(wgp + 12);
        acc[0] += o0 * q0.x + o1 * q1.x + o2 * q2.x + o3 * q3.x;
        acc[1] += o0 * q0.y + o1 * q1.y + o2 * q2.y + o3 * q3.y;
        acc[2] += o0 * q0.z + o1 * q1.z + o2 * q2.z + o3 * q3.z;
        acc[3] += o0 * q0.w + o1 * q1.w + o2 * q2.w + o3 * q3.w;
      }
#pragma unroll
      for (int c = 0; c < 20; ++c) acc[c] = wave_sum(acc[c]);
      float lg[4];
#pragma unroll
      for (int c = 0; c < 4; ++c) lg[c] = acc[c] + bg[c];
      int gi = 0; float gm = lg[0];
#pragma unroll
      for (int c = 1; c < 4; ++c) if (lg[c] > gm) { gm = lg[c]; gi = c; }
      float gs = 0.f;
#pragma unroll
      for (int c = 0; c < 4; ++c) gs += __expf(lg[c] - gm);
      const float gtop = 1.f / gs;
      float ev[4] = {0.f, 0.f, 0.f, 0.f};
#pragma unroll
      for (int gg = 0; gg < 4; ++gg)
#pragma unroll
        for (int c = 0; c < 4; ++c) if (gi == gg) ev[c] = acc[4 + gg * 4 + c] + be[gg * 4 + c];
      int i1 = 0; float v1 = ev[0];
#pragma unroll
      for (int c = 1; c < 4; ++c) if (ev[c] > v1) { v1 = ev[c]; i1 = c; }
      int i2 = -1; float v2 = -3e38f;
#pragma unroll
      for (int c = 0; c < 4; ++c) if (c != i1 && ev[c] > v2) { v2 = ev[c]; i2 = c; }
      const float ex = __expf(v2 - v1);
      const float w1 = gtop / (1.f + ex), w2 = gtop * ex / (1.f + ex);
      const int lo = min(i1, i2), hi = max(i1, i2);
      const float wlo = (i1 < i2) ? w1 : w2, whi = (i1 < i2) ? w2 : w1;
      const int pi = (lo == 0) ? (hi - 1) : ((lo == 1) ? (hi + 1) : 5);
      if (lane == 0) {
        const int tl = w * 16 + tk;
        tokb[tl] = gi * 6 + pi;
        tokw[(size_t)(tb + tl) * 2] = wlo;
        tokw[(size_t)(tb + tl) * 2 + 1] = whi;
      }
    }
    __syncthreads();
    int myb = 0;
    if (tid < 64) { myb = tokb[tid]; lpos[tid] = atomicAdd(&lcnt[myb], 1); }
    __syncthreads();
    if (tid < 24) { int c = lcnt[tid]; lbase[tid] = c ? atomicAdd(&gcnt[tid], c) : 0; }
    __syncthreads();
    if (tid < 64) list[(size_t)myb * T + lbase[myb] + lpos[tid]] = tb + tid;
  }
}

struct MoeTile { int bk, r0, cnt, srow0, elo, ehi; };
DEV int moe_total_tiles(const int* gcnt) {
  int tot = 0;
  for (int b = 0; b < 24; ++b) tot += (gcnt[b] + 127) >> 7;
  return tot;
}
DEV MoeTile moe_find(const int* gcnt, int tile) {
  MoeTile r; int acc = 0, srow = 0; r.bk = 0; r.r0 = 0; r.cnt = 0; r.srow0 = 0;
  for (int b = 0; b < 24; ++b) {
    int c = gcnt[b]; int nt = (c + 127) >> 7;
    if (tile >= acc && tile < acc + nt) { r.bk = b; r.r0 = (tile - acc) * 128; r.cnt = c; r.srow0 = srow; }
    acc += nt; srow += c;
  }
  int g = r.bk / 6, pi = r.bk - g * 6;
  int lo = (pi < 3) ? 0 : ((pi < 5) ? 1 : 2);
  int hi = (pi < 3) ? pi + 1 : ((pi < 5) ? pi - 1 : 3);
  r.elo = g * 4 + lo; r.ehi = g * 4 + hi;
  return r;
}

DEV void phase_moe1(const Params& p, int layer, unsigned char* smem) {
  const int* gcnt = (const int*)(p.ws + S_CNT) + layer * 32;
  const int* list = (const int*)(p.ws + S_LIST);
  const float* tokw = (const float*)(p.ws + S_TOKW);
  const bfu* X1b = (const bfu*)(p.ws + OFF_X1B);
  const bfu* Wgu = (const bfu*)(p.ws + OFF_WGU) + (size_t)layer * 16 * 512 * 1024;
  bfu* H = (bfu*)(p.ws + OFF_H);
  const int total = moe_total_tiles(gcnt) * 8;
  const int r0 = my_tid() >> 3;
  auto mkA = [&](const MoeTile& mt) {
    GatherLoader g;
    g.base = X1b;
#pragma unroll
    for (int i = 0; i < 4; ++i) {
      const int r = mt.r0 + r0 + 32 * i;
      const int tok = list[(size_t)mt.bk * T + (r < mt.cnt ? r : 0)];
      g.off[i] = (unsigned)tok * 1024u;
    }
    return g;
  };
  auto mkB = [&](const MoeTile& mt, int nt) {
    const int ex = (nt < 4) ? mt.elo : mt.ehi;
    return RowLoader{Wgu, (unsigned)(ex * 512 + (nt & 3) * 128 + r0) * 1024u, 32768u};
  };
  GemmPipe gp;
  bool first = true;
  int it = blockIdx.x;
  if (it >= total) return;
  MoeTile mt = moe_find(gcnt, it >> 3);
  GatherLoader al = mkA(mt);
  RowLoader bl = mkB(mt, it & 7);
  for (;;) {
    const int nt = it & 7;
    const int itn = it + gridDim.x;
    const bool hasNext = itn < total;
    const int itq = hasNext ? itn : it;
    const MoeTile mtn = moe_find(gcnt, itq >> 3);
    const GatherLoader aln = mkA(mtn);
    const RowLoader bln = mkB(mtn, itq & 7);
    auto epi = [&](f32x4(&acc)[4][4], int wm, int wn, int l15, int lq) {
      const int q = (nt & 3) * 2 + wn;
#pragma unroll
      for (int bi = 0; bi < 4; ++bi) {
        const int r = mt.r0 + wm * 64 + bi * 16 + l15;
        if (r < mt.cnt) {
          const int tok = list[(size_t)mt.bk * T + r];
          const float gw = tokw[(size_t)tok * 2 + (nt >> 2)];
#pragma unroll
          for (int ai = 0; ai < 2; ++ai) {
            float o[4];
#pragma unroll
            for (int j = 0; j < 4; ++j) o[j] = siluf(acc[ai][bi][j]) * acc[ai + 2][bi][j] * gw;
            *(uint2*)(H + (size_t)(mt.srow0 + r) * 512 + (nt >> 2) * 256 + q * 32 + ai * 16 + lq * 4) =
                make_uint2(pack2(o[0], o[1]), pack2(o[2], o[3]));
          }
        }
      }
    };
    gemm128(true, 1024, first, hasNext, al, bl, aln, bln, epi, gp, smem);
    first = false;
    if (!hasNext) break;
    it = itn; mt = mtn; al = aln; bl = bln;
  }
}

DEV void phase_moe2(const Params& p, int layer, unsigned char* smem) {
  const int* gcnt = (const int*)(p.ws + S_CNT) + layer * 32;
  const int* list = (const int*)(p.ws + S_LIST);
  const bfu* H = (const bfu*)(p.ws + OFF_H);
  const bfu* Wdn = (const bfu*)(p.ws + OFF_WDN) + (size_t)layer * 16 * 1024 * 256;
  bfu* FF = (bfu*)(p.ws + OFF_MIX);
  const int total = moe_total_tiles(gcnt) * 8;
  const int r0 = my_tid() >> 3;
  auto mkA = [&](const MoeTile& mt) { return RowLoader{H, (unsigned)(mt.srow0 + mt.r0 + r0) * 512u, 16384u}; };
  auto mkB = [&](const MoeTile& mt, int nt) {
    return SplitKLoader{Wdn, (unsigned)(mt.elo * 1024 + nt * 128 + r0) * 256u, (unsigned)((mt.ehi - mt.elo) * 1024) * 256u};
  };
  GemmPipe gp;
  bool first = true;
  int it = blockIdx.x;
  if (it >= total) return;
  MoeTile mt = moe_find(gcnt, it >> 3);
  RowLoader al = mkA(mt);
  SplitKLoader bl = mkB(mt, it & 7);
  for (;;) {
    const int nt = it & 7;
    const int itn = it + gridDim.x;
    const bool hasNext = itn < total;
    const int itq = hasNext ? itn : it;
    const MoeTile mtn = moe_find(gcnt, itq >> 3);
    const RowLoader aln = mkA(mtn);
    const SplitKLoader bln = mkB(mtn, itq & 7);
    auto epi = [&](f32x4(&acc)[4][4], int wm, int wn, int l15, int lq) {
#pragma unroll
      for (int bi = 0; bi < 4; ++bi) {
        const int r = mt.r0 + wm * 64 + bi * 16 + l15;
        if (r < mt.cnt) {
          const int tok = list[(size_t)mt.bk * T + r];
#pragma unroll
          for (int ai = 0; ai < 4; ++ai)
            *(uint2*)(FF + (size_t)tok * 1024 + nt * 128 + wn * 64 + ai * 16 + lq * 4) =
                make_uint2(pack2(acc[ai][bi][0], acc[ai][bi][1]), pack2(acc[ai][bi][2], acc[ai][bi][3]));
        }
      }
    };
    gemm128(true, 512, first, hasNext, al, bl, aln, bln, epi, gp, smem);
    first = false;
    if (!hasNext) break;
    it = itn; mt = mtn; al = aln; bl = bln;
  }
}

DEV void phase_ln2(const Params& p, int layer, float* __restrict__ outp, bfu* __restrict__ outb) {
  const bfu* X1b = (const bfu*)(p.ws + OFF_X1B);
  const bfu* FF = (const bfu*)(p.ws + OFF_MIX);
  const float* g2 = p.ln2_g + layer * 1024;
  const float* b2 = p.ln2_b + layer * 1024;
  const int lane = my_tid() & 63, w = my_tid() >> 6;
  const int stride = gridDim.x * 4;
  int t = blockIdx.x * 4 + w;
  if (t >= T) return;
  uint2 nxa[4]; uint2 nxm[4];
#pragma unroll
  for (int i = 0; i < 4; ++i) {
    nxa[i] = *(const uint2*)(X1b + (size_t)t * 1024 + i * 256 + lane * 4);
    nxm[i] = *(const uint2*)(FF + (size_t)t * 1024 + i * 256 + lane * 4);
  }
  for (; t < T; t += stride) {
    uint2 cxa[4]; uint2 cxm[4];
#pragma unroll
    for (int i = 0; i < 4; ++i) { cxa[i] = nxa[i]; cxm[i] = nxm[i]; }
    {
      const int tn = (t + stride < T) ? t + stride : t;
#pragma unroll
      for (int i = 0; i < 4; ++i) {
        nxa[i] = *(const uint2*)(X1b + (size_t)tn * 1024 + i * 256 + lane * 4);
        nxm[i] = *(const uint2*)(FF + (size_t)tn * 1024 + i * 256 + lane * 4);
      }
    }
    float xv[16];
    float s = 0.f;
#pragma unroll
    for (int i = 0; i < 4; ++i) {
      const uint2 ab_ = cxa[i];
      const float4 a = make_float4(__uint_as_float(ab_.x << 16), __uint_as_float(ab_.x & 0xffff0000u), __uint_as_float(ab_.y << 16), __uint_as_float(ab_.y & 0xffff0000u));
      const uint2 mb = cxm[i];
      const float4 m = make_float4(__uint_as_float(mb.x << 16), __uint_as_float(mb.x & 0xffff0000u), __uint_as_float(mb.y << 16), __uint_as_float(mb.y & 0xffff0000u));
      xv[4 * i] = ALPHA * a.x + m.x; xv[4 * i + 1] = ALPHA * a.y + m.y;
      xv[4 * i + 2] = ALPHA * a.z + m.z; xv[4 * i + 3] = ALPHA * a.w + m.w;
      s += xv[4 * i] + xv[4 * i + 1] + xv[4 * i + 2] + xv[4 * i + 3];
    }
    const float mu = wave_sum(s) * (1.f / 1024.f);
    float vs = 0.f;
#pragma unroll
    for (int e = 0; e < 16; ++e) { float d = xv[e] - mu; vs += d * d; }
    const float rstd = rsqrtf(wave_sum(vs) * (1.f / 1024.f) + 1e-5f);
#pragma unroll
    for (int i = 0; i < 4; ++i) {
      float4 gg = *(const float4*)(g2 + i * 256 + lane * 4);
      float4 bb = *(const float4*)(b2 + i * 256 + lane * 4);
      const float o0 = (xv[4 * i] - mu) * rstd * gg.x + bb.x, o1 = (xv[4 * i + 1] - mu) * rstd * gg.y + bb.y;
      const float o2 = (xv[4 * i + 2] - mu) * rstd * gg.z + bb.z, o3 = (xv[4 * i + 3] - mu) * rstd * gg.w + bb.w;
      *(float4*)(outp + (size_t)t * 1024 + i * 256 + lane * 4) = make_float4(o0, o1, o2, o3);
      if (outb) *(uint2*)(outb + (size_t)t * 1024 + i * 256 + lane * 4) = make_uint2(pack2(o0, o1), pack2(o2, o3));
    }
  }
}

template <int NK, bool SINK, typename KP, typename VP, typename MK, typename OUT>
DEV void attn_core(const bfu* qptr, KP kptr, VP vptr, MK maskf, float sink, OUT outf, unsigned char* smem) {
  constexpr int NT = NK / 16;
  constexpr int VS = NK + 16;
  constexpr int KS = 80;
  bfu* Ks = (bfu*)smem;
  bfu* Ps = Ks;
  bfu* Vt = Ks + NK * KS;
  const int tid = my_tid(), lane = tid & 63, w = tid >> 6, l15 = lane & 15, lq = lane >> 4;
  uint4 k0, k1, k2, k3, k4, k5, k6, k7, v0, v1, v2, v3, v4, v5, v6, v7;
#define ATT_LD(i) if constexpr (i < NK / 32) { const int idx = tid + 256 * i; const int kk = idx >> 3, sg = idx & 7; \
    k##i = *(const uint4*)(kptr(kk) + sg * 8); const int d = idx / (NK / 8), k8 = idx - d * (NK / 8); v##i = *(const uint4*)(vptr(d, k8)); }
  ATT_LD(0) ATT_LD(1) ATT_LD(2) ATT_LD(3) ATT_LD(4) ATT_LD(5) ATT_LD(6) ATT_LD(7)
#undef ATT_LD
  const uint4 qf0 = *(const uint4*)(qptr + lq * 8), qf1 = *(const uint4*)(qptr + 32 + lq * 8);
  __syncthreads();
#define ATT_ST(i) if constexpr (i < NK / 32) { const int idx = tid + 256 * i; const int kk = idx >> 3, sg = idx & 7; \
    *(uint4*)(Ks + kk * KS + sg * 8) = k##i; const int d = idx / (NK / 8), k8 = idx - d * (NK / 8); *(uint4*)(Vt + d * VS + k8 * 8) = v##i; }
  ATT_ST(0) ATT_ST(1) ATT_ST(2) ATT_ST(3) ATT_ST(4) ATT_ST(5) ATT_ST(6) ATT_ST(7)
#undef ATT_ST
  __syncthreads();
  f32x4 s[NT];
#pragma unroll
  for (int ni = 0; ni < NT; ++ni) {
    f32x4 a = f32x4{0.f, 0.f, 0.f, 0.f};
    a = mfma16(lds128(Ks + (ni * 16 + l15) * KS + lq * 8), qf0, a);
    a = mfma16(lds128(Ks + (ni * 16 + l15) * KS + 32 + lq * 8), qf1, a);
    s[ni] = a;
  }
  const int row = 16 * w + l15;
  float mx = NEGF;
#pragma unroll
  for (int ni = 0; ni < NT; ++ni)
#pragma unroll
    for (int j = 0; j < 4; ++j) {
      const int kk = ni * 16 + lq * 4 + j;
      float v = maskf(row, kk) ? s[ni][j] * 0.125f : NEGF;
      s[ni][j] = v;
      mx = fmaxf(mx, v);
    }
  mx = fmaxf(mx, __shfl_xor(mx, 16));
  mx = fmaxf(mx, __shfl_xor(mx, 32));
  if (SINK) mx = fmaxf(mx, sink);
  float ls = 0.f;
#pragma unroll
  for (int ni = 0; ni < NT; ++ni)
#pragma unroll
    for (int j = 0; j < 4; ++j) {
      float pv = __expf(s[ni][j] - mx);
      ls += pv;
      s[ni][j] = pv;
    }
  ls += __shfl_xor(ls, 16);
  ls += __shfl_xor(ls, 32);
  if (SINK) ls += __expf(sink - mx);
  __syncthreads();
#pragma unroll
  for (int ni = 0; ni < NT; ++ni)
    *(uint2*)(Ps + row * VS + ni * 16 + lq * 4) = make_uint2(pack2(s[ni][0], s[ni][1]), pack2(s[ni][2], s[ni][3]));
  __syncthreads();
  f32x4 o[4];
#pragma unroll
  for (int ni = 0; ni < 4; ++ni) o[ni] = f32x4{0.f, 0.f, 0.f, 0.f};
#pragma unroll
  for (int ks = 0; ks < NK / 32; ++ks) {
    uint4 pb = lds128(Ps + row * VS + ks * 32 + lq * 8);
#pragma unroll
    for (int ni = 0; ni < 4; ++ni) o[ni] = mfma16(lds128(Vt + (ni * 16 + l15) * VS + ks * 32 + lq * 8), pb, o[ni]);
  }
#pragma unroll
  for (int ni = 0; ni < 4; ++ni) outf(row, ni * 16 + lq * 4, o[ni], mx, ls);
}

DEV void swa_item(const Params& p, int it, unsigned char* smem) {
  const int h = it & 7, qt = (it >> 3) & 255, b = it >> 11;
  const int hk = h >> 2;
  const int t0 = qt * 64, kstart = t0 - 128;
  const bfu* P = (const bfu*)(p.ws + OFF_P);
  bfu* Y = (bfu*)(p.ws + OFF_Y);
  const int lane = my_tid() & 63, w = my_tid() >> 6, l15 = lane & 15;
  const bfu* qptr = P + ((size_t)b * L + t0 + 16 * w + l15) * 1536 + h * 64;
  const bfu* kb = P + (size_t)b * L * 1536 + 512 + hk * 64;
  auto kptr = [&](int kk) -> const bfu* { int pos = kstart + kk; pos = pos < 0 ? 0 : pos; return kb + (size_t)pos * 1536; };
  const bfu* vtb = (const bfu*)(p.ws + OFF_VT) + (size_t)((0 * 2 + b) * 2 + hk) * 64 * L;
  auto vptr = [&](int d, int k8) -> const bfu* { int pos = kstart + k8 * 8; pos = pos < 0 ? 0 : pos; return vtb + (size_t)d * L + pos; };
  auto maskf = [&](int row, int kk) -> bool { int pos = kstart + kk, t = t0 + row; return pos >= 0 && pos <= t && (t - pos) < 128; };
  auto outf = [&](int row, int d0, f32x4 o, float m, float l) {
    const float inv = 1.f / l;
    *(uint2*)(Y + ((size_t)b * L + t0 + row) * 1024 + h * 64 + d0) = make_uint2(pack2(o[0] * inv, o[1] * inv), pack2(o[2] * inv, o[3] * inv));
  };
  attn_core<192, true>(qptr, kptr, vptr, maskf, p.od_sinks[h], outf, smem);
}

DEV void kmean_item(const Params& p, int it, unsigned char* smem) {
  const int j = it & 63, bhk = it >> 6, b = bhk >> 1, hk = bhk & 1;
  const bfu* P = (const bfu*)(p.ws + OFF_P);
  float* red = (float*)smem;
  const int tid = my_tid(), d = tid & 63, part = tid >> 6;
  const bfu* kb = P + ((size_t)b * L + j * 256 + part * 64) * 1536 + 1280 + hk * 64 + d;
  float s = 0.f;
  for (int i = 0; i < 64; ++i) s += bf2f(kb[(size_t)i * 1536]);
  __syncthreads();
  red[part * 64 + d] = s;
  __syncthreads();
  if (tid < 64) {
    float tot = red[tid] + red[64 + tid] + red[128 + tid] + red[192 + tid];
    ((bfu*)(p.ws + S_KMEAN))[(size_t)it * 64 + tid] = f2bf(tot * (1.f / 256.f));
  }
}

DEV int cap_off(int j) { return 1024 * (63 * j - (j * (j - 1)) / 2); }

DEV void moba_own_item(const Params& p, int it, unsigned char* smem) {
  const int h = it & 7, o4 = (it >> 3) & 3, c = (it >> 5) & 63, b = it >> 11;
  const int hk = h >> 2, g = h & 3;
  const int t0 = c * 256 + o4 * 64;
  const bfu* P = (const bfu*)(p.ws + OFF_P);
  bfu* PO = (bfu*)(p.ws + OFF_PO);
  float* PM = (float*)(p.ws + OFF_PM);
  float* PL = (float*)(p.ws + OFF_PL);
  const int tid = my_tid(), lane = tid & 63, w = tid >> 6, l15 = lane & 15, lq = lane >> 4;
  const bfu* qptr = P + ((size_t)b * L + t0 + 16 * w + l15) * 1536 + 768 + h * 64;
  const bfu* kb = P + ((size_t)b * L + c * 256) * 1536 + 1280 + hk * 64;
  auto kptr = [&](int kk) -> const bfu* { return kb + (size_t)kk * 1536; };
  const bfu* vtb = (const bfu*)(p.ws + OFF_VT) + (size_t)((1 * 2 + b) * 2 + hk) * 64 * L + c * 256;
  auto vptr = [&](int d, int k8) -> const bfu* { return vtb + (size_t)d * L + k8 * 8; };
  auto maskf = [&](int row, int kk) -> bool { return kk <= o4 * 64 + row; };
  auto outf = [&](int row, int d0, f32x4 o, float m, float l) {
    const size_t idx = (((size_t)b * L + t0 + row) * 8 + h) * 4;
    const float inv = 1.f / l;
    *(uint2*)(PO + idx * 64 + d0) = make_uint2(pack2(o[0] * inv, o[1] * inv), pack2(o[2] * inv, o[3] * inv));
    if (d0 == 0) { PM[idx] = m; PL[idx] = l; }
  };
  attn_core<256, false>(qptr, kptr, vptr, maskf, 0.f, outf, smem);
  int* lcnt = (int*)(smem + SM_AUX);
  int* lbase = lcnt + 64;
  int* sel = lbase + 64;
  if (tid < 64) lcnt[tid] = 0;
  __syncthreads();
  const uint4 qf0 = *(const uint4*)(qptr + lq * 8), qf1 = *(const uint4*)(qptr + 32 + lq * 8);
  const bfu* km = (const bfu*)(p.ws + S_KMEAN) + (size_t)(b * 2 + hk) * 64 * 64;
  float cand[4][4];
#pragma unroll
  for (int ni = 0; ni < 4; ++ni) {
    f32x4 a = f32x4{0.f, 0.f, 0.f, 0.f};
    a = mfma16(qf0, *(const uint4*)(km + (ni * 16 + l15) * 64 + lq * 8), a);
    a = mfma16(qf1, *(const uint4*)(km + (ni * 16 + l15) * 64 + 32 + lq * 8), a);
#pragma unroll
    for (int j = 0; j < 4; ++j) cand[ni][j] = (ni * 16 + l15 < c) ? a[j] : -3e38f;
  }
#pragma unroll
  for (int j = 0; j < 4; ++j) {
    const int row = 16 * w + lq * 4 + j;
#pragma unroll
    for (int sl = 0; sl < 3; ++sl) {
      float bv = cand[0][j]; int bi = l15;
#pragma unroll
      for (int ni = 1; ni < 4; ++ni) if (cand[ni][j] > bv) { bv = cand[ni][j]; bi = ni * 16 + l15; }
#pragma unroll
      for (int off = 8; off >= 1; off >>= 1) {
        float ov = __shfl_xor(bv, off); int oi = __shfl_xor(bi, off);
        if (ov > bv || (ov == bv && oi < bi)) { bv = ov; bi = oi; }
      }
      const bool valid = bv > -1e38f;
#pragma unroll
      for (int ni = 0; ni < 4; ++ni) if (ni * 16 + l15 == bi) cand[ni][j] = -3e38f;
      if (l15 == 0) {
        const size_t idx = (((size_t)b * L + t0 + row) * 8 + h) * 4 + 1 + sl;
        if (valid) {
          int lp = atomicAdd(&lcnt[bi], 1);
          sel[row * 3 + sl] = bi | (lp << 8);
        } else {
          sel[row * 3 + sl] = -1;
          PM[idx] = NEGF; PL[idx] = 0.f;
        }
      }
    }
  }
  __syncthreads();
  int* gcnt = (int*)(p.ws + S_CNT) + 64 + (b * 2 + hk) * 64;
  if (tid < 64) { int cc = lcnt[tid]; lbase[tid] = cc ? atomicAdd(&gcnt[tid], cc) : 0; }
  __syncthreads();
  if (tid < 192) {
    const int row = tid / 3, sl = tid - row * 3;
    const int sv = sel[tid];
    if (sv >= 0) {
      const int bi = sv & 255, lp = sv >> 8;
      int* bucket = (int*)(p.ws + OFF_BUCK) + (size_t)(b * 2 + hk) * BUCK_PER_BH + cap_off(bi);
      bucket[lbase[bi] + lp] = ((t0 + row) << 4) | (g << 2) | (sl + 1);
    }
  }
}

DEV void phase_moba_bucket(const Params& p, unsigned char* smem) {
  int* pref = (int*)(smem + SM_AUX);
  const int* gcnt = (const int*)(p.ws + S_CNT) + 64;
  const int tid = my_tid(), lane = tid & 63, w = tid >> 6, l15 = lane & 15;
  {
    int nt = (gcnt[tid] + 63) >> 6;
    __syncthreads();
    pref[tid] = nt;
    __syncthreads();
    for (int off = 1; off < 256; off <<= 1) {
      int v = pref[tid];
      if (tid >= off) v += pref[tid - off];
      __syncthreads();
      pref[tid] = v;
      __syncthreads();
    }
  }
  const int total = pref[255];
  const bfu* P = (const bfu*)(p.ws + OFF_P);
  bfu* PO = (bfu*)(p.ws + OFF_PO);
  float* PM = (float*)(p.ws + OFF_PM);
  float* PL = (float*)(p.ws + OFF_PL);
  const int lq = lane >> 4;
  struct Item { int bk, cnt, rbase; };
  auto decode = [&](int it) -> Item {
    int lo = 0, hi = 255;
    while (lo < hi) { int mid = (lo + hi) >> 1; if (pref[mid] > it) hi = mid; else lo = mid + 1; }
    Item r; r.bk = lo; r.cnt = gcnt[lo];
    const int ntb = (r.cnt + 63) >> 6;
    r.rbase = (it - (pref[lo] - ntb)) * 64;
    return r;
  };
  auto bucket_of = [&](int bk) -> const int* {
    return (const int*)(p.ws + OFF_BUCK) + (size_t)(bk >> 6) * BUCK_PER_BH + cap_off(bk & 63);
  };
  auto load_entries = [&](const Item& im, int& e, int (&en)[4]) {
    const int* bucket = bucket_of(im.bk);
    const int rr = im.rbase + 16 * w + l15;
    e = bucket[rr < im.cnt ? rr : 0];
#pragma unroll
    for (int j = 0; j < 4; ++j) { const int r = im.rbase + 16 * w + lq * 4 + j; en[j] = bucket[r < im.cnt ? r : 0]; }
  };
  int it = blockIdx.x;
  if (it >= total) return;
  Item cur = decode(it);
  int e, en[4];
  load_entries(cur, e, en);
  for (;;) {
    const int itn = it + gridDim.x;
    const bool hasNext = itn < total;
    Item nxt = cur; int e2 = e, en2[4] = {en[0], en[1], en[2], en[3]};
    if (hasNext) { nxt = decode(itn); load_entries(nxt, e2, en2); }
    const int bk = cur.bk, cnt = cur.cnt, rbase = cur.rbase;
    const int j = bk & 63, bhk = bk >> 6, b = bhk >> 1, hk = bhk & 1;
    const bfu* qptr = P + ((size_t)b * L + (e >> 4)) * 1536 + 768 + (hk * 4 + ((e >> 2) & 3)) * 64;
    const bfu* kb = P + ((size_t)b * L + j * 256) * 1536 + 1280 + hk * 64;
    auto kptr = [&](int kk) -> const bfu* { return kb + (size_t)kk * 1536; };
    const bfu* vtb = (const bfu*)(p.ws + OFF_VT) + (size_t)((1 * 2 + b) * 2 + hk) * 64 * L + j * 256;
    auto vptr = [&](int d, int k8) -> const bfu* { return vtb + (size_t)d * L + k8 * 8; };
    auto maskf = [&](int row, int kk) -> bool { return true; };
    auto outf = [&](int row, int d0, f32x4 o, float m, float l) {
      if (rbase + row < cnt) {
        const size_t idx = (((size_t)b * L + (e >> 4)) * 8 + hk * 4 + ((e >> 2) & 3)) * 4 + (e & 3);
        const float inv = 1.f / l;
        *(uint2*)(PO + idx * 64 + d0) = make_uint2(pack2(o[0] * inv, o[1] * inv), pack2(o[2] * inv, o[3] * inv));
        if (d0 == 0) { PM[idx] = m; PL[idx] = l; }
      }
    };
    attn_core<256, false>(qptr, kptr, vptr, maskf, 0.f, outf, smem);
    if (!hasNext) break;
    it = itn; cur = nxt; e = e2;
#pragma unroll
    for (int q = 0; q < 4; ++q) en[q] = en2[q];
  }
}

DEV void phase_moba_merge(const Params& p) {
  const bfu* PO = (const bfu*)(p.ws + OFF_PO);
  const float* PM = (const float*)(p.ws + OFF_PM);
  const float* PL = (const float*)(p.ws + OFF_PL);
  bfu* Y = (bfu*)(p.ws + OFF_Y);
  const size_t total = (size_t)T * 8 * 8;
  for (size_t id = (size_t)blockIdx.x * 256 + my_tid(); id < total; id += (size_t)gridDim.x * 256) {
    const int ds = (int)(id & 7);
    const size_t th = id >> 3;
    const float4 m4 = *(const float4*)(PM + th * 4);
    const float4 l4 = *(const float4*)(PL + th * 4);
    float mm[4] = {m4.x, m4.y, m4.z, m4.w}, ll[4] = {l4.x, l4.y, l4.z, l4.w};
    float M = mm[0];
#pragma unroll
    for (int s = 1; s < 4; ++s) if (ll[s] > 0.f) M = fmaxf(M, mm[s]);
    float wsum = 0.f;
    float acc[8] = {0.f, 0.f, 0.f, 0.f, 0.f, 0.f, 0.f, 0.f};
#pragma unroll
    for (int s = 0; s < 4; ++s) {
      if (s == 0 || ll[s] > 0.f) {
        const float wgt = ll[s] * __expf(mm[s] - M);
        wsum += wgt;
        uint4 ov = *(const uint4*)(PO + (th * 4 + s) * 64 + ds * 8);
        unsigned uu[4] = {ov.x, ov.y, ov.z, ov.w};
#pragma unroll
        for (int e = 0; e < 4; ++e) {
          acc[2 * e] += wgt * __uint_as_float(uu[e] << 16);
          acc[2 * e + 1] += wgt * __uint_as_float(uu[e] & 0xffff0000u);
        }
      }
    }
    const float inv = 1.f / wsum;
    const size_t t = th >> 3; const int h = (int)(th & 7);
    *(uint4*)(Y + t * 1024 + 512 + h * 64 + ds * 8) =
        make_uint4(pack2(acc[0] * inv, acc[1] * inv), pack2(acc[2] * inv, acc[3] * inv),
                   pack2(acc[4] * inv, acc[5] * inv), pack2(acc[6] * inv, acc[7] * inv));
  }
}


#define XB_TMO      128
#define XB_XCNT(j)  (256  + 64 * (j))
#define XB_XSUB(j)  (1280 + 64 * (j))
#define XB_XGEN(j)  (2304 + 64 * (j))
#define XB_TOP      3328
#define XB_TOPGEN   3392
#define XCD_BAR_WORDS 3456
#define XB_SPIN_CAP (1u << 22)
#define LAS __attribute__((address_space(3)))
DEV unsigned xb_ld(unsigned* p) { return __hip_atomic_load(p, __ATOMIC_RELAXED, __HIP_MEMORY_SCOPE_AGENT); }
DEV unsigned xb_add(unsigned* p, unsigned v) { return __hip_atomic_fetch_add(p, v, __ATOMIC_RELAXED, __HIP_MEMORY_SCOPE_AGENT); }
DEV unsigned xb_xcc_id() { return (unsigned)__builtin_amdgcn_s_getreg((3 << 11) | 20) & 0xFu; }
#define XB_SPIN(cond, bar) do { unsigned _sp = 0; while (cond) { __builtin_amdgcn_s_sleep(1); \
    if ((++_sp & 255u) == 0u) { if (xb_ld(&(bar)[XB_TMO])) break; if (_sp > XB_SPIN_CAP) { atomicAdd(&(bar)[XB_TMO], 1u); break; } } } } while (0)
struct XcdBarrier { unsigned* bar; unsigned x; volatile LAS unsigned* st; };
DEV XcdBarrier xcd_barrier_post(unsigned* bar, volatile LAS unsigned* st) {
  XcdBarrier b; b.bar = bar; b.x = xb_xcc_id(); b.st = st;
  if (threadIdx.x == 0) (void)xb_add(&bar[XB_XCNT(b.x)], 1u);
  return b;
}
DEV void xcd_barrier_complete(unsigned* bar, unsigned x, unsigned& nloc, unsigned& nx) {
  const unsigned G = gridDim.x * gridDim.y * gridDim.z;
  unsigned sum, cnt, mine, sp = 0u;
  for (;;) {
    sum = 0u; cnt = 0u; mine = 0u;
#pragma unroll
    for (unsigned j = 0; j < 16; ++j) { const unsigned c = xb_ld(&bar[XB_XCNT(j)]); sum += c; cnt += (c > 0u) ? 1u : 0u; mine = (j == x) ? c : mine; }
    if (sum == G) break;
    __builtin_amdgcn_s_sleep(1);
    if ((++sp & 255u) == 0u) { if (xb_ld(&bar[XB_TMO])) break; if (sp > XB_SPIN_CAP) { atomicAdd(&bar[XB_TMO], 1u); break; } }
  }
  nloc = mine > 0u ? mine : 1u; nx = cnt > 0u ? cnt : 1u;
}
DEV void xcd_barrier(const XcdBarrier& b) {
  asm volatile("s_waitcnt vmcnt(0)" ::: "memory");
  __syncthreads();
  if (threadIdx.x == 0) {
    unsigned* bar = b.bar;
    __builtin_amdgcn_s_waitcnt(0);
    unsigned nloc = b.st[0], nx = b.st[1];
    if (nloc == 0u) { xcd_barrier_complete(bar, b.x, nloc, nx); b.st[0] = nloc; b.st[1] = nx; }
    const unsigned old = xb_add(&bar[XB_XSUB(b.x)], 1u);
    const unsigned gen = old / nloc;
    if (old + 1u == (gen + 1u) * nloc) {
      __builtin_amdgcn_fence(__ATOMIC_RELEASE, "agent");
      asm volatile("s_waitcnt vmcnt(0)" ::: "memory");
      const unsigned og = xb_add(&bar[XB_TOP], 1u);
      const unsigned tg = og / nx;
      if (og + 1u == (tg + 1u) * nx) xb_add(&bar[XB_TOPGEN], 1u);
      else XB_SPIN(xb_ld(&bar[XB_TOPGEN]) == tg, bar);
      __builtin_amdgcn_fence(__ATOMIC_ACQUIRE, "agent");
      xb_add(&bar[XB_XGEN(b.x)], 1u);
      asm volatile("s_waitcnt vmcnt(0)" ::: "memory");
    } else {
      XB_SPIN(xb_ld(&bar[XB_XGEN(b.x)]) == gen, bar);
      __builtin_amdgcn_fence(__ATOMIC_ACQUIRE, "agent");
      asm volatile("s_waitcnt vmcnt(0)" ::: "memory");
    }
  }
  __syncthreads();
}

__global__ void __launch_bounds__(256, 2) mega(Params p) {
  __shared__ __attribute__((aligned(16))) unsigned char smem[SMEM_BYTES];
  cg::grid_group grid = cg::this_grid();
  unsigned char* ws = p.ws;
  unsigned* barw = (unsigned*)(ws + S_BAR);
  volatile LAS unsigned* xbst = (volatile LAS unsigned*)(smem + SMEM_BYTES - 16);
  if (threadIdx.x == 0) { xbst[0] = 0u; xbst[1] = 0u; }
  if (blockIdx.x == 0) for (int i = threadIdx.x; i < XCD_BAR_WORDS; i += 256) barw[i] = 0u;

#if XSYNC
  for (int i = 0; i < 20; ++i) grid.sync();
#endif
  phase_prep(p, smem);
#if (DUPMASK >> 0) & 1
  grid.sync();
  phase_prep(p, smem);
#endif
  grid.sync();
  XcdBarrier xb = xcd_barrier_post(barw, xbst);
  phase_proj((const bfu*)(ws + OFF_XB), (const bfu*)(ws + OFF_WEVIN), (bfu*)(ws + OFF_P), 2560, (bfu*)p.out, 0, smem);
#if (DUPMASK >> 1) & 1
  GSYNC;
  phase_proj((const bfu*)(ws + OFF_XB), (const bfu*)(ws + OFF_WEVIN), (bfu*)(ws + OFF_P), 2560, (bfu*)p.out, 0, smem);
#endif
  GSYNC;
  for (int it = blockIdx.x; it < 2048; it += gridDim.x) hgrn_dstate_item(p, it, smem);
  {
    uint4 bf[8], cf[4]; float2 ab; float dsk;
    s5_load_consts(p, (blockIdx.x & 7) * 4 + (my_tid() >> 6), my_tid() & 63, bf, cf, ab, dsk);
    for (int it = blockIdx.x; it < 4096; it += gridDim.x) s5_pass1_item(p, it, bf, ab, smem);
  }
#if (DUPMASK >> 2) & 1
  GSYNC;
  for (int it = blockIdx.x; it < 2048; it += gridDim.x) hgrn_dstate_item(p, it, smem);
  {
    uint4 bf[8], cf[4]; float2 ab; float dsk;
    s5_load_consts(p, (blockIdx.x & 7) * 4 + (my_tid() >> 6), my_tid() & 63, bf, cf, ab, dsk);
    for (int it = blockIdx.x; it < 4096; it += gridDim.x) s5_pass1_item(p, it, bf, ab, smem);
  }
#endif
  GSYNC;
  if (blockIdx.x < 64) hgrn_scan_item(p, blockIdx.x);
  else if (blockIdx.x < 80) s5_carry_item(p, blockIdx.x - 64);
#if (DUPMASK >> 3) & 1
  GSYNC;
  if (blockIdx.x < 64) hgrn_scan_item(p, blockIdx.x);
  else if (blockIdx.x < 80) s5_carry_item(p, blockIdx.x - 64);
#endif
  GSYNC;
  for (int it = blockIdx.x; it < 2048; it += gridDim.x) hgrn_out_item(p, it, smem);
  {
    uint4 bf[8], cf[4]; float2 ab; float dsk;
    s5_load_consts(p, (blockIdx.x & 7) * 4 + (my_tid() >> 6), my_tid() & 63, bf, cf, ab, dsk);
    for (int it = blockIdx.x; it < 4096; it += gridDim.x) s5_pass2_item(p, it, bf, cf, ab, dsk, smem);
  }
#if (DUPMASK >> 4) & 1
  GSYNC;
  for (int it = blockIdx.x; it < 2048; it += gridDim.x) hgrn_out_item(p, it, smem);
  {
    uint4 bf[8], cf[4]; float2 ab; float dsk;
    s5_load_consts(p, (blockIdx.x & 7) * 4 + (my_tid() >> 6), my_tid() & 63, bf, cf, ab, dsk);
    for (int it = blockIdx.x; it < 4096; it += gridDim.x) s5_pass2_item(p, it, bf, cf, ab, dsk, smem);
  }
#endif
  GSYNC;
  phase_glu(p, smem);
#if (DUPMASK >> 5) & 1
  GSYNC;
  phase_glu(p, smem);
#endif
  GSYNC;
  phase_outproj(p, (const bfu*)(ws + OFF_WEVOUT), smem);
#if (DUPMASK >> 6) & 1
  GSYNC;
  phase_outproj(p, (const bfu*)(ws + OFF_WEVOUT), smem);
#endif
  GSYNC;
  phase_ln1_router(p, p.x, 0, smem);
#if (DUPMASK >> 7) & 1
  GSYNC;
  if (blockIdx.x == 0 && my_tid() < 24) ((int*)(ws + S_CNT))[my_tid()] = 0;
  GSYNC;
  phase_ln1_router(p, p.x, 0, smem);
#endif
  GSYNC;
  phase_moe1(p, 0, smem);
#if (DUPMASK >> 8) & 1
  GSYNC;
  phase_moe1(p, 0, smem);
#endif
  GSYNC;
  phase_moe2(p, 0, smem);
#if (DUPMASK >> 9) & 1
  GSYNC;
  phase_moe2(p, 0, smem);
#endif
  GSYNC;
  phase_ln2(p, 0, p.out, (bfu*)(ws + OFF_X2B));
#if (DUPMASK >> 10) & 1
  GSYNC;
  phase_ln2(p, 0, p.out, (bfu*)(ws + OFF_X2B));
#endif
  GSYNC;
  phase_proj((const bfu*)(ws + OFF_X2B), (const bfu*)(ws + OFF_WODIN), (bfu*)(ws + OFF_P), 1536, (bfu*)(ws + OFF_VT), 1, smem);
#if (DUPMASK >> 11) & 1
  GSYNC;
  phase_proj((const bfu*)(ws + OFF_X2B), (const bfu*)(ws + OFF_WODIN), (bfu*)(ws + OFF_P), 1536, (bfu*)(ws + OFF_VT), 1, smem);
#endif
  GSYNC;
  for (int it = blockIdx.x; it < 4096 + 256; it += gridDim.x) {
    if (it < 4096) swa_item(p, it, smem); else kmean_item(p, it - 4096, smem);
  }
#if (DUPMASK >> 12) & 1
  GSYNC;
  for (int it = blockIdx.x; it < 4096 + 256; it += gridDim.x) {
    if (it < 4096) swa_item(p, it, smem); else kmean_item(p, it - 4096, smem);
  }
#endif
  GSYNC;
  for (int it = blockIdx.x; it < 4096; it += gridDim.x) moba_own_item(p, it, smem);
#if (DUPMASK >> 13) & 1
  GSYNC;
  if (blockIdx.x == 0) ((int*)(ws + S_CNT))[64 + my_tid()] = 0;
  GSYNC;
  for (int it = blockIdx.x; it < 4096; it += gridDim.x) moba_own_item(p, it, smem);
#endif
  GSYNC;
  phase_moba_bucket(p, smem);
#if (DUPMASK >> 14) & 1
  GSYNC;
  phase_moba_bucket(p, smem);
#endif
  GSYNC;
  phase_moba_merge(p);
#if (DUPMASK >> 15) & 1
  GSYNC;
  phase_moba_merge(p);
#endif
  GSYNC;
  phase_outproj(p, (const bfu*)(ws + OFF_WODOUT), smem);
#if (DUPMASK >> 16) & 1
  GSYNC;
  phase_outproj(p, (const bfu*)(ws + OFF_WODOUT), smem);
#endif
  GSYNC;
  phase_ln1_router(p, p.out, 1, smem);
#if (DUPMASK >> 17) & 1
  GSYNC;
  phase_ln1_router(p, p.out, 1, smem);
#endif
  GSYNC;
  phase_moe1(p, 1, smem);
#if (DUPMASK >> 18) & 1
  GSYNC;
  phase_moe1(p, 1, smem);
#endif
  GSYNC;
  phase_moe2(p, 1, smem);
#if (DUPMASK >> 19) & 1
  GSYNC;
  phase_moe2(p, 1, smem);
#endif
  GSYNC;
  phase_ln2(p, 1, p.out, (bfu*)nullptr);
#if (DUPMASK >> 20) & 1
  GSYNC;
  phase_ln2(p, 1, p.out, (bfu*)nullptr);
#endif
}

extern "C" void kernel_launch(void* const* d_in, const int* in_sizes, int n_in, void* d_out, int out_size, void* d_ws,
                              size_t ws_size, hipStream_t stream) {
  static int grid_blocks = 0;
  if (!grid_blocks) {
    int dev = 0, cus = 0, per_cu = 0;
    hipGetDevice(&dev);
    hipDeviceGetAttribute(&cus, hipDeviceAttributeMultiprocessorCount, dev);
    hipOccupancyMaxActiveBlocksPerMultiprocessor(&per_cu, mega, 256, 0);
    if (per_cu < 1) per_cu = 1;
    if (per_cu > 2) per_cu = 2;
    grid_blocks = (cus * per_cu) & ~7;
    if (ws_size < WS_NEED) fprintf(stderr, "workspace too small: %zu < %zu\n", ws_size, (size_t)WS_NEED);
  }
  Params p{};
  const float** f = (const float**)&p;
  for (int i = 0; i < 27; ++i) f[i] = (const float*)d_in[i];
  p.out = (float*)d_out;
  p.ws = (unsigned char*)d_ws;
  void* args[] = {&p};
  hipError_t e = hipLaunchCooperativeKernel((void*)mega, dim3(grid_blocks), dim3(256), args, 0, stream);
  if (e != hipSuccess) fprintf(stderr, "cooperative launch failed: %s (grid %d)\n", hipGetErrorString(e), grid_blocks);
}
```

```cpp
#ifndef DUPMASK
#define DUPMASK 0
#endif
#ifndef GX
#define GX 0
#endif
#ifndef XSYNC
#define XSYNC 0
#endif
#define GSYNC xcd_barrier(xb)
#include <hip/hip_runtime.h>
#include <hip/hip_cooperative_groups.h>
#include <cstdio>
namespace cg = cooperative_groups;

typedef unsigned short bfu;
typedef __attribute__((ext_vector_type(8))) short bf16x8;
typedef __attribute__((ext_vector_type(4))) float f32x4;
typedef __attribute__((ext_vector_type(2))) float f32x2;

#define DEV __device__ __forceinline__

constexpr int T = 32768, L = 16384;
constexpr float ALPHA = 1.41421356237309515f;
constexpr float NEGF = -1e30f;

constexpr size_t MiB = 1u << 20;
constexpr size_t OFF_WEVIN = 0;
constexpr size_t OFF_WGLU = OFF_WEVIN + 5 * MiB;
constexpr size_t OFF_WEVOUT = OFF_WGLU + 1 * MiB;
constexpr size_t OFF_WODIN = OFF_WEVOUT + 2 * MiB;
constexpr size_t OFF_WODOUT = OFF_WODIN + 3 * MiB;
constexpr size_t OFF_WGU = OFF_WODOUT + 2 * MiB;
constexpr size_t OFF_WDN = OFF_WGU + 32 * MiB;
constexpr size_t OFF_SMALL = OFF_WDN + 16 * MiB;
constexpr size_t OFF_P = OFF_SMALL + 8 * MiB;
constexpr size_t OFF_A = OFF_P + 160 * MiB;
constexpr size_t OFF_X1 = OFF_A + 128 * MiB;
constexpr size_t WS_NEED = OFF_X1 + 128 * MiB;
constexpr size_t S_CNT = OFF_SMALL;
constexpr size_t S_LB = OFF_SMALL + 4096;
constexpr size_t S_ABAR = OFF_SMALL + 8192;
constexpr size_t S_APOW = OFF_SMALL + 24576;
constexpr size_t S_BBAR = OFF_SMALL + 40960;
constexpr size_t S_KMEAN = OFF_SMALL + 303104;
constexpr size_t S_TOKW = OFF_SMALL + 524288;
constexpr size_t S_LIST = OFF_SMALL + 1 * MiB;
constexpr size_t S_BAR = OFF_SMALL + 4 * MiB;
constexpr size_t OFF_BUCK = OFF_P + 96 * MiB;
constexpr size_t OFF_X1B = OFF_P;
constexpr size_t OFF_H = OFF_P + 64 * MiB;
constexpr size_t OFF_X2B = OFF_P + 96 * MiB;
constexpr size_t OFF_XB = OFF_A;
constexpr size_t OFF_DS = OFF_A;
constexpr size_t OFF_SP = OFF_A + 64 * MiB;
constexpr size_t OFF_MIX = OFF_A;
constexpr size_t OFF_PO = OFF_A;
constexpr size_t OFF_YS5 = OFF_X1;
constexpr size_t OFF_Y = OFF_X1 + 32 * MiB;
constexpr size_t OFF_HEND = OFF_X1 + 96 * MiB;
constexpr size_t OFF_CARRY = OFF_X1 + 104 * MiB;
constexpr size_t OFF_DEC = OFF_X1 + 112 * MiB;
constexpr size_t OFF_VT = OFF_X1;
constexpr size_t OFF_PM = OFF_X1 + 96 * MiB;
constexpr size_t OFF_PL = OFF_X1 + 100 * MiB;

constexpr int SMEM_BYTES = 80 * 1024;
constexpr int SM_AUX = 75 * 1024;
constexpr int BUCK_PER_BH = 2016 * 1024;

struct Params {
  const float *x, *lb_logits, *ev_w_in, *ev_a_norm, *a_re, *a_im, *log_dt, *b_re, *b_im, *c_re, *c_im, *s5_d,
      *w_glu, *ev_w_out, *od_w_in, *od_sinks, *od_w_out, *ln1_g, *ln1_b, *w_group, *b_group, *w_expert, *b_expert,
      *w_gate_up, *w_down, *ln2_g, *ln2_b;
  float* out;
  unsigned char* ws;
};

DEV int my_tid() { int t = threadIdx.x; asm volatile("" : "+v"(t)); return t; }
typedef __attribute__((ext_vector_type(2))) __bf16 bf16x2_t;
typedef __attribute__((ext_vector_type(2))) float f32x2c;
DEV bfu f2bf(float f) { __bf16 h = (__bf16)f; return __builtin_bit_cast(bfu, h); }
DEV float bf2f(bfu h) { return __uint_as_float(((unsigned)h) << 16); }
DEV unsigned pack2(float a, float b) { f32x2c v = {a, b}; bf16x2_t r = __builtin_convertvector(v, bf16x2_t); return __builtin_bit_cast(unsigned, r); }
DEV float frcp(float x) { return __builtin_amdgcn_rcpf(x); }
DEV float sigm(float x) { return frcp(1.f + __expf(-x)); }
DEV float siluf(float x) { return x * frcp(1.f + __expf(-x)); }
DEV float gelu_tanh(float x) {
  float u = 1.5957691216057308f * (x + 0.044715f * x * x * x);
  return x * frcp(1.f + __expf(-u));
}
DEV f32x4 mfma16(uint4 a, uint4 b, f32x4 c) {
  return __builtin_amdgcn_mfma_f32_16x16x32_bf16(__builtin_bit_cast(bf16x8, a), __builtin_bit_cast(bf16x8, b), c, 0, 0, 0);
}
DEV uint4 lds128(const bfu* p) { return *(const uint4*)p; }
template <int CTRL> DEV float dpp_f(float v) {
  return __int_as_float(__builtin_amdgcn_update_dpp(0, __float_as_int(v), CTRL, 0xF, 0xF, false));
}
DEV float sum16(float v) {
  v += dpp_f<0xB1>(v);
  v += dpp_f<0x4E>(v);
  v += dpp_f<0x141>(v);
  v += dpp_f<0x140>(v);
  return v;
}
DEV float wave_sum(float v) {
  v = sum16(v);
  const int iv = __float_as_int(v);
  const float s0 = __int_as_float(__builtin_amdgcn_readlane(iv, 0)), s1 = __int_as_float(__builtin_amdgcn_readlane(iv, 16));
  const float s2 = __int_as_float(__builtin_amdgcn_readlane(iv, 32)), s3 = __int_as_float(__builtin_amdgcn_readlane(iv, 48));
  return (s0 + s1) + (s2 + s3);
}
DEV float max16(float v) {
  v = fmaxf(v, __shfl_xor(v, 8)); v = fmaxf(v, __shfl_xor(v, 4));
  v = fmaxf(v, __shfl_xor(v, 2)); v = fmaxf(v, __shfl_xor(v, 1));
  return v;
}
DEV uint4 ld8_f32(const float* p) {
  float4 u = ((const float4*)p)[0], v = ((const float4*)p)[1];
  return make_uint4(pack2(u.x, u.y), pack2(u.z, u.w), pack2(v.x, v.y), pack2(v.z, v.w));
}
DEV uint4 ld8_bf(const bfu* p) { return *(const uint4*)p; }
DEV int perm_half(int c, int half) {
  if (half == 0) return c;
  int hi = c >= half ? 1 : 0;
  int cc = hi ? c - half : c;
  return (cc >> 5) * 64 + hi * 32 + (cc & 31);
}

template <bool SWAP>
DEV void mma_tile(const bfu* As, const bfu* Bs, int wm, int wn, int l15, int lq, f32x4 (&acc)[4][4]) {
#pragma unroll
  for (int ks = 0; ks < 2; ++ks) {
    uint4 af[4], bfr[4];
#pragma unroll
    for (int i = 0; i < 4; ++i) {
      af[i] = lds128(As + (wm * 64 + i * 16 + l15) * 80 + ks * 32 + lq * 8);
      bfr[i] = lds128(Bs + (wn * 64 + i * 16 + l15) * 80 + ks * 32 + lq * 8);
    }
    __builtin_amdgcn_s_setprio(1);
#pragma unroll
    for (int i1 = 0; i1 < 4; ++i1)
#pragma unroll
      for (int i2 = 0; i2 < 4; ++i2)
        acc[i1][i2] = SWAP ? mfma16(bfr[i1], af[i2], acc[i1][i2]) : mfma16(af[i1], bfr[i2], acc[i1][i2]);
    __builtin_amdgcn_s_setprio(0);
    if (ks == 0) __builtin_amdgcn_sched_barrier(0);
  }
}

template <int N> struct IC { static constexpr int v = N; };
template <int I, int N, typename F> DEV void static_for(F&& f) { if constexpr (I < N) { f(IC<I>{}); static_for<I + 1, N>(f); } }

DEV uint4 ld8_at(const bfu* base, unsigned o) { asm volatile("" : "+v"(o)); return ld8_bf(base + o); }
struct RowLoader {
  const bfu* base; unsigned off; unsigned stride32;
  DEV uint4 operator()(int i, int kb, int so) const { return ld8_at(base, off + (unsigned)i * stride32 + (unsigned)kb + (unsigned)so); }
};
struct GatherLoader {
  const bfu* base; unsigned off[4];
  DEV uint4 operator()(int i, int kb, int so) const { return ld8_at(base, off[i] + (unsigned)kb + (unsigned)so); }
};
struct SplitKLoader {
  const bfu* base; unsigned lo; unsigned dhi;
  DEV uint4 operator()(int i, int kb, int so) const {
    const unsigned u = (kb < 256) ? 0u : dhi;
    return ld8_at(base, lo + u + (unsigned)i * 8192u + (unsigned)(kb & 255) + (unsigned)so);
  }
};
struct GemmPipe { uint4 ra[2][4], rb[2][4]; };

template <typename AL, typename BL, typename EP>
DEV void gemm128(bool SWAP, int K, bool first, bool hasNext, const AL& aload, const BL& bload, const AL& aloadN, const BL& bloadN,
                 EP epi, GemmPipe& gp, unsigned char* smem) {
  const int tid = my_tid(), lane = tid & 63, w = tid >> 6, wm = w >> 1, wn = w & 1, l15 = lane & 15, lq = lane >> 4;
  const int seg = tid & 7, r0 = tid >> 3;
  const int nk = K >> 6;
  f32x4 acc[4][4];
#pragma unroll
  for (int mi = 0; mi < 4; ++mi)
#pragma unroll
    for (int ni = 0; ni < 4; ++ni) acc[mi][ni] = f32x4{0.f, 0.f, 0.f, 0.f};
  if (first) {
#pragma unroll
    for (int i = 0; i < 4; ++i) { gp.ra[0][i] = aload(i, 0, seg * 8); gp.rb[0][i] = bload(i, 0, seg * 8); }
#pragma unroll
    for (int i = 0; i < 4; ++i) { gp.ra[1][i] = aload(i, 64, seg * 8); gp.rb[1][i] = bload(i, 64, seg * 8); }
    __syncthreads();
    bfu* As = (bfu*)smem; bfu* Bs = As + 128 * 80;
#pragma unroll
    for (int i = 0; i < 4; ++i) {
      *(uint4*)(As + (r0 + 32 * i) * 80 + seg * 8) = gp.ra[0][i];
      *(uint4*)(Bs + (r0 + 32 * i) * 80 + seg * 8) = gp.rb[0][i];
    }
#pragma unroll
    for (int i = 0; i < 4; ++i) { gp.ra[0][i] = aload(i, 128, seg * 8); gp.rb[0][i] = bload(i, 128, seg * 8); }
  }
  auto body = [&](auto pc, int kt) {
    constexpr int PAR = decltype(pc)::v;
    constexpr int NXT = PAR ^ 1;
    __syncthreads();
    if (kt + 1 < nk || hasNext) {
      bfu* As = (bfu*)(smem + NXT * 40960); bfu* Bs = As + 128 * 80;
#pragma unroll
      for (int i = 0; i < 4; ++i) {
        *(uint4*)(As + (r0 + 32 * i) * 80 + seg * 8) = gp.ra[NXT][i];
        *(uint4*)(Bs + (r0 + 32 * i) * 80 + seg * 8) = gp.rb[NXT][i];
      }
    }
    if (kt + 3 < nk) {
      const int k = (kt + 3) * 64;
#pragma unroll
      for (int i = 0; i < 4; ++i) { gp.ra[NXT][i] = aload(i, k, seg * 8); gp.rb[NXT][i] = bload(i, k, seg * 8); }
    } else if (hasNext) {
      const int k = (kt + 3 - nk) * 64;
#pragma unroll
      for (int i = 0; i < 4; ++i) { gp.ra[NXT][i] = aloadN(i, k, seg * 8); gp.rb[NXT][i] = bloadN(i, k, seg * 8); }
    } else {
      const int k = (nk - 1) * 64;
#pragma unroll
      for (int i = 0; i < 4; ++i) { gp.ra[NXT][i] = aload(i, k, seg * 8); gp.rb[NXT][i] = bload(i, k, seg * 8); }
    }
    const bfu* Ac = (const bfu*)(smem + PAR * 40960);
    mma_tile<true>(Ac, Ac + 128 * 80, wm, wn, l15, lq, acc);
  };
  for (int kt = 0; kt < nk; kt += 2) {
    body(IC<0>{}, kt);
    body(IC<1>{}, kt + 1);
  }
  epi(acc, wm, wn, l15, lq);
}

DEV bool gemm_item(int iter, int MT, int NT, int& mt, int& nt) {
  const int nl = gridDim.x >> 3;
  const int x = blockIdx.x & 7, lw = blockIdx.x >> 3;
  const int mper = MT >> 3;
  const int li = lw + iter * nl;
  if (li >= mper * NT) return false;
  const int per_group = mper * 4;
  const int g = li / per_group, r = li - g * per_group;
  mt = x * mper + (r >> 2);
  nt = g * 4 + (r & 3);
  return true;
}
DEV int xcd_item(int iter, int total, int inner) {
  const int nl = gridDim.x >> 3;
  const int x = blockIdx.x & 7, lw = blockIdx.x >> 3;
  const int outer = total / inner;
  const int chunk = (outer + 7) >> 3;
  const int o0 = x * chunk;
  int o1 = o0 + chunk; if (o1 > outer) o1 = outer;
  const int li = lw + iter * nl;
  if (o0 >= o1 || li >= (o1 - o0) * inner) return -1;
  return o0 * inner + li;
}

DEV void transpose_job(const float* __restrict__ src, bfu* __restrict__ dst, int nmat, int K, int N, int half, bfu* tl) {
  const int tk = K >> 6, tn = N >> 6;
  const int per = tk * tn, total = nmat * per;
  const int tid = my_tid();
  const int c4 = tid & 15, r = tid >> 4;
  int it = blockIdx.x;
  if (it >= total) return;
  auto tile_src = [&](int itx) -> const float* {
    const int m = itx / per, rem = itx - m * per;
    const int kt = rem / tn, nt = rem - kt * tn;
    return src + (size_t)m * K * N + (size_t)(kt * 64) * N + nt * 64;
  };
  float4 nv[4];
  {
    const float* s = tile_src(it);
#pragma unroll
    for (int i = 0; i < 4; ++i) nv[i] = *(const float4*)(s + (size_t)(r + 16 * i) * N + c4 * 4);
  }
  for (; it < total; it += gridDim.x) {
    const int m = it / per, rem = it - m * per;
    const int kt = rem / tn, nt = rem - kt * tn;
    float4 v[4];
#pragma unroll
    for (int i = 0; i < 4; ++i) v[i] = nv[i];
    {
      const float* s = tile_src(it + gridDim.x < total ? it + gridDim.x : it);
#pragma unroll
      for (int i = 0; i < 4; ++i) nv[i] = *(const float4*)(s + (size_t)(r + 16 * i) * N + c4 * 4);
    }
    __syncthreads();
#pragma unroll
    for (int i = 0; i < 4; ++i) {
      tl[(c4 * 4 + 0) * 72 + r + 16 * i] = f2bf(v[i].x);
      tl[(c4 * 4 + 1) * 72 + r + 16 * i] = f2bf(v[i].y);
      tl[(c4 * 4 + 2) * 72 + r + 16 * i] = f2bf(v[i].z);
      tl[(c4 * 4 + 3) * 72 + r + 16 * i] = f2bf(v[i].w);
    }
    __syncthreads();
    bfu* d = dst + (size_t)m * K * N;
#pragma unroll
    for (int i = 0; i < 2; ++i) {
      const int idx = tid + 256 * i, n = idx >> 3, sg = idx & 7;
      const int pn = perm_half(nt * 64 + n, half);
      *(uint4*)(d + (size_t)pn * K + kt * 64 + sg * 8) = *(const uint4*)(tl + n * 72 + sg * 8);
    }
  }
}

DEV void phase_prep(const Params& p, unsigned char* smem) {
  bfu* tl = (bfu*)smem;
  unsigned char* ws = p.ws;
  const int gtid = blockIdx.x * 256 + my_tid();
  if (gtid < 512) ((int*)(ws + S_CNT))[gtid] = 0;
  if (gtid < 512) {
    float l0 = p.lb_logits[gtid], l1 = p.lb_logits[512 + gtid], l2 = p.lb_logits[1024 + gtid];
    float m = fmaxf(l0, fmaxf(l1, l2));
    float e0 = expf(l0 - m), e1 = expf(l1 - m), e2 = expf(l2 - m);
    ((float*)(ws + S_LB))[gtid] = e0 / (e0 + e1 + e2);
  }
  if (gtid < 2048) {
    int g = gtid >> 6;
    float dt = expf(p.log_dt[g]);
    float ar = p.a_re[gtid], ai = p.a_im[gtid];
    float mag = expf(dt * ar);
    float abr = mag * cosf(dt * ai), abi = mag * sinf(dt * ai);
    float den = ar * ar + ai * ai;
    float xr = abr - 1.f, xi = abi;
    float fr = (xr * ar + xi * ai) / den, fi = (xi * ar - xr * ai) / den;
    float* ab = (float*)(ws + S_ABAR);
    ab[gtid * 2] = abr; ab[gtid * 2 + 1] = abi;
    float pr = abr, pi = abi;
#pragma unroll
    for (int i = 0; i < 6; ++i) { float nr = pr * pr - pi * pi, ni = 2.f * pr * pi; pr = nr; pi = ni; }
    float* ap = (float*)(ws + S_APOW);
    ap[gtid * 2] = pr; ap[gtid * 2 + 1] = pi;
    float* bb = (float*)(ws + S_BBAR) + (size_t)gtid * 32;
    for (int m = 0; m < 16; ++m) {
      float br = p.b_re[gtid * 16 + m], bi = p.b_im[gtid * 16 + m];
      bb[m] = fr * br - fi * bi;
      bb[16 + m] = fr * bi + fi * br;
    }
  }
  transpose_job(p.ev_w_in, (bfu*)(ws + OFF_WEVIN), 1, 1024, 2560, 0, tl);
  transpose_job(p.w_glu, (bfu*)(ws + OFF_WGLU), 1, 512, 1024, 512, tl);
  transpose_job(p.ev_w_out, (bfu*)(ws + OFF_WEVOUT), 1, 1024, 1024, 0, tl);
  transpose_job(p.od_w_in, (bfu*)(ws + OFF_WODIN), 1, 1024, 1536, 0, tl);
  transpose_job(p.od_w_out, (bfu*)(ws + OFF_WODOUT), 1, 1024, 1024, 0, tl);
  transpose_job(p.w_gate_up, (bfu*)(ws + OFF_WGU), 32, 1024, 512, 256, tl);
  transpose_job(p.w_down, (bfu*)(ws + OFF_WDN), 32, 256, 1024, 0, tl);
  {
    uint4* xb = (uint4*)(ws + OFF_XB);
    const size_t n8 = (size_t)T * 1024 / 8;
    for (size_t i = (size_t)blockIdx.x * 256 + my_tid(); i < n8; i += (size_t)gridDim.x * 256) xb[i] = ld8_f32(p.x + i * 8);
  }
}

DEV void phase_proj(const bfu* __restrict__ X, const bfu* __restrict__ Wt, bfu* __restrict__ P, int N, bfu* __restrict__ VT, int layer, unsigned char* smem) {
  const int ntn = N >> 7;
  const int total = (T >> 7) * ntn;
  const int r0 = my_tid() >> 3;
  GemmPipe gp;
  bool first = true;
  for (int it = blockIdx.x; it < total; it += gridDim.x) {
    const int mt = it / ntn, nt = it - mt * ntn;
    const int itn = it + gridDim.x;
    const bool hasNext = itn < total;
    const int itq = hasNext ? itn : it;
    const int mtn = itq / ntn, ntq = itq - mtn * ntn;
    const RowLoader al{X, (unsigned)(mt * 128 + r0) * 1024u, 32768u}, bl{Wt, (unsigned)(nt * 128 + r0) * 1024u, 32768u};
    const RowLoader aln{X, (unsigned)(mtn * 128 + r0) * 1024u, 32768u}, bln{Wt, (unsigned)(ntq * 128 + r0) * 1024u, 32768u};
    auto epi = [&](f32x4(&acc)[4][4], int wm, int wn, int l15, int lq) {
#pragma unroll
      for (int ai = 0; ai < 4; ++ai)
#pragma unroll
        for (int bi = 0; bi < 4; ++bi) {
          const int row = mt * 128 + wm * 64 + bi * 16 + l15, col = nt * 128 + wn * 64 + ai * 16 + lq * 4;
          *(uint2*)(P + (size_t)row * N + col) = make_uint2(pack2(acc[ai][bi][0], acc[ai][bi][1]), pack2(acc[ai][bi][2], acc[ai][bi][3]));
        }
    };
    const bool vt_tile = layer == 0 ? (nt >= 8 && nt <= 11) : (nt == 5 || nt == 11);
    auto epi2 = [&](f32x4(&acc)[4][4], int wm, int wn, int l15, int lq) {
      if (vt_tile) {
        bfu* Ct = (bfu*)(smem + 40960);
        __syncthreads();
#pragma unroll
        for (int ai = 0; ai < 4; ++ai)
#pragma unroll
          for (int bi = 0; bi < 4; ++bi)
#pragma unroll
            for (int j = 0; j < 4; ++j)
              Ct[(wn * 64 + ai * 16 + lq * 4 + j) * 136 + wm * 64 + bi * 16 + l15] = f2bf(acc[ai][bi][j]);
        __syncthreads();
        const int which = nt == 11 ? 1 : 0;
        const int m0 = mt * 128;
        const int b = m0 >> 14, t0 = m0 & (L - 1);
        const int tid = my_tid();
#pragma unroll
        for (int i = 0; i < 8; ++i) {
          const int idx = tid + 256 * i, n = idx >> 4, c = idx & 15;
          const size_t vrow = layer == 0 ? (size_t)((b * 4 + (nt - 8)) * 128 + n) : (size_t)(((which * 2 + b) * 2 + (n >> 6)) * 64 + (n & 63));
          *(uint4*)(VT + vrow * L + t0 + c * 8) = *(const uint4*)(Ct + n * 136 + c * 8);
        }
      } else {
        epi(acc, wm, wn, l15, lq);
      }
    };
    gemm128(true, 1024, first, hasNext, al, bl, aln, bln, epi2, gp, smem);
    first = false;
  }
}

DEV void phase_glu(const Params& p, unsigned char* smem) {
  const bfu* A = (const bfu*)(p.ws + OFF_YS5);
  const bfu* Wt = (const bfu*)(p.ws + OFF_WGLU);
  bfu* Y = (bfu*)(p.ws + OFF_Y);
  const int r0 = my_tid() >> 3;
  const int total = (T >> 7) * 8;
  GemmPipe gp;
  bool first = true;
  for (int it = blockIdx.x; it < total; it += gridDim.x) {
    const int mt = it >> 3, nt = it & 7;
    const int itn = it + gridDim.x;
    const bool hasNext = itn < total;
    const int itq = hasNext ? itn : it;
    const RowLoader al{A, (unsigned)(mt * 128 + r0) * 512u, 16384u}, bl{Wt, (unsigned)(nt * 128 + r0) * 512u, 16384u};
    const RowLoader aln{A, (unsigned)((itq >> 3) * 128 + r0) * 512u, 16384u}, bln{Wt, (unsigned)((itq & 7) * 128 + r0) * 512u, 16384u};
    auto epi = [&](f32x4(&acc)[4][4], int wm, int wn, int l15, int lq) {
      const int q = nt * 2 + wn;
#pragma unroll
      for (int ai = 0; ai < 2; ++ai)
#pragma unroll
        for (int bi = 0; bi < 4; ++bi) {
          const int row = mt * 128 + wm * 64 + bi * 16 + l15, col = q * 32 + ai * 16 + lq * 4;
          float o[4];
#pragma unroll
          for (int j = 0; j < 4; ++j) o[j] = acc[ai][bi][j] * sigm(acc[ai + 2][bi][j]);
          *(uint2*)(Y + (size_t)row * 1024 + 512 + col) = make_uint2(pack2(o[0], o[1]), pack2(o[2], o[3]));
        }
    };
    gemm128(true, 512, first, hasNext, al, bl, aln, bln, epi, gp, smem);
    first = false;
  }
}

DEV void phase_outproj(const Params& p, const bfu* __restrict__ Wt, unsigned char* smem) {
  const bfu* A = (const bfu*)(p.ws + OFF_Y);
  bfu* MIX = (bfu*)(p.ws + OFF_MIX);
  const int r0 = my_tid() >> 3;
  const int total = (T >> 7) * 8;
  GemmPipe gp;
  bool first = true;
  for (int it = blockIdx.x; it < total; it += gridDim.x) {
    const int mt = it >> 3, nt = it & 7;
    const int itn = it + gridDim.x;
    const bool hasNext = itn < total;
    const int itq = hasNext ? itn : it;
    const RowLoader al{A, (unsigned)(mt * 128 + r0) * 1024u, 32768u}, bl{Wt, (unsigned)(nt * 128 + r0) * 1024u, 32768u};
    const RowLoader aln{A, (unsigned)((itq >> 3) * 128 + r0) * 1024u, 32768u}, bln{Wt, (unsigned)((itq & 7) * 128 + r0) * 1024u, 32768u};
    auto epi = [&](f32x4(&acc)[4][4], int wm, int wn, int l15, int lq) {
#pragma unroll
      for (int ai = 0; ai < 4; ++ai)
#pragma unroll
        for (int bi = 0; bi < 4; ++bi) {
          const int row = mt * 128 + wm * 64 + bi * 16 + l15, col = nt * 128 + wn * 64 + ai * 16 + lq * 4;
          *(uint2*)(MIX + (size_t)row * 1024 + col) = make_uint2(pack2(acc[ai][bi][0], acc[ai][bi][1]), pack2(acc[ai][bi][2], acc[ai][bi][3]));
        }
    };
    gemm128(true, 1024, first, hasNext, al, bl, aln, bln, epi, gp, smem);
    first = false;
  }
}


DEV void stage_tile64x128(const bfu* __restrict__ src, int ld, bfu* dst, int ls) {
#pragma unroll
  for (int i = 0; i < 4; ++i) {
    const int idx = my_tid() + 256 * i, row = idx >> 4, sg = idx & 15;
    *(uint4*)(dst + row * ls + sg * 8) = *(const uint4*)(src + (size_t)row * ld + sg * 8);
  }
}
DEV void stage_tile64x128_T(const bfu* __restrict__ src, int ld, bfu* dst, int ls) {
#pragma unroll
  for (int i = 0; i < 4; ++i) {
    const int idx = my_tid() + 256 * i, row = idx >> 4, sg = idx & 15;
    uint4 v = *(const uint4*)(src + (size_t)row * ld + sg * 8);
    unsigned uu[4] = {v.x, v.y, v.z, v.w};
#pragma unroll
    for (int e = 0; e < 4; ++e) {
      dst[(sg * 8 + 2 * e) * ls + row] = (bfu)(uu[e] & 0xffffu);
      dst[(sg * 8 + 2 * e + 1) * ls + row] = (bfu)(uu[e] >> 16);
    }
  }
}


DEV void stage_vt(const bfu* __restrict__ vt0, int bh, int tl0, bfu* dst, int ls) {
#pragma unroll
  for (int i = 0; i < 4; ++i) {
    const int idx = my_tid() + 256 * i, v = idx >> 3, c = idx & 7;
    *(uint4*)(dst + v * ls + c * 8) = *(const uint4*)(vt0 + ((size_t)(bh * 128 + v)) * L + tl0 + c * 8);
  }
}

DEV void hgrn_dstate_item(const Params& p, int ch, unsigned char* smem) {
  const int bh = ch >> 8, n = ch & 255, b = bh >> 2, h = bh & 3;
  const size_t t0 = (size_t)b * L + (size_t)n * 64;
  const bfu* P = (const bfu*)(p.ws + OFF_P);
  bfu* As = (bfu*)smem;
  bfu* Bs = As + 128 * 80;
  bfu* Fr = Bs + 128 * 80;
  const int tid = my_tid(), k = tid & 127, half = tid >> 7;
  const float lb = ((const float*)(p.ws + S_LB))[h * 128 + k];
  __syncthreads();
  stage_tile64x128(P + t0 * 2560 + 512 + h * 128, 2560, Fr, 128);
  stage_vt((const bfu*)p.out, bh, n * 64, As, 80);
  __syncthreads();
  float* tot = (float*)(Fr + 64 * 128);
  float fv[32], cum[32];
  float run = 0.f;
#pragma unroll
  for (int i = 0; i < 32; ++i) {
    const float f = lb + (1.f - lb) * sigm(bf2f(Fr[(half * 32 + i) * 128 + k]));
    run += __logf(f);
    fv[i] = f; cum[i] = run;
  }
  tot[half * 128 + k] = run;
  __syncthreads();
  const float t0s = tot[k], t1s = tot[128 + k];
  const float btot = t0s + t1s;
  const float boff = half ? t0s : 0.f;
#pragma unroll
  for (int i = 0; i < 32; ++i) Bs[k * 80 + half * 32 + i] = f2bf((1.f - fv[i]) * __expf(btot - (boff + cum[i])));
  if (half == 0) ((float*)(p.ws + OFF_DEC))[(size_t)ch * 128 + k] = __expf(btot);
  __syncthreads();
  const int lane = tid & 63, w = tid >> 6, wm = w >> 1, wn = w & 1, l15 = lane & 15, lq = lane >> 4;
  f32x4 acc[4][4];
#pragma unroll
  for (int mi = 0; mi < 4; ++mi)
#pragma unroll
    for (int ni = 0; ni < 4; ++ni) acc[mi][ni] = f32x4{0.f, 0.f, 0.f, 0.f};
  mma_tile<true>(As, Bs, wm, wn, l15, lq, acc);
  bfu* DS = (bfu*)(p.ws + OFF_DS) + (size_t)ch * 16384;
#pragma unroll
  for (int ai = 0; ai < 4; ++ai)
#pragma unroll
    for (int bi = 0; bi < 4; ++bi) {
      const int v = wm * 64 + bi * 16 + l15, kk = wn * 64 + ai * 16 + lq * 4;
      *(uint2*)(DS + v * 128 + kk) = make_uint2(pack2(acc[ai][bi][0], acc[ai][bi][1]), pack2(acc[ai][bi][2], acc[ai][bi][3]));
    }
}

DEV void s5_load_bfrag(const Params& p, int g, int l15, int lq, uint4 (&bf)[8]) {
#pragma unroll
  for (int ni = 0; ni < 8; ++ni) {
    bf[ni] = make_uint4(0u, 0u, 0u, 0u);
    if (lq < 2) {
      const int col = ni * 16 + l15, pp = col & 63, part = col >> 6;
      const float* s = (const float*)(p.ws + S_BBAR) + (size_t)(g * 64 + pp) * 32 + part * 16 + lq * 8;
      const float4 u = ((const float4*)s)[0], v = ((const float4*)s)[1];
      bf[ni] = make_uint4(pack2(u.x, u.y), pack2(u.z, u.w), pack2(v.x, v.y), pack2(v.z, v.w));
    }
  }
}
DEV void s5_drive16(const uint4 a, const uint4 (&bf)[8], float* Dr, int l15, int lq) {
#pragma unroll
  for (int ni = 0; ni < 8; ++ni) {
    f32x4 acc = mfma16(a, bf[ni], f32x4{0.f, 0.f, 0.f, 0.f});
#pragma unroll
    for (int j = 0; j < 4; ++j) Dr[(lq * 4 + j) * 132 + ni * 16 + l15] = acc[j];
  }
}

struct S5Const { uint4 bf[8]; uint4 cf[4]; float2 ab; float dsk; };

DEV void s5_pass1_item(const Params& p, int it, const uint4 (&bf)[8], const float2 ab, unsigned char* smem) {
  const int gq = it & 7, bc = it >> 3;
  const size_t t0 = (size_t)(bc >> 8) * L + (size_t)(bc & 255) * 64;
  const int tid = my_tid(), lane = tid & 63, w = tid >> 6, l15 = lane & 15, lq = lane >> 4;
  float* Dr = (float*)smem + w * (16 * 132);
  const int g = gq * 4 + w;
  const int gp = g * 64 + lane;
  const bfu* P = (const bfu*)(p.ws + OFF_P);
  uint4 af[4];
#pragma unroll
  for (int sub = 0; sub < 4; ++sub) {
    af[sub] = make_uint4(0u, 0u, 0u, 0u);
    if (lq < 2) af[sub] = *(const uint4*)(P + (t0 + sub * 16 + l15) * 2560 + 2048 + g * 16 + lq * 8);
  }
  float hr = 0.f, hi = 0.f;
#pragma unroll
  for (int sub = 0; sub < 4; ++sub) {
    __syncthreads();
    s5_drive16(af[sub], bf, Dr, l15, lq);
    __syncthreads();
#pragma unroll 4
    for (int tt = 0; tt < 16; ++tt) {
      const float dr = Dr[tt * 132 + lane], di = Dr[tt * 132 + 64 + lane];
      const float nr = ab.x * hr - ab.y * hi + dr;
      const float ni = ab.x * hi + ab.y * hr + di;
      hr = nr; hi = ni;
    }
  }
  ((float2*)(p.ws + OFF_HEND))[(size_t)bc * 2048 + gp] = make_float2(hr, hi);
}

DEV void s5_pass2_item(const Params& p, int it, const uint4 (&bf)[8], const uint4 (&cf)[4], const float2 ab, const float dsk, unsigned char* smem) {
  const int gq = it & 7, bc = it >> 3;
  const size_t t0 = (size_t)(bc >> 8) * L + (size_t)(bc & 255) * 64;
  const int tid = my_tid(), lane = tid & 63, w = tid >> 6, l15 = lane & 15, lq = lane >> 4;
  float* Dr = (float*)smem + w * (16 * 132);
  bfu* Hs = (bfu*)(smem + 4 * 16 * 132 * 4) + w * (16 * 144);
  const int g = gq * 4 + w;
  const int gp = g * 64 + lane;
  const bfu* P = (const bfu*)(p.ws + OFF_P);
  uint4 af[4];
#pragma unroll
  for (int sub = 0; sub < 4; ++sub) {
    af[sub] = make_uint4(0u, 0u, 0u, 0u);
    if (lq < 2) af[sub] = *(const uint4*)(P + (t0 + sub * 16 + l15) * 2560 + 2048 + g * 16 + lq * 8);
  }
  float2 hc = ((const float2*)(p.ws + OFF_CARRY))[(size_t)bc * 2048 + gp];
  float hr = hc.x, hi = hc.y;
  bfu* YS = (bfu*)(p.ws + OFF_YS5);
#pragma unroll
  for (int sub = 0; sub < 4; ++sub) {
    float us[4];
#pragma unroll
    for (int j = 0; j < 4; ++j) us[j] = bf2f(P[(t0 + sub * 16 + lq * 4 + j) * 2560 + 2048 + g * 16 + l15]);
    __syncthreads();
    s5_drive16(af[sub], bf, Dr, l15, lq);
    __syncthreads();
#pragma unroll 4
    for (int tt = 0; tt < 16; ++tt) {
      const float dr = Dr[tt * 132 + lane], di = Dr[tt * 132 + 64 + lane];
      const float nr = ab.x * hr - ab.y * hi + dr;
      const float ni = ab.x * hi + ab.y * hr + di;
      hr = nr; hi = ni;
      Hs[tt * 144 + lane] = f2bf(hr);
      Hs[tt * 144 + 64 + lane] = f2bf(hi);
    }
    __syncthreads();
    f32x4 acc = f32x4{0.f, 0.f, 0.f, 0.f};
#pragma unroll
    for (int ks = 0; ks < 4; ++ks) acc = mfma16(lds128(Hs + l15 * 144 + ks * 32 + lq * 8), cf[ks], acc);
#pragma unroll
    for (int j = 0; j < 4; ++j) {
      const int t = sub * 16 + lq * 4 + j;
      const float y = acc[j] + dsk * us[j];
      YS[(t0 + t) * 512 + g * 16 + l15] = f2bf(gelu_tanh(y));
    }
  }
}


DEV void s5_load_consts(const Params& p, int g, int lane, uint4 (&bf)[8], uint4 (&cf)[4], float2& ab, float& dsk) {
  const int l15 = lane & 15, lq = lane >> 4;
  s5_load_bfrag(p, g, l15, lq, bf);
  ab = ((const float2*)(p.ws + S_ABAR))[g * 64 + lane];
#pragma unroll
  for (int ks = 0; ks < 4; ++ks) {
    const float* src = (ks < 2 ? p.c_re : p.c_im) + ((size_t)g * 16 + l15) * 64 + (ks & 1) * 32 + lq * 8;
    float4 u = ((const float4*)src)[0], v = ((const float4*)src)[1];
    float sgn = ks < 2 ? 1.f : -1.f;
    cf[ks] = make_uint4(pack2(sgn * u.x, sgn * u.y), pack2(sgn * u.z, sgn * u.w), pack2(sgn * v.x, sgn * v.y), pack2(sgn * v.z, sgn * v.w));
  }
  dsk = p.s5_d[g * 16 + l15];
}

DEV void hgrn_scan_item(const Params& p, int it) {
  const int bh = it >> 3, vs = it & 7;
  const int tid = my_tid(), v = vs * 16 + (tid >> 4), k8 = tid & 15;
  const bfu* DS = (const bfu*)(p.ws + OFF_DS);
  bfu* SP = (bfu*)(p.ws + OFF_SP);
  const float* DEC = (const float*)(p.ws + OFF_DEC);
  float S[8];
#pragma unroll
  for (int i = 0; i < 8; ++i) S[i] = 0.f;
  uint4 dsr[8];
  float4 dca[8], dcb[8];
  const size_t base0 = ((size_t)(bh * 256) * 128 + v) * 128 + k8 * 8;
  const size_t dbase0 = (size_t)(bh * 256) * 128 + k8 * 8;
#pragma unroll
  for (int s = 0; s < 8; ++s) {
    dsr[s] = *(const uint4*)(DS + base0 + (size_t)s * 16384);
    dca[s] = *(const float4*)(DEC + dbase0 + (size_t)s * 128);
    dcb[s] = *(const float4*)(DEC + dbase0 + (size_t)s * 128 + 4);
  }
  for (int n0 = 0; n0 < 256; n0 += 8) {
#pragma unroll
    for (int s = 0; s < 8; ++s) {
      const int n = n0 + s;
      *(uint4*)(SP + base0 + (size_t)n * 16384) = make_uint4(pack2(S[0], S[1]), pack2(S[2], S[3]), pack2(S[4], S[5]), pack2(S[6], S[7]));
      const uint4 d = dsr[s];
      const float4 a = dca[s], c = dcb[s];
      S[0] = a.x * S[0] + __uint_as_float(d.x << 16); S[1] = a.y * S[1] + __uint_as_float(d.x & 0xffff0000u);
      S[2] = a.z * S[2] + __uint_as_float(d.y << 16); S[3] = a.w * S[3] + __uint_as_float(d.y & 0xffff0000u);
      S[4] = c.x * S[4] + __uint_as_float(d.z << 16); S[5] = c.y * S[5] + __uint_as_float(d.z & 0xffff0000u);
      S[6] = c.z * S[6] + __uint_as_float(d.w << 16); S[7] = c.w * S[7] + __uint_as_float(d.w & 0xffff0000u);
      if (n + 8 < 256) {
        dsr[s] = *(const uint4*)(DS + base0 + (size_t)(n + 8) * 16384);
        dca[s] = *(const float4*)(DEC + dbase0 + (size_t)(n + 8) * 128);
        dcb[s] = *(const float4*)(DEC + dbase0 + (size_t)(n + 8) * 128 + 4);
      }
    }
  }
}

DEV void s5_carry_item(const Params& p, int it) {
  const int id = it * 256 + my_tid();
  const int b = id >> 11, gp = id & 2047;
  const float2 ap = ((const float2*)(p.ws + S_APOW))[gp];
  const float2* HE = (const float2*)(p.ws + OFF_HEND) + (size_t)b * 256 * 2048 + gp;
  float2* CA = (float2*)(p.ws + OFF_CARRY) + (size_t)b * 256 * 2048 + gp;
  float cr = 0.f, ci = 0.f;
  float2 ring[8];
#pragma unroll
  for (int s = 0; s < 8; ++s) ring[s] = HE[(size_t)s * 2048];
  for (int c0 = 0; c0 < 256; c0 += 8) {
#pragma unroll
    for (int s = 0; s < 8; ++s) {
      const int c = c0 + s;
      CA[(size_t)c * 2048] = make_float2(cr, ci);
      float nr = ap.x * cr - ap.y * ci + ring[s].x;
      float ni = ap.x * ci + ap.y * cr + ring[s].y;
      cr = nr; ci = ni;
      if (c + 8 < 256) ring[s] = HE[(size_t)(c + 8) * 2048];
    }
  }
}

DEV void hgrn_out_item(const Params& p, int ch, unsigned char* smem) {
  const int bh = ch >> 8, n = ch & 255, b = bh >> 2, h = bh & 3;
  const size_t t0 = (size_t)b * L + (size_t)n * 64;
  const bfu* P = (const bfu*)(p.ws + OFF_P);
  bfu* Qs = (bfu*)smem;
  bfu* RB = Qs + 64 * 144;
  bfu* Ks = RB;
  bfu* ATT = RB;
  bfu* Vt = RB + 64 * 80;
  bfu* St = RB;
  bfu* Fr = RB + 64 * 144;
  float* tot = (float*)(Fr + 64 * 128);
  bfu* Gs = (bfu*)(smem + 55296);
  const int tid = my_tid(), lane = tid & 63, w = tid >> 6, l15 = lane & 15, lq = lane >> 4;
  uint4 rq0, rq1, rq2, rq3, rf0, rf1, rf2, rf3, rv0, rv1, rv2, rv3, rg0, rg1, rg2, rg3, rs0, rs1, rs2, rs3, rs4, rs5, rs6, rs7;
  {
    const bfu* qsrc = P + t0 * 2560 + h * 128;
    const bfu* vt0 = (const bfu*)p.out;
    const bfu* SPc = (const bfu*)(p.ws + OFF_SP) + (size_t)ch * 16384;
#define HG_LD(i) { const int idx = tid + 256 * i, row = idx >> 4, sg = idx & 15; \
      rq##i = *(const uint4*)(qsrc + (size_t)row * 2560 + sg * 8); \
      rf##i = *(const uint4*)(qsrc + 512 + (size_t)row * 2560 + sg * 8); \
      rg##i = *(const uint4*)(qsrc + 1536 + (size_t)row * 2560 + sg * 8); \
      const int v = idx >> 3, c = idx & 7; \
      rv##i = *(const uint4*)(vt0 + ((size_t)(bh * 128 + v)) * L + n * 64 + c * 8); }
    HG_LD(0) HG_LD(1) HG_LD(2) HG_LD(3)
#undef HG_LD
#define HG_LS(i) { const int idx = tid + 256 * i, v = idx >> 4, sg = idx & 15; rs##i = *(const uint4*)(SPc + v * 128 + sg * 8); }
    HG_LS(0) HG_LS(1) HG_LS(2) HG_LS(3) HG_LS(4) HG_LS(5) HG_LS(6) HG_LS(7)
#undef HG_LS
  }
  float ng[8];
#pragma unroll
  for (int ni = 0; ni < 8; ++ni) ng[ni] = p.ev_a_norm[h * 128 + ni * 16 + l15];
  __syncthreads();
#define HG_ST(i) { const int idx = tid + 256 * i, row = idx >> 4, sg = idx & 15; \
    *(uint4*)(Qs + row * 144 + sg * 8) = rq##i; *(uint4*)(Fr + row * 128 + sg * 8) = rf##i; *(uint4*)(Gs + row * 144 + sg * 8) = rg##i; }
  HG_ST(0) HG_ST(1) HG_ST(2) HG_ST(3)
#undef HG_ST
  __syncthreads();
  {
    const int k = tid & 127, half = tid >> 7;
    const float lb = ((const float*)(p.ws + S_LB))[h * 128 + k];
    float fv[32], cum[32];
    float run = 0.f;
#pragma unroll
    for (int i = 0; i < 32; ++i) {
      const float f = lb + (1.f - lb) * sigm(bf2f(Fr[(half * 32 + i) * 128 + k]));
      run += __logf(f);
      fv[i] = f; cum[i] = run;
    }
    tot[half * 128 + k] = run;
    __syncthreads();
    const float boff = half ? tot[k] : 0.f;
#pragma unroll
    for (int i = 0; i < 32; ++i) {
      const int s = half * 32 + i;
      const float eb = __expf(boff + cum[i]);
      const float q = siluf(bf2f(Qs[s * 144 + k]));
      Qs[s * 144 + k] = f2bf(q * eb);
      Ks[s * 144 + k] = f2bf((1.f - fv[i]) * frcp(eb));
    }
  }
  __syncthreads();
  f32x4 at[4];
#pragma unroll
  for (int ni = 0; ni < 4; ++ni) at[ni] = f32x4{0.f, 0.f, 0.f, 0.f};
#pragma unroll
  for (int ks = 0; ks < 4; ++ks) {
    uint4 a = lds128(Qs + (16 * w + l15) * 144 + ks * 32 + lq * 8);
#pragma unroll
    for (int ni = 0; ni < 4; ++ni) at[ni] = mfma16(a, lds128(Ks + (ni * 16 + l15) * 144 + ks * 32 + lq * 8), at[ni]);
  }
  __syncthreads();
#pragma unroll
  for (int ni = 0; ni < 4; ++ni)
#pragma unroll
    for (int j = 0; j < 4; ++j) {
      int c = 16 * w + lq * 4 + j, s = ni * 16 + l15;
      ATT[c * 80 + s] = f2bf(s <= c ? at[ni][j] : 0.f);
    }
#define HG_SV(i) { const int idx = tid + 256 * i, v = idx >> 3, c = idx & 7; *(uint4*)(Vt + v * 80 + c * 8) = rv##i; }
  HG_SV(0) HG_SV(1) HG_SV(2) HG_SV(3)
#undef HG_SV
  __syncthreads();
  f32x4 o[8];
#pragma unroll
  for (int ni = 0; ni < 8; ++ni) o[ni] = f32x4{0.f, 0.f, 0.f, 0.f};
#pragma unroll
  for (int ks = 0; ks < 2; ++ks) {
    uint4 a = lds128(ATT + (16 * w + l15) * 80 + ks * 32 + lq * 8);
#pragma unroll
    for (int ni = 0; ni < 8; ++ni) o[ni] = mfma16(a, lds128(Vt + (ni * 16 + l15) * 80 + ks * 32 + lq * 8), o[ni]);
  }
  __syncthreads();
#define HG_SS(i) { const int idx = tid + 256 * i, v = idx >> 4, sg = idx & 15; *(uint4*)(St + v * 144 + sg * 8) = rs##i; }
  HG_SS(0) HG_SS(1) HG_SS(2) HG_SS(3) HG_SS(4) HG_SS(5) HG_SS(6) HG_SS(7)
#undef HG_SS
  __syncthreads();
#pragma unroll
  for (int ks = 0; ks < 4; ++ks) {
    uint4 a = lds128(Qs + (16 * w + l15) * 144 + ks * 32 + lq * 8);
#pragma unroll
    for (int ni = 0; ni < 8; ++ni) o[ni] = mfma16(a, lds128(St + (ni * 16 + l15) * 144 + ks * 32 + lq * 8), o[ni]);
  }
#pragma unroll
  for (int j = 0; j < 4; ++j) {
    float ss = 0.f;
#pragma unroll
    for (int ni = 0; ni < 8; ++ni) ss += o[ni][j] * o[ni][j];
    ss = sum16(ss);
    const float rsn = rsqrtf(ss * (1.f / 128.f) + 1e-6f);
    const int c = 16 * w + lq * 4 + j;
#pragma unroll
    for (int ni = 0; ni < 8; ++ni) {
      const int v = ni * 16 + l15;
      const float gate = bf2f(Gs[c * 144 + v]);
      Gs[c * 144 + v] = f2bf(o[ni][j] * rsn * ng[ni] * siluf(gate));
    }
  }
  __syncthreads();
  bfu* Y = (bfu*)(p.ws + OFF_Y);
#pragma unroll
  for (int i = 0; i < 4; ++i) {
    const int idx = tid + 256 * i, row = idx >> 4, sg = idx & 15;
    *(uint4*)(Y + (t0 + row) * 1024 + h * 128 + sg * 8) = *(const uint4*)(Gs + row * 144 + sg * 8);
  }
}

DEV void phase_ln1_router(const Params& p, const float* __restrict__ Xin, int layer, unsigned char* smem) {
  const bfu* MIX = (const bfu*)(p.ws + OFF_MIX);
  float* X1 = (float*)(p.ws + OFF_X1);
  bfu* X1b = (bfu*)(p.ws + OFF_X1B);
  const float* g1 = p.ln1_g + layer * 1024;
  const float* b1 = p.ln1_b + layer * 1024;
  const float* wg = p.w_group + (size_t)layer * 1024 * 4;
  const float* we = p.w_expert + (size_t)layer * 1024 * 16;
  const float* bg = p.b_group + layer * 4;
  const float* be = p.b_expert + layer * 16;
  float* tokw = (float*)(p.ws + S_TOKW);
  int* list = (int*)(p.ws + S_LIST);
  int* gcnt = (int*)(p.ws + S_CNT) + layer * 32;
  float* Wes = (float*)smem;
  int* tokb = (int*)(smem + 65536);
  int* lcnt = tokb + 64;
  int* lbase = lcnt + 32;
  int* lpos = lbase + 32;
  const int tid = my_tid(), lane = tid & 63, w = tid >> 6;
  __syncthreads();
  {
    float4 wv[16];
#pragma unroll
    for (int i = 0; i < 16; ++i) wv[i] = *(const float4*)(we + (size_t)(tid + 256 * i) * 4);
#pragma unroll
    for (int i = 0; i < 16; ++i) {
      const int idx = tid + 256 * i, d = idx >> 2, c4 = idx & 3;
      Wes[(c4 * 4 + 0) * 1024 + d] = wv[i].x; Wes[(c4 * 4 + 1) * 1024 + d] = wv[i].y;
      Wes[(c4 * 4 + 2) * 1024 + d] = wv[i].z; Wes[(c4 * 4 + 3) * 1024 + d] = wv[i].w;
    }
  }
  __syncthreads();
  for (int it = blockIdx.x; it < T / 64; it += gridDim.x) {
    const int tb = it * 64;
    __syncthreads();
    if (tid < 24) lcnt[tid] = 0;
    float4 nxa[4]; uint2 nxm[4];
    {
      const size_t tn = (size_t)tb + w * 16;
#pragma unroll
      for (int i = 0; i < 4; ++i) {
        nxa[i] = *(const float4*)(Xin + tn * 1024 + i * 256 + lane * 4);
        nxm[i] = *(const uint2*)(MIX + tn * 1024 + i * 256 + lane * 4);
      }
    }
    for (int tk = 0; tk < 16; ++tk) {
      const size_t t = (size_t)tb + w * 16 + tk;
      float4 cxa[4]; uint2 cxm[4];
#pragma unroll
      for (int i = 0; i < 4; ++i) { cxa[i] = nxa[i]; cxm[i] = nxm[i]; }
      {
        const size_t tn = (size_t)tb + w * 16 + (tk < 15 ? tk + 1 : 15);
#pragma unroll
        for (int i = 0; i < 4; ++i) {
          nxa[i] = *(const float4*)(Xin + tn * 1024 + i * 256 + lane * 4);
          nxm[i] = *(const uint2*)(MIX + tn * 1024 + i * 256 + lane * 4);
        }
      }
      float xv[16];
      float s = 0.f;
#pragma unroll
      for (int i = 0; i < 4; ++i) {
        const float4 a = cxa[i];
        const float4 m = make_float4(__uint_as_float(cxm[i].x << 16), __uint_as_float(cxm[i].x & 0xffff0000u), __uint_as_float(cxm[i].y << 16), __uint_as_float(cxm[i].y & 0xffff0000u));
        xv[4 * i] = ALPHA * a.x + m.x; xv[4 * i + 1] = ALPHA * a.y + m.y;
        xv[4 * i + 2] = ALPHA * a.z + m.z; xv[4 * i + 3] = ALPHA * a.w + m.w;
        s += xv[4 * i] + xv[4 * i + 1] + xv[4 * i + 2] + xv[4 * i + 3];
      }
      const float mu = wave_sum(s) * (1.f / 1024.f);
      float vs = 0.f;
#pragma unroll
      for (int e = 0; e < 16; ++e) { float d = xv[e] - mu; vs += d * d; }
      const float rstd = rsqrtf(wave_sum(vs) * (1.f / 1024.f) + 1e-5f);
      float acc[20];
#pragma unroll
      for (int c = 0; c < 20; ++c) acc[c] = 0.f;
#pragma unroll
      for (int i = 0; i < 4; ++i) {
        float4 gg = *(const float4*)(g1 + i * 256 + lane * 4);
        float4 bb = *(const float4*)(b1 + i * 256 + lane * 4);
        const float o0 = (xv[4 * i] - mu) * rstd * gg.x + bb.x;
        const float o1 = (xv[4 * i + 1] - mu) * rstd * gg.y + bb.y;
        const float o2 = (xv[4 * i + 2] - mu) * rstd * gg.z + bb.z;
        const float o3 = (xv[4 * i + 3] - mu) * rstd * gg.w + bb.w;
        *(uint2*)(X1b + t * 1024 + i * 256 + lane * 4) = make_uint2(pack2(o0, o1), pack2(o2, o3));
#pragma unroll
        for (int c = 0; c < 16; ++c) {
          float4 wv = *(const float4*)(Wes + c * 1024 + i * 256 + lane * 4);
          acc[4 + c] += o0 * wv.x + o1 * wv.y + o2 * wv.z + o3 * wv.w;
        }
        const float* wgp = wg + (size_t)(i * 256 + lane * 4) * 4;
        float4 q0 = *(const float4*)(wgp), q1 = *(const float4*)(wgp + 4), q2 = *(const float4*)(wgp + 8), q3 = *(const float4*)(wgp + 12);
        acc[0] += o0 * q0.x + o1 * q1.x + o2 * q2.x + o3 * q3.x;
        acc[1] += o0 * q0.y + o1 * q1.y + o2 * q2.y + o3 * q3.y;
        acc[2] += o0 * q0.z + o1 * q1.z + o2 * q2.z + o3 * q3.z;
        acc[3] += o0 * q0.w + o1 * q1.w + o2 * q2.w + o3 * q3.w;
      }
#pragma unroll
      for (int c = 0; c < 20; ++c) acc[c] = wave_sum(acc[c]);
      float lg[4];
#pragma unroll
      for (int c = 0; c < 4; ++c) lg[c] = acc[c] + bg[c];
      int gi = 0; float gm = lg[0];
#pragma unroll
      for (int c = 1; c < 4; ++c) if (lg[c] > gm) { gm = lg[c]; gi = c; }
      float gs = 0.f;
#pragma unroll
      for (int c = 0; c < 4; ++c) gs += __expf(lg[c] - gm);
      const float gtop = 1.f / gs;
      float ev[4] = {0.f, 0.f, 0.f, 0.f};
#pragma unroll
      for (int gg = 0; gg < 4; ++gg)
#pragma unroll
        for (int c = 0; c < 4; ++c) if (gi == gg) ev[c] = acc[4 + gg * 4 + c] + be[gg * 4 + c];
      int i1 = 0; float v1 = ev[0];
#pragma unroll
      for (int c = 1; c < 4; ++c) if (ev[c] > v1) { v1 = ev[c]; i1 = c; }
      int i2 = -1; float v2 = -3e38f;
#pragma unroll
      for (int c = 0; c < 4; ++c) if (c != i1 && ev[c] > v2) { v2 = ev[c]; i2 = c; }
      const float ex = __expf(v2 - v1);
      const float w1 = gtop / (1.f + ex), w2 = gtop * ex / (1.f + ex);
      const int lo = min(i1, i2), hi = max(i1, i2);
      const float wlo = (i1 < i2) ? w1 : w2, whi = (i1 < i2) ? w2 : w1;
      const int pi = (lo == 0) ? (hi - 1) : ((lo == 1) ? (hi + 1) : 5);
      if (lane == 0) {
        const int tl = w * 16 + tk;
        tokb[tl] = gi * 6 + pi;
        tokw[(size_t)(tb + tl) * 2] = wlo;
        tokw[(size_t)(tb + tl) * 2 + 1] = whi;
      }
    }
    __syncthreads();
    int myb = 0;
    if (tid < 64) { myb = tokb[tid]; lpos[tid] = atomicAdd(&lcnt[myb], 1); }
    __syncthreads();
    if (tid < 24) { int c = lcnt[tid]; lbase[tid] = c ? atomicAdd(&gcnt[tid], c) : 0; }
    __syncthreads();
    if (tid < 64) list[(size_t)myb * T + lbase[myb] + lpos[tid]] = tb + tid;
  }
}

struct MoeTile { int bk, r0, cnt, srow0, elo, ehi; };
DEV int moe_total_tiles(const int* gcnt) {
  int tot = 0;
  for (int b = 0; b < 24; ++b) tot += (gcnt[b] + 127) >> 7;
  return tot;
}
DEV MoeTile moe_find(const int* gcnt, int tile) {
  MoeTile r; int acc = 0, srow = 0; r.bk = 0; r.r0 = 0; r.cnt = 0; r.srow0 = 0;
  for (int b = 0; b < 24; ++b) {
    int c = gcnt[b]; int nt = (c + 127) >> 7;
    if (tile >= acc && tile < acc + nt) { r.bk = b; r.r0 = (tile - acc) * 128; r.cnt = c; r.srow0 = srow; }
    acc += nt; srow += c;
  }
  int g = r.bk / 6, pi = r.bk - g * 6;
  int lo = (pi < 3) ? 0 : ((pi < 5) ? 1 : 2);
  int hi = (pi < 3) ? pi + 1 : ((pi < 5) ? pi - 1 : 3);
  r.elo = g * 4 + lo; r.ehi = g * 4 + hi;
  return r;
}

DEV void phase_moe1(const Params& p, int layer, unsigned char* smem) {
  const int* gcnt = (const int*)(p.ws + S_CNT) + layer * 32;
  const int* list = (const int*)(p.ws + S_LIST);
  const float* tokw = (const float*)(p.ws + S_TOKW);
  const bfu* X1b = (const bfu*)(p.ws + OFF_X1B);
  const bfu* Wgu = (const bfu*)(p.ws + OFF_WGU) + (size_t)layer * 16 * 512 * 1024;
  bfu* H = (bfu*)(p.ws + OFF_H);
  const int total = moe_total_tiles(gcnt) * 8;
  const int r0 = my_tid() >> 3;
  auto mkA = [&](const MoeTile& mt) {
    GatherLoader g;
    g.base = X1b;
#pragma unroll
    for (int i = 0; i < 4; ++i) {
      const int r = mt.r0 + r0 + 32 * i;
      const int tok = list[(size_t)mt.bk * T + (r < mt.cnt ? r : 0)];
      g.off[i] = (unsigned)tok * 1024u;
    }
    return g;
  };
  auto mkB = [&](const MoeTile& mt, int nt) {
    const int ex = (nt < 4) ? mt.elo : mt.ehi;
    return RowLoader{Wgu, (unsigned)(ex * 512 + (nt & 3) * 128 + r0) * 1024u, 32768u};
  };
  GemmPipe gp;
  bool first = true;
  int it = blockIdx.x;
  if (it >= total) return;
  MoeTile mt = moe_find(gcnt, it >> 3);
  GatherLoader al = mkA(mt);
  RowLoader bl = mkB(mt, it & 7);
  for (;;) {
    const int nt = it & 7;
    const int itn = it + gridDim.x;
    const bool hasNext = itn < total;
    const int itq = hasNext ? itn : it;
    const MoeTile mtn = moe_find(gcnt, itq >> 3);
    const GatherLoader aln = mkA(mtn);
    const RowLoader bln = mkB(mtn, itq & 7);
    auto epi = [&](f32x4(&acc)[4][4], int wm, int wn, int l15, int lq) {
      const int q = (nt & 3) * 2 + wn;
#pragma unroll
      for (int bi = 0; bi < 4; ++bi) {
        const int r = mt.r0 + wm * 64 + bi * 16 + l15;
        if (r < mt.cnt) {
          const int tok = list[(size_t)mt.bk * T + r];
          const float gw = tokw[(size_t)tok * 2 + (nt >> 2)];
#pragma unroll
          for (int ai = 0; ai < 2; ++ai) {
            float o[4];
#pragma unroll
            for (int j = 0; j < 4; ++j) o[j] = siluf(acc[ai][bi][j]) * acc[ai + 2][bi][j] * gw;
            *(uint2*)(H + (size_t)(mt.srow0 + r) * 512 + (nt >> 2) * 256 + q * 32 + ai * 16 + lq * 4) =
                make_uint2(pack2(o[0], o[1]), pack2(o[2], o[3]));
          }
        }
      }
    };
    gemm128(true, 1024, first, hasNext, al, bl, aln, bln, epi, gp, smem);
    first = false;
    if (!hasNext) break;
    it = itn; mt = mtn; al = aln; bl = bln;
  }
}

DEV void phase_moe2(const Params& p, int layer, unsigned char* smem) {
  const int* gcnt = (const int*)(p.ws + S_CNT) + layer * 32;
  const int* list = (const int*)(p.ws + S_LIST);
  const bfu* H = (const bfu*)(p.ws + OFF_H);
  const bfu* Wdn = (const bfu*)(p.ws + OFF_WDN) + (size_t)layer * 16 * 1024 * 256;
  bfu* FF = (bfu*)(p.ws + OFF_MIX);
  const int total = moe_total_tiles(gcnt) * 8;
  const int r0 = my_tid() >> 3;
  auto mkA = [&](const MoeTile& mt) { return RowLoader{H, (unsigned)(mt.srow0 + mt.r0 + r0) * 512u, 16384u}; };
  auto mkB = [&](const MoeTile& mt, int nt) {
    return SplitKLoader{Wdn, (unsigned)(mt.elo * 1024 + nt * 128 + r0) * 256u, (unsigned)((mt.ehi - mt.elo) * 1024) * 256u};
  };
  GemmPipe gp;
  bool first = true;
  int it = blockIdx.x;
  if (it >= total) return;
  MoeTile mt = moe_find(gcnt, it >> 3);
  RowLoader al = mkA(mt);
  SplitKLoader bl = mkB(mt, it & 7);
  for (;;) {
    const int nt = it & 7;
    const int itn = it + gridDim.x;
    const bool hasNext = itn < total;
    const int itq = hasNext ? itn : it;
    const MoeTile mtn = moe_find(gcnt, itq >> 3);
    const RowLoader aln = mkA(mtn);
    const SplitKLoader bln = mkB(mtn, itq & 7);
    auto epi = [&](f32x4(&acc)[4][4], int wm, int wn, int l15, int lq) {
#pragma unroll
      for (int bi = 0; bi < 4; ++bi) {
        const int r = mt.r0 + wm * 64 + bi * 16 + l15;
        if (r < mt.cnt) {
          const int tok = list[(size_t)mt.bk * T + r];
#pragma unroll
          for (int ai = 0; ai < 4; ++ai)
            *(uint2*)(FF + (size_t)tok * 1024 + nt * 128 + wn * 64 + ai * 16 + lq * 4) =
                make_uint2(pack2(acc[ai][bi][0], acc[ai][bi][1]), pack2(acc[ai][bi][2], acc[ai][bi][3]));
        }
      }
    };
    gemm128(true, 512, first, hasNext, al, bl, aln, bln, epi, gp, smem);
    first = false;
    if (!hasNext) break;
    it = itn; mt = mtn; al = aln; bl = bln;
  }
}

DEV void phase_ln2(const Params& p, int layer, float* __restrict__ outp, bfu* __restrict__ outb) {
  const bfu* X1b = (const bfu*)(p.ws + OFF_X1B);
  const bfu* FF = (const bfu*)(p.ws + OFF_MIX);
  const float* g2 = p.ln2_g + layer * 1024;
  const float* b2 = p.ln2_b + layer * 1024;
  const int lane = my_tid() & 63, w = my_tid() >> 6;
  const int stride = gridDim.x * 4;
  int t = blockIdx.x * 4 + w;
  if (t >= T) return;
  uint2 nxa[4]; uint2 nxm[4];
#pragma unroll
  for (int i = 0; i < 4; ++i) {
    nxa[i] = *(const uint2*)(X1b + (size_t)t * 1024 + i * 256 + lane * 4);
    nxm[i] = *(const uint2*)(FF + (size_t)t * 1024 + i * 256 + lane * 4);
  }
  for (; t < T; t += stride) {
    uint2 cxa[4]; uint2 cxm[4];
#pragma unroll
    for (int i = 0; i < 4; ++i) { cxa[i] = nxa[i]; cxm[i] = nxm[i]; }
    {
      const int tn = (t + stride < T) ? t + stride : t;
#pragma unroll
      for (int i = 0; i < 4; ++i) {
        nxa[i] = *(const uint2*)(X1b + (size_t)tn * 1024 + i * 256 + lane * 4);
        nxm[i] = *(const uint2*)(FF + (size_t)tn * 1024 + i * 256 + lane * 4);
      }
    }
    float xv[16];
    float s = 0.f;
#pragma unroll
    for (int i = 0; i < 4; ++i) {
      const uint2 ab_ = cxa[i];
      const float4 a = make_float4(__uint_as_float(ab_.x << 16), __uint_as_float(ab_.x & 0xffff0000u), __uint_as_float(ab_.y << 16), __uint_as_float(ab_.y & 0xffff0000u));
      const uint2 mb = cxm[i];
      const float4 m = make_float4(__uint_as_float(mb.x << 16), __uint_as_float(mb.x & 0xffff0000u), __uint_as_float(mb.y << 16), __uint_as_float(mb.y & 0xffff0000u));
      xv[4 * i] = ALPHA * a.x + m.x; xv[4 * i + 1] = ALPHA * a.y + m.y;
      xv[4 * i + 2] = ALPHA * a.z + m.z; xv[4 * i + 3] = ALPHA * a.w + m.w;
      s += xv[4 * i] + xv[4 * i + 1] + xv[4 * i + 2] + xv[4 * i + 3];
    }
    const float mu = wave_sum(s) * (1.f / 1024.f);
    float vs = 0.f;
#pragma unroll
    for (int e = 0; e < 16; ++e) { float d = xv[e] - mu; vs += d * d; }
    const float rstd = rsqrtf(wave_sum(vs) * (1.f / 1024.f) + 1e-5f);
#pragma unroll
    for (int i = 0; i < 4; ++i) {
      float4 gg = *(const float4*)(g2 + i * 256 + lane * 4);
      float4 bb = *(const float4*)(b2 + i * 256 + lane * 4);
      const float o0 = (xv[4 * i] - mu) * rstd * gg.x + bb.x, o1 = (xv[4 * i + 1] - mu) * rstd * gg.y + bb.y;
      const float o2 = (xv[4 * i + 2] - mu) * rstd * gg.z + bb.z, o3 = (xv[4 * i + 3] - mu) * rstd * gg.w + bb.w;
      *(float4*)(outp + (size_t)t * 1024 + i * 256 + lane * 4) = make_float4(o0, o1, o2, o3);
      if (outb) *(uint2*)(outb + (size_t)t * 1024 + i * 256 + lane * 4) = make_uint2(pack2(o0, o1), pack2(o2, o3));
    }
  }
}

template <int NK, bool SINK, typename KP, typename VP, typename MK, typename OUT>
DEV void attn_core(const bfu* qptr, KP kptr, VP vptr, MK maskf, float sink, OUT outf, unsigned char* smem) {
  constexpr int NT = NK / 16;
  constexpr int VS = NK + 16;
  constexpr int KS = 80;
  bfu* Ks = (bfu*)smem;
  bfu* Ps = Ks;
  bfu* Vt = Ks + NK * KS;
  const int tid = my_tid(), lane = tid & 63, w = tid >> 6, l15 = lane & 15, lq = lane >> 4;
  uint4 k0, k1, k2, k3, k4, k5, k6, k7, v0, v1, v2, v3, v4, v5, v6, v7;
#define ATT_LD(i) if constexpr (i < NK / 32) { const int idx = tid + 256 * i; const int kk = idx >> 3, sg = idx & 7; \
    k##i = *(const uint4*)(kptr(kk) + sg * 8); const int d = idx / (NK / 8), k8 = idx - d * (NK / 8); v##i = *(const uint4*)(vptr(d, k8)); }
  ATT_LD(0) ATT_LD(1) ATT_LD(2) ATT_LD(3) ATT_LD(4) ATT_LD(5) ATT_LD(6) ATT_LD(7)
#undef ATT_LD
  const uint4 qf0 = *(const uint4*)(qptr + lq * 8), qf1 = *(const uint4*)(qptr + 32 + lq * 8);
  __syncthreads();
#define ATT_ST(i) if constexpr (i < NK / 32) { const int idx = tid + 256 * i; const int kk = idx >> 3, sg = idx & 7; \
    *(uint4*)(Ks + kk * KS + sg * 8) = k##i; const int d = idx / (NK / 8), k8 = idx - d * (NK / 8); *(uint4*)(Vt + d * VS + k8 * 8) = v##i; }
  ATT_ST(0) ATT_ST(1) ATT_ST(2) ATT_ST(3) ATT_ST(4) ATT_ST(5) ATT_ST(6) ATT_ST(7)
#undef ATT_ST
  __syncthreads();
  f32x4 s[NT];
#pragma unroll
  for (int ni = 0; ni < NT; ++ni) {
    f32x4 a = f32x4{0.f, 0.f, 0.f, 0.f};
    a = mfma16(lds128(Ks + (ni * 16 + l15) * KS + lq * 8), qf0, a);
    a = mfma16(lds128(Ks + (ni * 16 + l15) * KS + 32 + lq * 8), qf1, a);
    s[ni] = a;
  }
  const int row = 16 * w + l15;
  float mx = NEGF;
#pragma unroll
  for (int ni = 0; ni < NT; ++ni)
#pragma unroll
    for (int j = 0; j < 4; ++j) {
      const int kk = ni * 16 + lq * 4 + j;
      float v = maskf(row, kk) ? s[ni][j] * (0.125f * 1.4426950408889634f) : NEGF;
      s[ni][j] = v;
      mx = fmaxf(mx, v);
    }
  mx = fmaxf(mx, __shfl_xor(mx, 16));
  mx = fmaxf(mx, __shfl_xor(mx, 32));
  const float sink2 = sink * 1.4426950408889634f;
  if (SINK) mx = fmaxf(mx, sink2);
  float ls = 0.f;
#pragma unroll
  for (int ni = 0; ni < NT; ++ni)
#pragma unroll
    for (int j = 0; j < 4; ++j) {
      float pv = __builtin_amdgcn_exp2f(s[ni][j] - mx);
      ls += pv;
      s[ni][j] = pv;
    }
  ls += __shfl_xor(ls, 16);
  ls += __shfl_xor(ls, 32);
  if (SINK) ls += __builtin_amdgcn_exp2f(sink2 - mx);
  __syncthreads();
#pragma unroll
  for (int ni = 0; ni < NT; ++ni)
    *(uint2*)(Ps + row * VS + ni * 16 + lq * 4) = make_uint2(pack2(s[ni][0], s[ni][1]), pack2(s[ni][2], s[ni][3]));
  __syncthreads();
  f32x4 o[4];
#pragma unroll
  for (int ni = 0; ni < 4; ++ni) o[ni] = f32x4{0.f, 0.f, 0.f, 0.f};
#pragma unroll
  for (int ks = 0; ks < NK / 32; ++ks) {
    uint4 pb = lds128(Ps + row * VS + ks * 32 + lq * 8);
#pragma unroll
    for (int ni = 0; ni < 4; ++ni) o[ni] = mfma16(lds128(Vt + (ni * 16 + l15) * VS + ks * 32 + lq * 8), pb, o[ni]);
  }
  const float mnat = mx * 0.6931471805599453f;
#pragma unroll
  for (int ni = 0; ni < 4; ++ni) outf(row, ni * 16 + lq * 4, o[ni], mnat, ls);
}

DEV void swa_item(const Params& p, int it, unsigned char* smem) {
  const int h = it & 7, qt = (it >> 3) & 255, b = it >> 11;
  const int hk = h >> 2;
  const int t0 = qt * 64, kstart = t0 - 128;
  const bfu* P = (const bfu*)(p.ws + OFF_P);
  bfu* Y = (bfu*)(p.ws + OFF_Y);
  const int lane = my_tid() & 63, w = my_tid() >> 6, l15 = lane & 15;
  const bfu* qptr = P + ((size_t)b * L + t0 + 16 * w + l15) * 1536 + h * 64;
  const bfu* kb = P + (size_t)b * L * 1536 + 512 + hk * 64;
  auto kptr = [&](int kk) -> const bfu* { int pos = kstart + kk; pos = pos < 0 ? 0 : pos; return kb + (size_t)pos * 1536; };
  const bfu* vtb = (const bfu*)(p.ws + OFF_VT) + (size_t)((0 * 2 + b) * 2 + hk) * 64 * L;
  auto vptr = [&](int d, int k8) -> const bfu* { int pos = kstart + k8 * 8; pos = pos < 0 ? 0 : pos; return vtb + (size_t)d * L + pos; };
  auto maskf = [&](int row, int kk) -> bool { int pos = kstart + kk, t = t0 + row; return pos >= 0 && pos <= t && (t - pos) < 128; };
  auto outf = [&](int row, int d0, f32x4 o, float m, float l) {
    const float inv = 1.f / l;
    *(uint2*)(Y + ((size_t)b * L + t0 + row) * 1024 + h * 64 + d0) = make_uint2(pack2(o[0] * inv, o[1] * inv), pack2(o[2] * inv, o[3] * inv));
  };
  attn_core<192, true>(qptr, kptr, vptr, maskf, p.od_sinks[h], outf, smem);
}

DEV void kmean_item(const Params& p, int it, unsigned char* smem) {
  const int j = it & 63, bhk = it >> 6, b = bhk >> 1, hk = bhk & 1;
  const bfu* P = (const bfu*)(p.ws + OFF_P);
  float* red = (float*)smem;
  const int tid = my_tid(), d = tid & 63, part = tid >> 6;
  const bfu* kb = P + ((size_t)b * L + j * 256 + part * 64) * 1536 + 1280 + hk * 64 + d;
  float s = 0.f;
  for (int i = 0; i < 64; ++i) s += bf2f(kb[(size_t)i * 1536]);
  __syncthreads();
  red[part * 64 + d] = s;
  __syncthreads();
  if (tid < 64) {
    float tot = red[tid] + red[64 + tid] + red[128 + tid] + red[192 + tid];
    ((bfu*)(p.ws + S_KMEAN))[(size_t)it * 64 + tid] = f2bf(tot * (1.f / 256.f));
  }
}

DEV int cap_off(int j) { return 1024 * (63 * j - (j * (j - 1)) / 2); }

DEV void moba_own_item(const Params& p, int it, unsigned char* smem) {
  const int h = it & 7, o4 = (it >> 3) & 3, c = (it >> 5) & 63, b = it >> 11;
  const int hk = h >> 2, g = h & 3;
  const int t0 = c * 256 + o4 * 64;
  const bfu* P = (const bfu*)(p.ws + OFF_P);
  bfu* PO = (bfu*)(p.ws + OFF_PO);
  float* PM = (float*)(p.ws + OFF_PM);
  float* PL = (float*)(p.ws + OFF_PL);
  const int tid = my_tid(), lane = tid & 63, w = tid >> 6, l15 = lane & 15, lq = lane >> 4;
  const bfu* qptr = P + ((size_t)b * L + t0 + 16 * w + l15) * 1536 + 768 + h * 64;
  const bfu* kb = P + ((size_t)b * L + c * 256) * 1536 + 1280 + hk * 64;
  auto kptr = [&](int kk) -> const bfu* { return kb + (size_t)kk * 1536; };
  const bfu* vtb = (const bfu*)(p.ws + OFF_VT) + (size_t)((1 * 2 + b) * 2 + hk) * 64 * L + c * 256;
  auto vptr = [&](int d, int k8) -> const bfu* { return vtb + (size_t)d * L + k8 * 8; };
  auto maskf = [&](int row, int kk) -> bool { return kk <= o4 * 64 + row; };
  auto outf = [&](int row, int d0, f32x4 o, float m, float l) {
    const size_t idx = (((size_t)b * L + t0 + row) * 8 + h) * 4;
    const float inv = 1.f / l;
    *(uint2*)(PO + idx * 64 + d0) = make_uint2(pack2(o[0] * inv, o[1] * inv), pack2(o[2] * inv, o[3] * inv));
    if (d0 == 0) { PM[idx] = m; PL[idx] = l; }
  };
  attn_core<256, false>(qptr, kptr, vptr, maskf, 0.f, outf, smem);
  int* lcnt = (int*)(smem + SM_AUX);
  int* lbase = lcnt + 64;
  int* sel = lbase + 64;
  if (tid < 64) lcnt[tid] = 0;
  __syncthreads();
  const uint4 qf0 = *(const uint4*)(qptr + lq * 8), qf1 = *(const uint4*)(qptr + 32 + lq * 8);
  const bfu* km = (const bfu*)(p.ws + S_KMEAN) + (size_t)(b * 2 + hk) * 64 * 64;
  float cand[4][4];
#pragma unroll
  for (int ni = 0; ni < 4; ++ni) {
    f32x4 a = f32x4{0.f, 0.f, 0.f, 0.f};
    a = mfma16(qf0, *(const uint4*)(km + (ni * 16 + l15) * 64 + lq * 8), a);
    a = mfma16(qf1, *(const uint4*)(km + (ni * 16 + l15) * 64 + 32 + lq * 8), a);
#pragma unroll
    for (int j = 0; j < 4; ++j) cand[ni][j] = (ni * 16 + l15 < c) ? a[j] : -3e38f;
  }
#pragma unroll
  for (int j = 0; j < 4; ++j) {
    const int row = 16 * w + lq * 4 + j;
#pragma unroll
    for (int sl = 0; sl < 3; ++sl) {
      float bv = cand[0][j]; int bi = l15;
#pragma unroll
      for (int ni = 1; ni < 4; ++ni) if (cand[ni][j] > bv) { bv = cand[ni][j]; bi = ni * 16 + l15; }
#pragma unroll
      for (int off = 8; off >= 1; off >>= 1) {
        float ov = __shfl_xor(bv, off); int oi = __shfl_xor(bi, off);
        if (ov > bv || (ov == bv && oi < bi)) { bv = ov; bi = oi; }
      }
      const bool valid = bv > -1e38f;
#pragma unroll
      for (int ni = 0; ni < 4; ++ni) if (ni * 16 + l15 == bi) cand[ni][j] = -3e38f;
      if (l15 == 0) {
        const size_t idx = (((size_t)b * L + t0 + row) * 8 + h) * 4 + 1 + sl;
        if (valid) {
          int lp = atomicAdd(&lcnt[bi], 1);
          sel[row * 3 + sl] = bi | (lp << 8);
        } else {
          sel[row * 3 + sl] = -1;
          PM[idx] = NEGF; PL[idx] = 0.f;
        }
      }
    }
  }
  __syncthreads();
  int* gcnt = (int*)(p.ws + S_CNT) + 64 + (b * 2 + hk) * 64;
  if (tid < 64) { int cc = lcnt[tid]; lbase[tid] = cc ? atomicAdd(&gcnt[tid], cc) : 0; }
  __syncthreads();
  if (tid < 192) {
    const int row = tid / 3, sl = tid - row * 3;
    const int sv = sel[tid];
    if (sv >= 0) {
      const int bi = sv & 255, lp = sv >> 8;
      int* bucket = (int*)(p.ws + OFF_BUCK) + (size_t)(b * 2 + hk) * BUCK_PER_BH + cap_off(bi);
      bucket[lbase[bi] + lp] = ((t0 + row) << 4) | (g << 2) | (sl + 1);
    }
  }
}

DEV void phase_moba_bucket(const Params& p, unsigned char* smem) {
  int* pref = (int*)(smem + SM_AUX);
  const int* gcnt = (const int*)(p.ws + S_CNT) + 64;
  const int tid = my_tid(), lane = tid & 63, w = tid >> 6, l15 = lane & 15;
  {
    int nt = (gcnt[tid] + 63) >> 6;
    __syncthreads();
    pref[tid] = nt;
    __syncthreads();
    for (int off = 1; off < 256; off <<= 1) {
      int v = pref[tid];
      if (tid >= off) v += pref[tid - off];
      __syncthreads();
      pref[tid] = v;
      __syncthreads();
    }
  }
  const int total = pref[255];
  const bfu* P = (const bfu*)(p.ws + OFF_P);
  bfu* PO = (bfu*)(p.ws + OFF_PO);
  float* PM = (float*)(p.ws + OFF_PM);
  float* PL = (float*)(p.ws + OFF_PL);
  const int lq = lane >> 4;
  struct Item { int bk, cnt, rbase; };
  auto decode = [&](int it) -> Item {
    int lo = 0, hi = 255;
    while (lo < hi) { int mid = (lo + hi) >> 1; if (pref[mid] > it) hi = mid; else lo = mid + 1; }
    Item r; r.bk = lo; r.cnt = gcnt[lo];
    const int ntb = (r.cnt + 63) >> 6;
    r.rbase = (it - (pref[lo] - ntb)) * 64;
    return r;
  };
  auto bucket_of = [&](int bk) -> const int* {
    return (const int*)(p.ws + OFF_BUCK) + (size_t)(bk >> 6) * BUCK_PER_BH + cap_off(bk & 63);
  };
  auto load_entries = [&](const Item& im, int& e, int (&en)[4]) {
    const int* bucket = bucket_of(im.bk);
    const int rr = im.rbase + 16 * w + l15;
    e = bucket[rr < im.cnt ? rr : 0];
#pragma unroll
    for (int j = 0; j < 4; ++j) { const int r = im.rbase + 16 * w + lq * 4 + j; en[j] = bucket[r < im.cnt ? r : 0]; }
  };
  int it = blockIdx.x;
  if (it >= total) return;
  Item cur = decode(it);
  int e, en[4];
  load_entries(cur, e, en);
  for (;;) {
    const int itn = it + gridDim.x;
    const bool hasNext = itn < total;
    Item nxt = cur; int e2 = e, en2[4] = {en[0], en[1], en[2], en[3]};
    if (hasNext) { nxt = decode(itn); load_entries(nxt, e2, en2); }
    const int bk = cur.bk, cnt = cur.cnt, rbase = cur.rbase;
    const int j = bk & 63, bhk = bk >> 6, b = bhk >> 1, hk = bhk & 1;
    const bfu* qptr = P + ((size_t)b * L + (e >> 4)) * 1536 + 768 + (hk * 4 + ((e >> 2) & 3)) * 64;
    const bfu* kb = P + ((size_t)b * L + j * 256) * 1536 + 1280 + hk * 64;
    auto kptr = [&](int kk) -> const bfu* { return kb + (size_t)kk * 1536; };
    const bfu* vtb = (const bfu*)(p.ws + OFF_VT) + (size_t)((1 * 2 + b) * 2 + hk) * 64 * L + j * 256;
    auto vptr = [&](int d, int k8) -> const bfu* { return vtb + (size_t)d * L + k8 * 8; };
    auto maskf = [&](int row, int kk) -> bool { return true; };
    auto outf = [&](int row, int d0, f32x4 o, float m, float l) {
      if (rbase + row < cnt) {
        const size_t idx = (((size_t)b * L + (e >> 4)) * 8 + hk * 4 + ((e >> 2) & 3)) * 4 + (e & 3);
        const float inv = 1.f / l;
        *(uint2*)(PO + idx * 64 + d0) = make_uint2(pack2(o[0] * inv, o[1] * inv), pack2(o[2] * inv, o[3] * inv));
        if (d0 == 0) { PM[idx] = m; PL[idx] = l; }
      }
    };
    attn_core<256, false>(qptr, kptr, vptr, maskf, 0.f, outf, smem);
    if (!hasNext) break;
    it = itn; cur = nxt; e = e2;
#pragma unroll
    for (int q = 0; q < 4; ++q) en[q] = en2[q];
  }
}

DEV void phase_moba_merge(const Params& p) {
  const bfu* PO = (const bfu*)(p.ws + OFF_PO);
  const float* PM = (const float*)(p.ws + OFF_PM);
  const float* PL = (const float*)(p.ws + OFF_PL);
  bfu* Y = (bfu*)(p.ws + OFF_Y);
  const size_t total = (size_t)T * 8 * 8;
  for (size_t id = (size_t)blockIdx.x * 256 + my_tid(); id < total; id += (size_t)gridDim.x * 256) {
    const int ds = (int)(id & 7);
    const size_t th = id >> 3;
    const float4 m4 = *(const float4*)(PM + th * 4);
    const float4 l4 = *(const float4*)(PL + th * 4);
    float mm[4] = {m4.x, m4.y, m4.z, m4.w}, ll[4] = {l4.x, l4.y, l4.z, l4.w};
    float M = mm[0];
#pragma unroll
    for (int s = 1; s < 4; ++s) if (ll[s] > 0.f) M = fmaxf(M, mm[s]);
    float wsum = 0.f;
    float acc[8] = {0.f, 0.f, 0.f, 0.f, 0.f, 0.f, 0.f, 0.f};
#pragma unroll
    for (int s = 0; s < 4; ++s) {
      if (s == 0 || ll[s] > 0.f) {
        const float wgt = ll[s] * __expf(mm[s] - M);
        wsum += wgt;
        uint4 ov = *(const uint4*)(PO + (th * 4 + s) * 64 + ds * 8);
        unsigned uu[4] = {ov.x, ov.y, ov.z, ov.w};
#pragma unroll
        for (int e = 0; e < 4; ++e) {
          acc[2 * e] += wgt * __uint_as_float(uu[e] << 16);
          acc[2 * e + 1] += wgt * __uint_as_float(uu[e] & 0xffff0000u);
        }
      }
    }
    const float inv = 1.f / wsum;
    const size_t t = th >> 3; const int h = (int)(th & 7);
    *(uint4*)(Y + t * 1024 + 512 + h * 64 + ds * 8) =
        make_uint4(pack2(acc[0] * inv, acc[1] * inv), pack2(acc[2] * inv, acc[3] * inv),
                   pack2(acc[4] * inv, acc[5] * inv), pack2(acc[6] * inv, acc[7] * inv));
  }
}


#define XB_TMO      128
#define XB_XCNT(j)  (256  + 64 * (j))
#define XB_XSUB(j)  (1280 + 64 * (j))
#define XB_XGEN(j)  (2304 + 64 * (j))
#define XB_TOP      3328
#define XB_TOPGEN   3392
#define XCD_BAR_WORDS 3456
#define XB_SPIN_CAP (1u << 22)
#define LAS __attribute__((address_space(3)))
DEV unsigned xb_ld(unsigned* p) { return __hip_atomic_load(p, __ATOMIC_RELAXED, __HIP_MEMORY_SCOPE_AGENT); }
DEV unsigned xb_add(unsigned* p, unsigned v) { return __hip_atomic_fetch_add(p, v, __ATOMIC_RELAXED, __HIP_MEMORY_SCOPE_AGENT); }
DEV unsigned xb_xcc_id() { return (unsigned)__builtin_amdgcn_s_getreg((3 << 11) | 20) & 0xFu; }
#define XB_SPIN(cond, bar) do { unsigned _sp = 0; while (cond) { __builtin_amdgcn_s_sleep(1); \
    if ((++_sp & 255u) == 0u) { if (xb_ld(&(bar)[XB_TMO])) break; if (_sp > XB_SPIN_CAP) { atomicAdd(&(bar)[XB_TMO], 1u); break; } } } } while (0)
struct XcdBarrier { unsigned* bar; unsigned x; volatile LAS unsigned* st; };
DEV XcdBarrier xcd_barrier_post(unsigned* bar, volatile LAS unsigned* st) {
  XcdBarrier b; b.bar = bar; b.x = xb_xcc_id(); b.st = st;
  if (threadIdx.x == 0) (void)xb_add(&bar[XB_XCNT(b.x)], 1u);
  return b;
}
DEV void xcd_barrier_complete(unsigned* bar, unsigned x, unsigned& nloc, unsigned& nx) {
  const unsigned G = gridDim.x * gridDim.y * gridDim.z;
  unsigned sum, cnt, mine, sp = 0u;
  for (;;) {
    sum = 0u; cnt = 0u; mine = 0u;
#pragma unroll
    for (unsigned j = 0; j < 16; ++j) { const unsigned c = xb_ld(&bar[XB_XCNT(j)]); sum += c; cnt += (c > 0u) ? 1u : 0u; mine = (j == x) ? c : mine; }
    if (sum == G) break;
    __builtin_amdgcn_s_sleep(1);
    if ((++sp & 255u) == 0u) { if (xb_ld(&bar[XB_TMO])) break; if (sp > XB_SPIN_CAP) { atomicAdd(&bar[XB_TMO], 1u); break; } }
  }
  nloc = mine > 0u ? mine : 1u; nx = cnt > 0u ? cnt : 1u;
}
DEV void xcd_barrier(const XcdBarrier& b) {
  asm volatile("s_waitcnt vmcnt(0)" ::: "memory");
  __syncthreads();
  if (threadIdx.x == 0) {
    unsigned* bar = b.bar;
    __builtin_amdgcn_s_waitcnt(0);
    unsigned nloc = b.st[0], nx = b.st[1];
    if (nloc == 0u) { xcd_barrier_complete(bar, b.x, nloc, nx); b.st[0] = nloc; b.st[1] = nx; }
    const unsigned old = xb_add(&bar[XB_XSUB(b.x)], 1u);
    const unsigned gen = old / nloc;
    if (old + 1u == (gen + 1u) * nloc) {
      __builtin_amdgcn_fence(__ATOMIC_RELEASE, "agent");
      asm volatile("s_waitcnt vmcnt(0)" ::: "memory");
      const unsigned og = xb_add(&bar[XB_TOP], 1u);
      const unsigned tg = og / nx;
      if (og + 1u == (tg + 1u) * nx) xb_add(&bar[XB_TOPGEN], 1u);
      else XB_SPIN(xb_ld(&bar[XB_TOPGEN]) == tg, bar);
      __builtin_amdgcn_fence(__ATOMIC_ACQUIRE, "agent");
      xb_add(&bar[XB_XGEN(b.x)], 1u);
      asm volatile("s_waitcnt vmcnt(0)" ::: "memory");
    } else {
      XB_SPIN(xb_ld(&bar[XB_XGEN(b.x)]) == gen, bar);
      __builtin_amdgcn_fence(__ATOMIC_ACQUIRE, "agent");
      asm volatile("s_waitcnt vmcnt(0)" ::: "memory");
    }
  }
  __syncthreads();
}

__global__ void __launch_bounds__(256, 2) mega(Params p) {
  __shared__ __attribute__((aligned(16))) unsigned char smem[SMEM_BYTES];
  cg::grid_group grid = cg::this_grid();
  unsigned char* ws = p.ws;
  unsigned* barw = (unsigned*)(ws + S_BAR);
  volatile LAS unsigned* xbst = (volatile LAS unsigned*)(smem + SMEM_BYTES - 16);
  if (threadIdx.x == 0) { xbst[0] = 0u; xbst[1] = 0u; }
  if (blockIdx.x == 0) for (int i = threadIdx.x; i < XCD_BAR_WORDS; i += 256) barw[i] = 0u;

#if XSYNC
  for (int i = 0; i < 20; ++i) grid.sync();
#endif
  phase_prep(p, smem);
#if (DUPMASK >> 0) & 1
  grid.sync();
  phase_prep(p, smem);
#endif
  grid.sync();
  XcdBarrier xb = xcd_barrier_post(barw, xbst);
  phase_proj((const bfu*)(ws + OFF_XB), (const bfu*)(ws + OFF_WEVIN), (bfu*)(ws + OFF_P), 2560, (bfu*)p.out, 0, smem);
#if (DUPMASK >> 1) & 1
  GSYNC;
  phase_proj((const bfu*)(ws + OFF_XB), (const bfu*)(ws + OFF_WEVIN), (bfu*)(ws + OFF_P), 2560, (bfu*)p.out, 0, smem);
#endif
  GSYNC;
  for (int it = blockIdx.x; it < 2048; it += gridDim.x) hgrn_dstate_item(p, it, smem);
  {
    uint4 bf[8], cf[4]; float2 ab; float dsk;
    s5_load_consts(p, (blockIdx.x & 7) * 4 + (my_tid() >> 6), my_tid() & 63, bf, cf, ab, dsk);
    for (int it = blockIdx.x; it < 4096; it += gridDim.x) s5_pass1_item(p, it, bf, ab, smem);
  }
#if (DUPMASK >> 2) & 1
  GSYNC;
  for (int it = blockIdx.x; it < 2048; it += gridDim.x) hgrn_dstate_item(p, it, smem);
  {
    uint4 bf[8], cf[4]; float2 ab; float dsk;
    s5_load_consts(p, (blockIdx.x & 7) * 4 + (my_tid() >> 6), my_tid() & 63, bf, cf, ab, dsk);
    for (int it = blockIdx.x; it < 4096; it += gridDim.x) s5_pass1_item(p, it, bf, ab, smem);
  }
#endif
  GSYNC;
  if (blockIdx.x < 64) hgrn_scan_item(p, blockIdx.x);
  else if (blockIdx.x < 80) s5_carry_item(p, blockIdx.x - 64);
#if (DUPMASK >> 3) & 1
  GSYNC;
  if (blockIdx.x < 64) hgrn_scan_item(p, blockIdx.x);
  else if (blockIdx.x < 80) s5_carry_item(p, blockIdx.x - 64);
#endif
  GSYNC;
  for (int it = blockIdx.x; it < 2048; it += gridDim.x) hgrn_out_item(p, it, smem);
  {
    uint4 bf[8], cf[4]; float2 ab; float dsk;
    s5_load_consts(p, (blockIdx.x & 7) * 4 + (my_tid() >> 6), my_tid() & 63, bf, cf, ab, dsk);
    for (int it = blockIdx.x; it < 4096; it += gridDim.x) s5_pass2_item(p, it, bf, cf, ab, dsk, smem);
  }
#if (DUPMASK >> 4) & 1
  GSYNC;
  for (int it = blockIdx.x; it < 2048; it += gridDim.x) hgrn_out_item(p, it, smem);
  {
    uint4 bf[8], cf[4]; float2 ab; float dsk;
    s5_load_consts(p, (blockIdx.x & 7) * 4 + (my_tid() >> 6), my_tid() & 63, bf, cf, ab, dsk);
    for (int it = blockIdx.x; it < 4096; it += gridDim.x) s5_pass2_item(p, it, bf, cf, ab, dsk, smem);
  }
#endif
  GSYNC;
  phase_glu(p, smem);
#if (DUPMASK >> 5) & 1
  GSYNC;
  phase_glu(p, smem);
#endif
  GSYNC;
  phase_outproj(p, (const bfu*)(ws + OFF_WEVOUT), smem);
#if (DUPMASK >> 6) & 1
  GSYNC;
  phase_outproj(p, (const bfu*)(ws + OFF_WEVOUT), smem);
#endif
  GSYNC;
  phase_ln1_router(p, p.x, 0, smem);
#if (DUPMASK >> 7) & 1
  GSYNC;
  if (blockIdx.x == 0 && my_tid() < 24) ((int*)(ws + S_CNT))[my_tid()] = 0;
  GSYNC;
  phase_ln1_router(p, p.x, 0, smem);
#endif
  GSYNC;
  phase_moe1(p, 0, smem);
#if (DUPMASK >> 8) & 1
  GSYNC;
  phase_moe1(p, 0, smem);
#endif
  GSYNC;
  phase_moe2(p, 0, smem);
#if (DUPMASK >> 9) & 1
  GSYNC;
  phase_moe2(p, 0, smem);
#endif
  GSYNC;
  phase_ln2(p, 0, p.out, (bfu*)(ws + OFF_X2B));
#if (DUPMASK >> 10) & 1
  GSYNC;
  phase_ln2(p, 0, p.out, (bfu*)(ws + OFF_X2B));
#endif
  GSYNC;
  phase_proj((const bfu*)(ws + OFF_X2B), (const bfu*)(ws + OFF_WODIN), (bfu*)(ws + OFF_P), 1536, (bfu*)(ws + OFF_VT), 1, smem);
#if (DUPMASK >> 11) & 1
  GSYNC;
  phase_proj((const bfu*)(ws + OFF_X2B), (const bfu*)(ws + OFF_WODIN), (bfu*)(ws + OFF_P), 1536, (bfu*)(ws + OFF_VT), 1, smem);
#endif
  GSYNC;
  for (int it = blockIdx.x; it < 4096 + 256; it += gridDim.x) {
    if (it < 4096) swa_item(p, it, smem); else kmean_item(p, it - 4096, smem);
  }
#if (DUPMASK >> 12) & 1
  GSYNC;
  for (int it = blockIdx.x; it < 4096 + 256; it += gridDim.x) {
    if (it < 4096) swa_item(p, it, smem); else kmean_item(p, it - 4096, smem);
  }
#endif
  GSYNC;
  for (int it = blockIdx.x; it < 4096; it += gridDim.x) moba_own_item(p, it, smem);
#if (DUPMASK >> 13) & 1
  GSYNC;
  if (blockIdx.x == 0) ((int*)(ws + S_CNT))[64 + my_tid()] = 0;
  GSYNC;
  for (int it = blockIdx.x; it < 4096; it += gridDim.x) moba_own_item(p, it, smem);
#endif
  GSYNC;
  phase_moba_bucket(p, smem);
#if (DUPMASK >> 14) & 1
  GSYNC;
  phase_moba_bucket(p, smem);
#endif
  GSYNC;
  phase_moba_merge(p);
#if (DUPMASK >> 15) & 1
  GSYNC;
  phase_moba_merge(p);
#endif
  GSYNC;
  phase_outproj(p, (const bfu*)(ws + OFF_WODOUT), smem);
#if (DUPMASK >> 16) & 1
  GSYNC;
  phase_outproj(p, (const bfu*)(ws + OFF_WODOUT), smem);
#endif
  GSYNC;
  phase_ln1_router(p, p.out, 1, smem);
#if (DUPMASK >> 17) & 1
  GSYNC;
  phase_ln1_router(p, p.out, 1, smem);
#endif
  GSYNC;
  phase_moe1(p, 1, smem);
#if (DUPMASK >> 18) & 1
  GSYNC;
  phase_moe1(p, 1, smem);
#endif
  GSYNC;
  phase_moe2(p, 1, smem);
#if (DUPMASK >> 19) & 1
  GSYNC;
  phase_moe2(p, 1, smem);
#endif
  GSYNC;
  phase_ln2(p, 1, p.out, (bfu*)nullptr);
#if (DUPMASK >> 20) & 1
  GSYNC;
  phase_ln2(p, 1, p.out, (bfu*)nullptr);
#endif
}

extern "C" void kernel_launch(void* const* d_in, const int* in_sizes, int n_in, void* d_out, int out_size, void* d_ws,
                              size_t ws_size, hipStream_t stream) {
  static int grid_blocks = 0;
  if (!grid_blocks) {
    int dev = 0, cus = 0, per_cu = 0;
    hipGetDevice(&dev);
    hipDeviceGetAttribute(&cus, hipDeviceAttributeMultiprocessorCount, dev);
    hipOccupancyMaxActiveBlocksPerMultiprocessor(&per_cu, mega, 256, 0);
    if (per_cu < 1) per_cu = 1;
    if (per_cu > 2) per_cu = 2;
    grid_blocks = (cus * per_cu) & ~7;
    if (ws_size < WS_NEED) fprintf(stderr, "workspace too small: %zu < %zu\n", ws_size, (size_t)WS_NEED);
  }
  Params p{};
  const float** f = (const float**)&p;
  for (int i = 0; i < 27; ++i) f[i] = (const float*)d_in[i];
  p.out = (float*)d_out;
  p.ws = (unsigned char*)d_ws;
  void* args[] = {&p};
  hipError_t e = hipLaunchCooperativeKernel((void*)mega, dim3(grid_blocks), dim3(256), args, 0, stream);
  if (e != hipSuccess) fprintf(stderr, "cooperative launch failed: %s (grid %d)\n", hipGetErrorString(e), grid_blocks);
}
```

```cpp
#ifndef DUPMASK
#define DUPMASK 0
#endif
#ifndef GX
#define GX 0
#endif
#ifndef XSYNC
#define XSYNC 0
#endif
#define GSYNC xcd_barrier(xb)
#include <hip/hip_runtime.h>
#include <hip/hip_cooperative_groups.h>
#include <cstdio>
namespace cg = cooperative_groups;

typedef unsigned short bfu;
typedef __attribute__((ext_vector_type(8))) short bf16x8;
typedef __attribute__((ext_vector_type(4))) float f32x4;
typedef __attribute__((ext_vector_type(2))) float f32x2;

#define DEV __device__ __forceinline__

constexpr int T = 32768, L = 16384;
constexpr float ALPHA = 1.41421356237309515f;
constexpr float NEGF = -1e30f;

constexpr size_t MiB = 1u << 20;
constexpr size_t OFF_WEVIN = 0;
constexpr size_t OFF_WGLU = OFF_WEVIN + 5 * MiB;
constexpr size_t OFF_WEVOUT = OFF_WGLU + 1 * MiB;
constexpr size_t OFF_WODIN = OFF_WEVOUT + 2 * MiB;
constexpr size_t OFF_WODOUT = OFF_WODIN + 3 * MiB;
constexpr size_t OFF_WGU = OFF_WODOUT + 2 * MiB;
constexpr size_t OFF_WDN = OFF_WGU + 32 * MiB;
constexpr size_t OFF_SMALL = OFF_WDN + 16 * MiB;
constexpr size_t OFF_P = OFF_SMALL + 8 * MiB;
constexpr size_t OFF_A = OFF_P + 160 * MiB;
constexpr size_t OFF_X1 = OFF_A + 128 * MiB;
constexpr size_t WS_NEED = OFF_X1 + 128 * MiB;
constexpr size_t S_CNT = OFF_SMALL;
constexpr size_t S_LB = OFF_SMALL + 4096;
constexpr size_t S_ABAR = OFF_SMALL + 8192;
constexpr size_t S_APOW = OFF_SMALL + 24576;
constexpr size_t S_BBAR = OFF_SMALL + 40960;
constexpr size_t S_KMEAN = OFF_SMALL + 303104;
constexpr size_t S_TOKW = OFF_SMALL + 524288;
constexpr size_t S_LIST = OFF_SMALL + 1 * MiB;
constexpr size_t S_BAR = OFF_SMALL + 4 * MiB;
constexpr size_t OFF_BUCK = OFF_P + 96 * MiB;
constexpr size_t OFF_X1B = OFF_P;
constexpr size_t OFF_H = OFF_P + 64 * MiB;
constexpr size_t OFF_X2B = OFF_P + 96 * MiB;
constexpr size_t OFF_XB = OFF_A;
constexpr size_t OFF_DS = OFF_A;
constexpr size_t OFF_SP = OFF_A + 64 * MiB;
constexpr size_t OFF_MIX = OFF_A;
constexpr size_t OFF_PO = OFF_A;
constexpr size_t OFF_YS5 = OFF_X1;
constexpr size_t OFF_Y = OFF_X1 + 32 * MiB;
constexpr size_t OFF_HEND = OFF_X1 + 96 * MiB;
constexpr size_t OFF_CARRY = OFF_X1 + 104 * MiB;
constexpr size_t OFF_DEC = OFF_X1 + 112 * MiB;
constexpr size_t OFF_VT = OFF_X1;
constexpr size_t OFF_PM = OFF_X1 + 96 * MiB;
constexpr size_t OFF_PL = OFF_X1 + 100 * MiB;

constexpr int SMEM_BYTES = 80 * 1024;
constexpr int SM_AUX = 75 * 1024;
constexpr int BUCK_PER_BH = 2016 * 1024;

struct Params {
  const float *x, *lb_logits, *ev_w_in, *ev_a_norm, *a_re, *a_im, *log_dt, *b_re, *b_im, *c_re, *c_im, *s5_d,
      *w_glu, *ev_w_out, *od_w_in, *od_sinks, *od_w_out, *ln1_g, *ln1_b, *w_group, *b_group, *w_expert, *b_expert,
      *w_gate_up, *w_down, *ln2_g, *ln2_b;
  float* out;
  unsigned char* ws;
};

DEV int my_tid() { int t = threadIdx.x; asm volatile("" : "+v"(t)); return t; }
typedef __attribute__((ext_vector_type(2))) __bf16 bf16x2_t;
typedef __attribute__((ext_vector_type(2))) float f32x2c;
DEV bfu f2bf(float f) { __bf16 h = (__bf16)f; return __builtin_bit_cast(bfu, h); }
DEV float bf2f(bfu h) { return __uint_as_float(((unsigned)h) << 16); }
DEV unsigned pack2(float a, float b) { f32x2c v = {a, b}; bf16x2_t r = __builtin_convertvector(v, bf16x2_t); return __builtin_bit_cast(unsigned, r); }
DEV float frcp(float x) { return __builtin_amdgcn_rcpf(x); }
DEV float sigm(float x) { return frcp(1.f + __expf(-x)); }
DEV float siluf(float x) { return x * frcp(1.f + __expf(-x)); }
DEV float gelu_tanh(float x) {
  float u = 1.5957691216057308f * (x + 0.044715f * x * x * x);
  return x * frcp(1.f + __expf(-u));
}
DEV f32x4 mfma16(uint4 a, uint4 b, f32x4 c) {
  return __builtin_amdgcn_mfma_f32_16x16x32_bf16(__builtin_bit_cast(bf16x8, a), __builtin_bit_cast(bf16x8, b), c, 0, 0, 0);
}
DEV uint4 lds128(const bfu* p) { return *(const uint4*)p; }
DEV void wave_lds_sync() {
  __builtin_amdgcn_fence(__ATOMIC_RELEASE, "wavefront");
  __builtin_amdgcn_wave_barrier();
  __builtin_amdgcn_fence(__ATOMIC_ACQUIRE, "wavefront");
}

template <int CTRL> DEV float dpp_f(float v) {
  return __int_as_float(__builtin_amdgcn_update_dpp(0, __float_as_int(v), CTRL, 0xF, 0xF, false));
}
DEV float sum16(float v) {
  v += dpp_f<0xB1>(v);
  v += dpp_f<0x4E>(v);
  v += dpp_f<0x141>(v);
  v += dpp_f<0x140>(v);
  return v;
}
DEV float wave_sum(float v) {
  v = sum16(v);
  const int iv = __float_as_int(v);
  const float s0 = __int_as_float(__builtin_amdgcn_readlane(iv, 0)), s1 = __int_as_float(__builtin_amdgcn_readlane(iv, 16));
  const float s2 = __int_as_float(__builtin_amdgcn_readlane(iv, 32)), s3 = __int_as_float(__builtin_amdgcn_readlane(iv, 48));
  return (s0 + s1) + (s2 + s3);
}
DEV float max16(float v) {
  v = fmaxf(v, __shfl_xor(v, 8)); v = fmaxf(v, __shfl_xor(v, 4));
  v = fmaxf(v, __shfl_xor(v, 2)); v = fmaxf(v, __shfl_xor(v, 1));
  return v;
}
DEV uint4 ld8_f32(const float* p) {
  float4 u = ((const float4*)p)[0], v = ((const float4*)p)[1];
  return make_uint4(pack2(u.x, u.y), pack2(u.z, u.w), pack2(v.x, v.y), pack2(v.z, v.w));
}
DEV uint4 ld8_bf(const bfu* p) { return *(const uint4*)p; }
DEV int perm_half(int c, int half) {
  if (half == 0) return c;
  int hi = c >= half ? 1 : 0;
  int cc = hi ? c - half : c;
  return (cc >> 5) * 64 + hi * 32 + (cc & 31);
}

template <bool SWAP>
DEV void mma_tile(const bfu* As, const bfu* Bs, int wm, int wn, int l15, int lq, f32x4 (&acc)[4][4]) {
#pragma unroll
  for (int ks = 0; ks < 2; ++ks) {
    uint4 af[4], bfr[4];
#pragma unroll
    for (int i = 0; i < 4; ++i) {
      af[i] = lds128(As + (wm * 64 + i * 16 + l15) * 80 + ks * 32 + lq * 8);
      bfr[i] = lds128(Bs + (wn * 64 + i * 16 + l15) * 80 + ks * 32 + lq * 8);
    }
    __builtin_amdgcn_s_setprio(1);
#pragma unroll
    for (int i1 = 0; i1 < 4; ++i1)
#pragma unroll
      for (int i2 = 0; i2 < 4; ++i2)
        acc[i1][i2] = SWAP ? mfma16(bfr[i1], af[i2], acc[i1][i2]) : mfma16(af[i1], bfr[i2], acc[i1][i2]);
    __builtin_amdgcn_s_setprio(0);
    if (ks == 0) __builtin_amdgcn_sched_barrier(0);
  }
}

template <int N> struct IC { static constexpr int v = N; };
template <int I, int N, typename F> DEV void static_for(F&& f) { if constexpr (I < N) { f(IC<I>{}); static_for<I + 1, N>(f); } }

DEV uint4 ld8_at(const bfu* base, unsigned o) { asm volatile("" : "+v"(o)); return ld8_bf(base + o); }
struct RowLoader {
  const bfu* base; unsigned off; unsigned stride32;
  DEV uint4 operator()(int i, int kb, int so) const { return ld8_at(base, off + (unsigned)i * stride32 + (unsigned)kb + (unsigned)so); }
};
struct GatherLoader {
  const bfu* base; unsigned off[4];
  DEV uint4 operator()(int i, int kb, int so) const { return ld8_at(base, off[i] + (unsigned)kb + (unsigned)so); }
};
struct SplitKLoader {
  const bfu* base; unsigned lo; unsigned dhi;
  DEV uint4 operator()(int i, int kb, int so) const {
    const unsigned u = (kb < 256) ? 0u : dhi;
    return ld8_at(base, lo + u + (unsigned)i * 8192u + (unsigned)(kb & 255) + (unsigned)so);
  }
};
struct GemmPipe { uint4 ra[2][4], rb[2][4]; };

template <typename AL, typename BL, typename EP>
DEV void gemm128(bool SWAP, int K, bool first, bool hasNext, const AL& aload, const BL& bload, const AL& aloadN, const BL& bloadN,
                 EP epi, GemmPipe& gp, unsigned char* smem) {
  const int tid = my_tid(), lane = tid & 63, w = tid >> 6, wm = w >> 1, wn = w & 1, l15 = lane & 15, lq = lane >> 4;
  const int seg = tid & 7, r0 = tid >> 3;
  const int nk = K >> 6;
  f32x4 acc[4][4];
#pragma unroll
  for (int mi = 0; mi < 4; ++mi)
#pragma unroll
    for (int ni = 0; ni < 4; ++ni) acc[mi][ni] = f32x4{0.f, 0.f, 0.f, 0.f};
  if (first) {
#pragma unroll
    for (int i = 0; i < 4; ++i) { gp.ra[0][i] = aload(i, 0, seg * 8); gp.rb[0][i] = bload(i, 0, seg * 8); }
#pragma unroll
    for (int i = 0; i < 4; ++i) { gp.ra[1][i] = aload(i, 64, seg * 8); gp.rb[1][i] = bload(i, 64, seg * 8); }
    __syncthreads();
    bfu* As = (bfu*)smem; bfu* Bs = As + 128 * 80;
#pragma unroll
    for (int i = 0; i < 4; ++i) {
      *(uint4*)(As + (r0 + 32 * i) * 80 + seg * 8) = gp.ra[0][i];
      *(uint4*)(Bs + (r0 + 32 * i) * 80 + seg * 8) = gp.rb[0][i];
    }
#pragma unroll
    for (int i = 0; i < 4; ++i) { gp.ra[0][i] = aload(i, 128, seg * 8); gp.rb[0][i] = bload(i, 128, seg * 8); }
  }
  auto body = [&](auto pc, int kt) {
    constexpr int PAR = decltype(pc)::v;
    constexpr int NXT = PAR ^ 1;
    __syncthreads();
    if (kt + 1 < nk || hasNext) {
      bfu* As = (bfu*)(smem + NXT * 40960); bfu* Bs = As + 128 * 80;
#pragma unroll
      for (int i = 0; i < 4; ++i) {
        *(uint4*)(As + (r0 + 32 * i) * 80 + seg * 8) = gp.ra[NXT][i];
        *(uint4*)(Bs + (r0 + 32 * i) * 80 + seg * 8) = gp.rb[NXT][i];
      }
    }
    if (kt + 3 < nk) {
      const int k = (kt + 3) * 64;
#pragma unroll
      for (int i = 0; i < 4; ++i) { gp.ra[NXT][i] = aload(i, k, seg * 8); gp.rb[NXT][i] = bload(i, k, seg * 8); }
    } else if (hasNext) {
      const int k = (kt + 3 - nk) * 64;
#pragma unroll
      for (int i = 0; i < 4; ++i) { gp.ra[NXT][i] = aloadN(i, k, seg * 8); gp.rb[NXT][i] = bloadN(i, k, seg * 8); }
    } else {
      const int k = (nk - 1) * 64;
#pragma unroll
      for (int i = 0; i < 4; ++i) { gp.ra[NXT][i] = aload(i, k, seg * 8); gp.rb[NXT][i] = bload(i, k, seg * 8); }
    }
    const bfu* Ac = (const bfu*)(smem + PAR * 40960);
    mma_tile<true>(Ac, Ac + 128 * 80, wm, wn, l15, lq, acc);
  };
  for (int kt = 0; kt < nk; kt += 2) {
    body(IC<0>{}, kt);
    body(IC<1>{}, kt + 1);
  }
  epi(acc, wm, wn, l15, lq);
}

DEV bool gemm_item(int iter, int MT, int NT, int& mt, int& nt) {
  const int nl = gridDim.x >> 3;
  const int x = blockIdx.x & 7, lw = blockIdx.x >> 3;
  const int mper = MT >> 3;
  const int li = lw + iter * nl;
  if (li >= mper * NT) return false;
  const int per_group = mper * 4;
  const int g = li / per_group, r = li - g * per_group;
  mt = x * mper + (r >> 2);
  nt = g * 4 + (r & 3);
  return true;
}
DEV int xcd_item(int iter, int total, int inner) {
  const int nl = gridDim.x >> 3;
  const int x = blockIdx.x & 7, lw = blockIdx.x >> 3;
  const int outer = total / inner;
  const int chunk = (outer + 7) >> 3;
  const int o0 = x * chunk;
  int o1 = o0 + chunk; if (o1 > outer) o1 = outer;
  const int li = lw + iter * nl;
  if (o0 >= o1 || li >= (o1 - o0) * inner) return -1;
  return o0 * inner + li;
}

DEV void transpose_job(const float* __restrict__ src, bfu* __restrict__ dst, int nmat, int K, int N, int half, bfu* tl) {
  const int tk = K >> 6, tn = N >> 6;
  const int per = tk * tn, total = nmat * per;
  const int tid = my_tid();
  const int c4 = tid & 15, r = tid >> 4;
  int it = blockIdx.x;
  if (it >= total) return;
  auto tile_src = [&](int itx) -> const float* {
    const int m = itx / per, rem = itx - m * per;
    const int kt = rem / tn, nt = rem - kt * tn;
    return src + (size_t)m * K * N + (size_t)(kt * 64) * N + nt * 64;
  };
  float4 nv[4];
  {
    const float* s = tile_src(it);
#pragma unroll
    for (int i = 0; i < 4; ++i) nv[i] = *(const float4*)(s + (size_t)(r + 16 * i) * N + c4 * 4);
  }
  for (; it < total; it += gridDim.x) {
    const int m = it / per, rem = it - m * per;
    const int kt = rem / tn, nt = rem - kt * tn;
    float4 v[4];
#pragma unroll
    for (int i = 0; i < 4; ++i) v[i] = nv[i];
    {
      const float* s = tile_src(it + gridDim.x < total ? it + gridDim.x : it);
#pragma unroll
      for (int i = 0; i < 4; ++i) nv[i] = *(const float4*)(s + (size_t)(r + 16 * i) * N + c4 * 4);
    }
    __syncthreads();
#pragma unroll
    for (int i = 0; i < 4; ++i) {
      tl[(c4 * 4 + 0) * 72 + r + 16 * i] = f2bf(v[i].x);
      tl[(c4 * 4 + 1) * 72 + r + 16 * i] = f2bf(v[i].y);
      tl[(c4 * 4 + 2) * 72 + r + 16 * i] = f2bf(v[i].z);
      tl[(c4 * 4 + 3) * 72 + r + 16 * i] = f2bf(v[i].w);
    }
    __syncthreads();
    bfu* d = dst + (size_t)m * K * N;
#pragma unroll
    for (int i = 0; i < 2; ++i) {
      const int idx = tid + 256 * i, n = idx >> 3, sg = idx & 7;
      const int pn = perm_half(nt * 64 + n, half);
      *(uint4*)(d + (size_t)pn * K + kt * 64 + sg * 8) = *(const uint4*)(tl + n * 72 + sg * 8);
    }
  }
}

DEV void phase_prep(const Params& p, unsigned char* smem) {
  bfu* tl = (bfu*)smem;
  unsigned char* ws = p.ws;
  const int gtid = blockIdx.x * 256 + my_tid();
  if (gtid < 512) ((int*)(ws + S_CNT))[gtid] = 0;
  if (gtid < 512) {
    float l0 = p.lb_logits[gtid], l1 = p.lb_logits[512 + gtid], l2 = p.lb_logits[1024 + gtid];
    float m = fmaxf(l0, fmaxf(l1, l2));
    float e0 = expf(l0 - m), e1 = expf(l1 - m), e2 = expf(l2 - m);
    ((float*)(ws + S_LB))[gtid] = e0 / (e0 + e1 + e2);
  }
  if (gtid < 2048) {
    int g = gtid >> 6;
    float dt = expf(p.log_dt[g]);
    float ar = p.a_re[gtid], ai = p.a_im[gtid];
    float mag = expf(dt * ar);
    float abr = mag * cosf(dt * ai), abi = mag * sinf(dt * ai);
    float den = ar * ar + ai * ai;
    float xr = abr - 1.f, xi = abi;
    float fr = (xr * ar + xi * ai) / den, fi = (xi * ar - xr * ai) / den;
    float* ab = (float*)(ws + S_ABAR);
    ab[gtid * 2] = abr; ab[gtid * 2 + 1] = abi;
    float pr = abr, pi = abi;
#pragma unroll
    for (int i = 0; i < 6; ++i) { float nr = pr * pr - pi * pi, ni = 2.f * pr * pi; pr = nr; pi = ni; }
    float* ap = (float*)(ws + S_APOW);
    ap[gtid * 2] = pr; ap[gtid * 2 + 1] = pi;
    float* bb = (float*)(ws + S_BBAR) + (size_t)gtid * 32;
    for (int m = 0; m < 16; ++m) {
      float br = p.b_re[gtid * 16 + m], bi = p.b_im[gtid * 16 + m];
      bb[m] = fr * br - fi * bi;
      bb[16 + m] = fr * bi + fi * br;
    }
  }
  transpose_job(p.ev_w_in, (bfu*)(ws + OFF_WEVIN), 1, 1024, 2560, 0, tl);
  transpose_job(p.w_glu, (bfu*)(ws + OFF_WGLU), 1, 512, 1024, 512, tl);
  transpose_job(p.ev_w_out, (bfu*)(ws + OFF_WEVOUT), 1, 1024, 1024, 0, tl);
  transpose_job(p.od_w_in, (bfu*)(ws + OFF_WODIN), 1, 1024, 1536, 0, tl);
  transpose_job(p.od_w_out, (bfu*)(ws + OFF_WODOUT), 1, 1024, 1024, 0, tl);
  transpose_job(p.w_gate_up, (bfu*)(ws + OFF_WGU), 32, 1024, 512, 256, tl);
  transpose_job(p.w_down, (bfu*)(ws + OFF_WDN), 32, 256, 1024, 0, tl);
  {
    uint4* xb = (uint4*)(ws + OFF_XB);
    const size_t n8 = (size_t)T * 1024 / 8;
    for (size_t i = (size_t)blockIdx.x * 256 + my_tid(); i < n8; i += (size_t)gridDim.x * 256) xb[i] = ld8_f32(p.x + i * 8);
  }
}

DEV void phase_proj(const bfu* __restrict__ X, const bfu* __restrict__ Wt, bfu* __restrict__ P, int N, bfu* __restrict__ VT, int layer, unsigned char* smem) {
  const int ntn = N >> 7;
  const int total = (T >> 7) * ntn;
  const int r0 = my_tid() >> 3;
  GemmPipe gp;
  bool first = true;
  for (int it = blockIdx.x; it < total; it += gridDim.x) {
    const int mt = it / ntn, nt = it - mt * ntn;
    const int itn = it + gridDim.x;
    const bool hasNext = itn < total;
    const int itq = hasNext ? itn : it;
    const int mtn = itq / ntn, ntq = itq - mtn * ntn;
    const RowLoader al{X, (unsigned)(mt * 128 + r0) * 1024u, 32768u}, bl{Wt, (unsigned)(nt * 128 + r0) * 1024u, 32768u};
    const RowLoader aln{X, (unsigned)(mtn * 128 + r0) * 1024u, 32768u}, bln{Wt, (unsigned)(ntq * 128 + r0) * 1024u, 32768u};
    auto epi = [&](f32x4(&acc)[4][4], int wm, int wn, int l15, int lq) {
#pragma unroll
      for (int ai = 0; ai < 4; ++ai)
#pragma unroll
        for (int bi = 0; bi < 4; ++bi) {
          const int row = mt * 128 + wm * 64 + bi * 16 + l15, col = nt * 128 + wn * 64 + ai * 16 + lq * 4;
          *(uint2*)(P + (size_t)row * N + col) = make_uint2(pack2(acc[ai][bi][0], acc[ai][bi][1]), pack2(acc[ai][bi][2], acc[ai][bi][3]));
        }
    };
    const bool vt_tile = layer == 0 ? (nt >= 8 && nt <= 11) : (nt == 5 || nt == 11);
    auto epi2 = [&](f32x4(&acc)[4][4], int wm, int wn, int l15, int lq) {
      if (vt_tile) {
        bfu* Ct = (bfu*)(smem + 40960);
        __syncthreads();
#pragma unroll
        for (int ai = 0; ai < 4; ++ai)
#pragma unroll
          for (int bi = 0; bi < 4; ++bi)
#pragma unroll
            for (int j = 0; j < 4; ++j)
              Ct[(wn * 64 + ai * 16 + lq * 4 + j) * 136 + wm * 64 + bi * 16 + l15] = f2bf(acc[ai][bi][j]);
        __syncthreads();
        const int which = nt == 11 ? 1 : 0;
        const int m0 = mt * 128;
        const int b = m0 >> 14, t0 = m0 & (L - 1);
        const int tid = my_tid();
#pragma unroll
        for (int i = 0; i < 8; ++i) {
          const int idx = tid + 256 * i, n = idx >> 4, c = idx & 15;
          const size_t vrow = layer == 0 ? (size_t)((b * 4 + (nt - 8)) * 128 + n) : (size_t)(((which * 2 + b) * 2 + (n >> 6)) * 64 + (n & 63));
          *(uint4*)(VT + vrow * L + t0 + c * 8) = *(const uint4*)(Ct + n * 136 + c * 8);
        }
      } else {
        epi(acc, wm, wn, l15, lq);
      }
    };
    gemm128(true, 1024, first, hasNext, al, bl, aln, bln, epi2, gp, smem);
    first = false;
  }
}

DEV void phase_glu(const Params& p, unsigned char* smem) {
  const bfu* A = (const bfu*)(p.ws + OFF_YS5);
  const bfu* Wt = (const bfu*)(p.ws + OFF_WGLU);
  bfu* Y = (bfu*)(p.ws + OFF_Y);
  const int r0 = my_tid() >> 3;
  const int total = (T >> 7) * 8;
  GemmPipe gp;
  bool first = true;
  for (int it = blockIdx.x; it < total; it += gridDim.x) {
    const int mt = it >> 3, nt = it & 7;
    const int itn = it + gridDim.x;
    const bool hasNext = itn < total;
    const int itq = hasNext ? itn : it;
    const RowLoader al{A, (unsigned)(mt * 128 + r0) * 512u, 16384u}, bl{Wt, (unsigned)(nt * 128 + r0) * 512u, 16384u};
    const RowLoader aln{A, (unsigned)((itq >> 3) * 128 + r0) * 512u, 16384u}, bln{Wt, (unsigned)((itq & 7) * 128 + r0) * 512u, 16384u};
    auto epi = [&](f32x4(&acc)[4][4], int wm, int wn, int l15, int lq) {
      const int q = nt * 2 + wn;
#pragma unroll
      for (int ai = 0; ai < 2; ++ai)
#pragma unroll
        for (int bi = 0; bi < 4; ++bi) {
          const int row = mt * 128 + wm * 64 + bi * 16 + l15, col = q * 32 + ai * 16 + lq * 4;
          float o[4];
#pragma unroll
          for (int j = 0; j < 4; ++j) o[j] = acc[ai][bi][j] * sigm(acc[ai + 2][bi][j]);
          *(uint2*)(Y + (size_t)row * 1024 + 512 + col) = make_uint2(pack2(o[0], o[1]), pack2(o[2], o[3]));
        }
    };
    gemm128(true, 512, first, hasNext, al, bl, aln, bln, epi, gp, smem);
    first = false;
  }
}

DEV void phase_outproj(const Params& p, const bfu* __restrict__ Wt, unsigned char* smem) {
  const bfu* A = (const bfu*)(p.ws + OFF_Y);
  bfu* MIX = (bfu*)(p.ws + OFF_MIX);
  const int r0 = my_tid() >> 3;
  const int total = (T >> 7) * 8;
  GemmPipe gp;
  bool first = true;
  for (int it = blockIdx.x; it < total; it += gridDim.x) {
    const int mt = it >> 3, nt = it & 7;
    const int itn = it + gridDim.x;
    const bool hasNext = itn < total;
    const int itq = hasNext ? itn : it;
    const RowLoader al{A, (unsigned)(mt * 128 + r0) * 1024u, 32768u}, bl{Wt, (unsigned)(nt * 128 + r0) * 1024u, 32768u};
    const RowLoader aln{A, (unsigned)((itq >> 3) * 128 + r0) * 1024u, 32768u}, bln{Wt, (unsigned)((itq & 7) * 128 + r0) * 1024u, 32768u};
    auto epi = [&](f32x4(&acc)[4][4], int wm, int wn, int l15, int lq) {
#pragma unroll
      for (int ai = 0; ai < 4; ++ai)
#pragma unroll
        for (int bi = 0; bi < 4; ++bi) {
          const int row = mt * 128 + wm * 64 + bi * 16 + l15, col = nt * 128 + wn * 64 + ai * 16 + lq * 4;
          *(uint2*)(MIX + (size_t)row * 1024 + col) = make_uint2(pack2(acc[ai][bi][0], acc[ai][bi][1]), pack2(acc[ai][bi][2], acc[ai][bi][3]));
        }
    };
    gemm128(true, 1024, first, hasNext, al, bl, aln, bln, epi, gp, smem);
    first = false;
  }
}


DEV void stage_tile64x128(const bfu* __restrict__ src, int ld, bfu* dst, int ls) {
#pragma unroll
  for (int i = 0; i < 4; ++i) {
    const int idx = my_tid() + 256 * i, row = idx >> 4, sg = idx & 15;
    *(uint4*)(dst + row * ls + sg * 8) = *(const uint4*)(src + (size_t)row * ld + sg * 8);
  }
}
DEV void stage_tile64x128_T(const bfu* __restrict__ src, int ld, bfu* dst, int ls) {
#pragma unroll
  for (int i = 0; i < 4; ++i) {
    const int idx = my_tid() + 256 * i, row = idx >> 4, sg = idx & 15;
    uint4 v = *(const uint4*)(src + (size_t)row * ld + sg * 8);
    unsigned uu[4] = {v.x, v.y, v.z, v.w};
#pragma unroll
    for (int e = 0; e < 4; ++e) {
      dst[(sg * 8 + 2 * e) * ls + row] = (bfu)(uu[e] & 0xffffu);
      dst[(sg * 8 + 2 * e + 1) * ls + row] = (bfu)(uu[e] >> 16);
    }
  }
}


DEV void stage_vt(const bfu* __restrict__ vt0, int bh, int tl0, bfu* dst, int ls) {
#pragma unroll
  for (int i = 0; i < 4; ++i) {
    const int idx = my_tid() + 256 * i, v = idx >> 3, c = idx & 7;
    *(uint4*)(dst + v * ls + c * 8) = *(const uint4*)(vt0 + ((size_t)(bh * 128 + v)) * L + tl0 + c * 8);
  }
}

DEV void hgrn_dstate_item(const Params& p, int ch, unsigned char* smem) {
  const int bh = ch >> 8, n = ch & 255, b = bh >> 2, h = bh & 3;
  const size_t t0 = (size_t)b * L + (size_t)n * 64;
  const bfu* P = (const bfu*)(p.ws + OFF_P);
  bfu* As = (bfu*)smem;
  bfu* Bs = As + 128 * 80;
  bfu* Fr = Bs + 128 * 80;
  const int tid = my_tid(), k = tid & 127, half = tid >> 7;
  const float lb = ((const float*)(p.ws + S_LB))[h * 128 + k];
  __syncthreads();
  stage_tile64x128(P + t0 * 2560 + 512 + h * 128, 2560, Fr, 128);
  stage_vt((const bfu*)p.out, bh, n * 64, As, 80);
  __syncthreads();
  float* tot = (float*)(Fr + 64 * 128);
  float fv[32], cum[32];
  float run = 0.f;
#pragma unroll
  for (int i = 0; i < 32; ++i) {
    const float f = lb + (1.f - lb) * sigm(bf2f(Fr[(half * 32 + i) * 128 + k]));
    run += __logf(f);
    fv[i] = f; cum[i] = run;
  }
  tot[half * 128 + k] = run;
  __syncthreads();
  const float t0s = tot[k], t1s = tot[128 + k];
  const float btot = t0s + t1s;
  const float boff = half ? t0s : 0.f;
#pragma unroll
  for (int i = 0; i < 32; ++i) Bs[k * 80 + half * 32 + i] = f2bf((1.f - fv[i]) * __expf(btot - (boff + cum[i])));
  if (half == 0) ((float*)(p.ws + OFF_DEC))[(size_t)ch * 128 + k] = __expf(btot);
  __syncthreads();
  const int lane = tid & 63, w = tid >> 6, wm = w >> 1, wn = w & 1, l15 = lane & 15, lq = lane >> 4;
  f32x4 acc[4][4];
#pragma unroll
  for (int mi = 0; mi < 4; ++mi)
#pragma unroll
    for (int ni = 0; ni < 4; ++ni) acc[mi][ni] = f32x4{0.f, 0.f, 0.f, 0.f};
  mma_tile<true>(As, Bs, wm, wn, l15, lq, acc);
  bfu* DS = (bfu*)(p.ws + OFF_DS) + (size_t)ch * 16384;
#pragma unroll
  for (int ai = 0; ai < 4; ++ai)
#pragma unroll
    for (int bi = 0; bi < 4; ++bi) {
      const int v = wm * 64 + bi * 16 + l15, kk = wn * 64 + ai * 16 + lq * 4;
      *(uint2*)(DS + v * 128 + kk) = make_uint2(pack2(acc[ai][bi][0], acc[ai][bi][1]), pack2(acc[ai][bi][2], acc[ai][bi][3]));
    }
}

DEV void s5_load_bfrag(const Params& p, int g, int l15, int lq, uint4 (&bf)[8]) {
#pragma unroll
  for (int ni = 0; ni < 8; ++ni) {
    bf[ni] = make_uint4(0u, 0u, 0u, 0u);
    if (lq < 2) {
      const int col = ni * 16 + l15, pp = col & 63, part = col >> 6;
      const float* s = (const float*)(p.ws + S_BBAR) + (size_t)(g * 64 + pp) * 32 + part * 16 + lq * 8;
      const float4 u = ((const float4*)s)[0], v = ((const float4*)s)[1];
      bf[ni] = make_uint4(pack2(u.x, u.y), pack2(u.z, u.w), pack2(v.x, v.y), pack2(v.z, v.w));
    }
  }
}
DEV void s5_drive16(const uint4 a, const uint4 (&bf)[8], float* Dr, int l15, int lq) {
#pragma unroll
  for (int ni = 0; ni < 8; ++ni) {
    f32x4 acc = mfma16(a, bf[ni], f32x4{0.f, 0.f, 0.f, 0.f});
#pragma unroll
    for (int j = 0; j < 4; ++j) Dr[(lq * 4 + j) * 132 + ni * 16 + l15] = acc[j];
  }
}

struct S5Const { uint4 bf[8]; uint4 cf[4]; float2 ab; float dsk; };

DEV void s5_pass1_item(const Params& p, int it, const uint4 (&bf)[8], const float2 ab, unsigned char* smem) {
  const int gq = it & 7, bc = it >> 3;
  const size_t t0 = (size_t)(bc >> 8) * L + (size_t)(bc & 255) * 64;
  const int tid = my_tid(), lane = tid & 63, w = tid >> 6, l15 = lane & 15, lq = lane >> 4;
  float* Dr = (float*)smem + w * (16 * 132);
  const int g = gq * 4 + w;
  const int gp = g * 64 + lane;
  const bfu* P = (const bfu*)(p.ws + OFF_P);
  uint4 af[4];
#pragma unroll
  for (int sub = 0; sub < 4; ++sub) {
    af[sub] = make_uint4(0u, 0u, 0u, 0u);
    if (lq < 2) af[sub] = *(const uint4*)(P + (t0 + sub * 16 + l15) * 2560 + 2048 + g * 16 + lq * 8);
  }
  float hr = 0.f, hi = 0.f;
  __syncthreads();
#pragma unroll
  for (int sub = 0; sub < 4; ++sub) {
    wave_lds_sync();
    s5_drive16(af[sub], bf, Dr, l15, lq);
    wave_lds_sync();
#pragma unroll 4
    for (int tt = 0; tt < 16; ++tt) {
      const float dr = Dr[tt * 132 + lane], di = Dr[tt * 132 + 64 + lane];
      const float nr = ab.x * hr - ab.y * hi + dr;
      const float ni = ab.x * hi + ab.y * hr + di;
      hr = nr; hi = ni;
    }
  }
  ((float2*)(p.ws + OFF_HEND))[(size_t)bc * 2048 + gp] = make_float2(hr, hi);
}

DEV void s5_pass2_item(const Params& p, int it, const uint4 (&bf)[8], const uint4 (&cf)[4], const float2 ab, const float dsk, unsigned char* smem) {
  const int gq = it & 7, bc = it >> 3;
  const size_t t0 = (size_t)(bc >> 8) * L + (size_t)(bc & 255) * 64;
  const int tid = my_tid(), lane = tid & 63, w = tid >> 6, l15 = lane & 15, lq = lane >> 4;
  float* Dr = (float*)smem + w * (16 * 132);
  bfu* Hs = (bfu*)(smem + 4 * 16 * 132 * 4) + w * (16 * 144);
  const int g = gq * 4 + w;
  const int gp = g * 64 + lane;
  const bfu* P = (const bfu*)(p.ws + OFF_P);
  uint4 af[4];
#pragma unroll
  for (int sub = 0; sub < 4; ++sub) {
    af[sub] = make_uint4(0u, 0u, 0u, 0u);
    if (lq < 2) af[sub] = *(const uint4*)(P + (t0 + sub * 16 + l15) * 2560 + 2048 + g * 16 + lq * 8);
  }
  float2 hc = ((const float2*)(p.ws + OFF_CARRY))[(size_t)bc * 2048 + gp];
  float hr = hc.x, hi = hc.y;
  bfu* YS = (bfu*)(p.ws + OFF_YS5);
  __syncthreads();
#pragma unroll
  for (int sub = 0; sub < 4; ++sub) {
    float us[4];
#pragma unroll
    for (int j = 0; j < 4; ++j) us[j] = bf2f(P[(t0 + sub * 16 + lq * 4 + j) * 2560 + 2048 + g * 16 + l15]);
    wave_lds_sync();
    s5_drive16(af[sub], bf, Dr, l15, lq);
    wave_lds_sync();
#pragma unroll 4
    for (int tt = 0; tt < 16; ++tt) {
      const float dr = Dr[tt * 132 + lane], di = Dr[tt * 132 + 64 + lane];
      const float nr = ab.x * hr - ab.y * hi + dr;
      const float ni = ab.x * hi + ab.y * hr + di;
      hr = nr; hi = ni;
      Hs[tt * 144 + lane] = f2bf(hr);
      Hs[tt * 144 + 64 + lane] = f2bf(hi);
    }
    wave_lds_sync();
    f32x4 acc = f32x4{0.f, 0.f, 0.f, 0.f};
#pragma unroll
    for (int ks = 0; ks < 4; ++ks) acc = mfma16(lds128(Hs + l15 * 144 + ks * 32 + lq * 8), cf[ks], acc);
#pragma unroll
    for (int j = 0; j < 4; ++j) {
      const int t = sub * 16 + lq * 4 + j;
      const float y = acc[j] + dsk * us[j];
      YS[(t0 + t) * 512 + g * 16 + l15] = f2bf(gelu_tanh(y));
    }
  }
}


DEV void s5_load_consts(const Params& p, int g, int lane, uint4 (&bf)[8], uint4 (&cf)[4], float2& ab, float& dsk) {
  const int l15 = lane & 15, lq = lane >> 4;
  s5_load_bfrag(p, g, l15, lq, bf);
  ab = ((const float2*)(p.ws + S_ABAR))[g * 64 + lane];
#pragma unroll
  for (int ks = 0; ks < 4; ++ks) {
    const float* src = (ks < 2 ? p.c_re : p.c_im) + ((size_t)g * 16 + l15) * 64 + (ks & 1) * 32 + lq * 8;
    float4 u = ((const float4*)src)[0], v = ((const float4*)src)[1];
    float sgn = ks < 2 ? 1.f : -1.f;
    cf[ks] = make_uint4(pack2(sgn * u.x, sgn * u.y), pack2(sgn * u.z, sgn * u.w), pack2(sgn * v.x, sgn * v.y), pack2(sgn * v.z, sgn * v.w));
  }
  dsk = p.s5_d[g * 16 + l15];
}

DEV void hgrn_scan_item(const Params& p, int it) {
  const int bh = it >> 3, vs = it & 7;
  const int tid = my_tid(), v = vs * 16 + (tid >> 4), k8 = tid & 15;
  const bfu* DS = (const bfu*)(p.ws + OFF_DS);
  bfu* SP = (bfu*)(p.ws + OFF_SP);
  const float* DEC = (const float*)(p.ws + OFF_DEC);
  float S[8];
#pragma unroll
  for (int i = 0; i < 8; ++i) S[i] = 0.f;
  uint4 dsr[8];
  float4 dca[8], dcb[8];
  const size_t base0 = ((size_t)(bh * 256) * 128 + v) * 128 + k8 * 8;
  const size_t dbase0 = (size_t)(bh * 256) * 128 + k8 * 8;
#pragma unroll
  for (int s = 0; s < 8; ++s) {
    dsr[s] = *(const uint4*)(DS + base0 + (size_t)s * 16384);
    dca[s] = *(const float4*)(DEC + dbase0 + (size_t)s * 128);
    dcb[s] = *(const float4*)(DEC + dbase0 + (size_t)s * 128 + 4);
  }
  for (int n0 = 0; n0 < 256; n0 += 8) {
#pragma unroll
    for (int s = 0; s < 8; ++s) {
      const int n = n0 + s;
      *(uint4*)(SP + base0 + (size_t)n * 16384) = make_uint4(pack2(S[0], S[1]), pack2(S[2], S[3]), pack2(S[4], S[5]), pack2(S[6], S[7]));
      const uint4 d = dsr[s];
      const float4 a = dca[s], c = dcb[s];
      S[0] = a.x * S[0] + __uint_as_float(d.x << 16); S[1] = a.y * S[1] + __uint_as_float(d.x & 0xffff0000u);
      S[2] = a.z * S[2] + __uint_as_float(d.y << 16); S[3] = a.w * S[3] + __uint_as_float(d.y & 0xffff0000u);
      S[4] = c.x * S[4] + __uint_as_float(d.z << 16); S[5] = c.y * S[5] + __uint_as_float(d.z & 0xffff0000u);
      S[6] = c.z * S[6] + __uint_as_float(d.w << 16); S[7] = c.w * S[7] + __uint_as_float(d.w & 0xffff0000u);
      if (n + 8 < 256) {
        dsr[s] = *(const uint4*)(DS + base0 + (size_t)(n + 8) * 16384);
        dca[s] = *(const float4*)(DEC + dbase0 + (size_t)(n + 8) * 128);
        dcb[s] = *(const float4*)(DEC + dbase0 + (size_t)(n + 8) * 128 + 4);
      }
    }
  }
}

DEV void s5_carry_item(const Params& p, int it) {
  const int id = it * 256 + my_tid();
  const int b = id >> 11, gp = id & 2047;
  const float2 ap = ((const float2*)(p.ws + S_APOW))[gp];
  const float2* HE = (const float2*)(p.ws + OFF_HEND) + (size_t)b * 256 * 2048 + gp;
  float2* CA = (float2*)(p.ws + OFF_CARRY) + (size_t)b * 256 * 2048 + gp;
  float cr = 0.f, ci = 0.f;
  float2 ring[8];
#pragma unroll
  for (int s = 0; s < 8; ++s) ring[s] = HE[(size_t)s * 2048];
  for (int c0 = 0; c0 < 256; c0 += 8) {
#pragma unroll
    for (int s = 0; s < 8; ++s) {
      const int c = c0 + s;
      CA[(size_t)c * 2048] = make_float2(cr, ci);
      float nr = ap.x * cr - ap.y * ci + ring[s].x;
      float ni = ap.x * ci + ap.y * cr + ring[s].y;
      cr = nr; ci = ni;
      if (c + 8 < 256) ring[s] = HE[(size_t)(c + 8) * 2048];
    }
  }
}

DEV void hgrn_out_item(const Params& p, int ch, unsigned char* smem) {
  const int bh = ch >> 8, n = ch & 255, b = bh >> 2, h = bh & 3;
  const size_t t0 = (size_t)b * L + (size_t)n * 64;
  const bfu* P = (const bfu*)(p.ws + OFF_P);
  bfu* Qs = (bfu*)smem;
  bfu* RB = Qs + 64 * 144;
  bfu* Ks = RB;
  bfu* ATT = RB;
  bfu* Vt = RB + 64 * 80;
  bfu* St = RB;
  bfu* Fr = RB + 64 * 144;
  float* tot = (float*)(Fr + 64 * 128);
  bfu* Gs = (bfu*)(smem + 55296);
  const int tid = my_tid(), lane = tid & 63, w = tid >> 6, l15 = lane & 15, lq = lane >> 4;
  uint4 rq0, rq1, rq2, rq3, rf0, rf1, rf2, rf3, rv0, rv1, rv2, rv3, rg0, rg1, rg2, rg3, rs0, rs1, rs2, rs3, rs4, rs5, rs6, rs7;
  {
    const bfu* qsrc = P + t0 * 2560 + h * 128;
    const bfu* vt0 = (const bfu*)p.out;
    const bfu* SPc = (const bfu*)(p.ws + OFF_SP) + (size_t)ch * 16384;
#define HG_LD(i) { const int idx = tid + 256 * i, row = idx >> 4, sg = idx & 15; \
      rq##i = *(const uint4*)(qsrc + (size_t)row * 2560 + sg * 8); \
      rf##i = *(const uint4*)(qsrc + 512 + (size_t)row * 2560 + sg * 8); \
      rg##i = *(const uint4*)(qsrc + 1536 + (size_t)row * 2560 + sg * 8); \
      const int v = idx >> 3, c = idx & 7; \
      rv##i = *(const uint4*)(vt0 + ((size_t)(bh * 128 + v)) * L + n * 64 + c * 8); }
    HG_LD(0) HG_LD(1) HG_LD(2) HG_LD(3)
#undef HG_LD
#define HG_LS(i) { const int idx = tid + 256 * i, v = idx >> 4, sg = idx & 15; rs##i = *(const uint4*)(SPc + v * 128 + sg * 8); }
    HG_LS(0) HG_LS(1) HG_LS(2) HG_LS(3) HG_LS(4) HG_LS(5) HG_LS(6) HG_LS(7)
#undef HG_LS
  }
  float ng[8];
#pragma unroll
  for (int ni = 0; ni < 8; ++ni) ng[ni] = p.ev_a_norm[h * 128 + ni * 16 + l15];
  __syncthreads();
#define HG_ST(i) { const int idx = tid + 256 * i, row = idx >> 4, sg = idx & 15; \
    *(uint4*)(Qs + row * 144 + sg * 8) = rq##i; *(uint4*)(Fr + row * 128 + sg * 8) = rf##i; *(uint4*)(Gs + row * 144 + sg * 8) = rg##i; }
  HG_ST(0) HG_ST(1) HG_ST(2) HG_ST(3)
#undef HG_ST
  __syncthreads();
  {
    const int k = tid & 127, half = tid >> 7;
    const float lb = ((const float*)(p.ws + S_LB))[h * 128 + k];
    float fv[32], cum[32];
    float run = 0.f;
#pragma unroll
    for (int i = 0; i < 32; ++i) {
      const float f = lb + (1.f - lb) * sigm(bf2f(Fr[(half * 32 + i) * 128 + k]));
      run += __logf(f);
      fv[i] = f; cum[i] = run;
    }
    tot[half * 128 + k] = run;
    __syncthreads();
    const float boff = half ? tot[k] : 0.f;
#pragma unroll
    for (int i = 0; i < 32; ++i) {
      const int s = half * 32 + i;
      const float eb = __expf(boff + cum[i]);
      const float q = siluf(bf2f(Qs[s * 144 + k]));
      Qs[s * 144 + k] = f2bf(q * eb);
      Ks[s * 144 + k] = f2bf((1.f - fv[i]) * frcp(eb));
    }
  }
  __syncthreads();
  f32x4 at[4];
#pragma unroll
  for (int ni = 0; ni < 4; ++ni) at[ni] = f32x4{0.f, 0.f, 0.f, 0.f};
#pragma unroll
  for (int ks = 0; ks < 4; ++ks) {
    uint4 a = lds128(Qs + (16 * w + l15) * 144 + ks * 32 + lq * 8);
#pragma unroll
    for (int ni = 0; ni < 4; ++ni) at[ni] = mfma16(a, lds128(Ks + (ni * 16 + l15) * 144 + ks * 32 + lq * 8), at[ni]);
  }
  __syncthreads();
#pragma unroll
  for (int ni = 0; ni < 4; ++ni)
#pragma unroll
    for (int j = 0; j < 4; ++j) {
      int c = 16 * w + lq * 4 + j, s = ni * 16 + l15;
      ATT[c * 80 + s] = f2bf(s <= c ? at[ni][j] : 0.f);
    }
#define HG_SV(i) { const int idx = tid + 256 * i, v = idx >> 3, c = idx & 7; *(uint4*)(Vt + v * 80 + c * 8) = rv##i; }
  HG_SV(0) HG_SV(1) HG_SV(2) HG_SV(3)
#undef HG_SV
  __syncthreads();
  f32x4 o[8];
#pragma unroll
  for (int ni = 0; ni < 8; ++ni) o[ni] = f32x4{0.f, 0.f, 0.f, 0.f};
#pragma unroll
  for (int ks = 0; ks < 2; ++ks) {
    uint4 a = lds128(ATT + (16 * w + l15) * 80 + ks * 32 + lq * 8);
#pragma unroll
    for (int ni = 0; ni < 8; ++ni) o[ni] = mfma16(a, lds128(Vt + (ni * 16 + l15) * 80 + ks * 32 + lq * 8), o[ni]);
  }
  __syncthreads();
#define HG_SS(i) { const int idx = tid + 256 * i, v = idx >> 4, sg = idx & 15; *(uint4*)(St + v * 144 + sg * 8) = rs##i; }
  HG_SS(0) HG_SS(1) HG_SS(2) HG_SS(3) HG_SS(4) HG_SS(5) HG_SS(6) HG_SS(7)
#undef HG_SS
  __syncthreads();
#pragma unroll
  for (int ks = 0; ks < 4; ++ks) {
    uint4 a = lds128(Qs + (16 * w + l15) * 144 + ks * 32 + lq * 8);
#pragma unroll
    for (int ni = 0; ni < 8; ++ni) o[ni] = mfma16(a, lds128(St + (ni * 16 + l15) * 144 + ks * 32 + lq * 8), o[ni]);
  }
#pragma unroll
  for (int j = 0; j < 4; ++j) {
    float ss = 0.f;
#pragma unroll
    for (int ni = 0; ni < 8; ++ni) ss += o[ni][j] * o[ni][j];
    ss = sum16(ss);
    const float rsn = rsqrtf(ss * (1.f / 128.f) + 1e-6f);
    const int c = 16 * w + lq * 4 + j;
#pragma unroll
    for (int ni = 0; ni < 8; ++ni) {
      const int v = ni * 16 + l15;
      const float gate = bf2f(Gs[c * 144 + v]);
      Gs[c * 144 + v] = f2bf(o[ni][j] * rsn * ng[ni] * siluf(gate));
    }
  }
  __syncthreads();
  bfu* Y = (bfu*)(p.ws + OFF_Y);
#pragma unroll
  for (int i = 0; i < 4; ++i) {
    const int idx = tid + 256 * i, row = idx >> 4, sg = idx & 15;
    *(uint4*)(Y + (t0 + row) * 1024 + h * 128 + sg * 8) = *(const uint4*)(Gs + row * 144 + sg * 8);
  }
}

DEV void phase_ln1_router(const Params& p, const float* __restrict__ Xin, int layer, unsigned char* smem) {
  const bfu* MIX = (const bfu*)(p.ws + OFF_MIX);
  float* X1 = (float*)(p.ws + OFF_X1);
  bfu* X1b = (bfu*)(p.ws + OFF_X1B);
  const float* g1 = p.ln1_g + layer * 1024;
  const float* b1 = p.ln1_b + layer * 1024;
  const float* wg = p.w_group + (size_t)layer * 1024 * 4;
  const float* we = p.w_expert + (size_t)layer * 1024 * 16;
  const float* bg = p.b_group + layer * 4;
  const float* be = p.b_expert + layer * 16;
  float* tokw = (float*)(p.ws + S_TOKW);
  int* list = (int*)(p.ws + S_LIST);
  int* gcnt = (int*)(p.ws + S_CNT) + layer * 32;
  float* Wes = (float*)smem;
  int* tokb = (int*)(smem + 65536);
  int* lcnt = tokb + 64;
  int* lbase = lcnt + 32;
  int* lpos = lbase + 32;
  const int tid = my_tid(), lane = tid & 63, w = tid >> 6;
  __syncthreads();
  {
    float4 wv[16];
#pragma unroll
    for (int i = 0; i < 16; ++i) wv[i] = *(const float4*)(we + (size_t)(tid + 256 * i) * 4);
#pragma unroll
    for (int i = 0; i < 16; ++i) {
      const int idx = tid + 256 * i, d = idx >> 2, c4 = idx & 3;
      Wes[(c4 * 4 + 0) * 1024 + d] = wv[i].x; Wes[(c4 * 4 + 1) * 1024 + d] = wv[i].y;
      Wes[(c4 * 4 + 2) * 1024 + d] = wv[i].z; Wes[(c4 * 4 + 3) * 1024 + d] = wv[i].w;
    }
  }
  __syncthreads();
  for (int it = blockIdx.x; it < T / 64; it += gridDim.x) {
    const int tb = it * 64;
    __syncthreads();
    if (tid < 24) lcnt[tid] = 0;
    float4 nxa[4]; uint2 nxm[4];
    {
      const size_t tn = (size_t)tb + w * 16;
#pragma unroll
      for (int i = 0; i < 4; ++i) {
        nxa[i] = *(const float4*)(Xin + tn * 1024 + i * 256 + lane * 4);
        nxm[i] = *(const uint2*)(MIX + tn * 1024 + i * 256 + lane * 4);
      }
    }
    for (int tk = 0; tk < 16; ++tk) {
      const size_t t = (size_t)tb + w * 16 + tk;
      float4 cxa[4]; uint2 cxm[4];
#pragma unroll
      for (int i = 0; i < 4; ++i) { cxa[i] = nxa[i]; cxm[i] = nxm[i]; }
      {
        const size_t tn = (size_t)tb + w * 16 + (tk < 15 ? tk + 1 : 15);
#pragma unroll
        for (int i = 0; i < 4; ++i) {
          nxa[i] = *(const float4*)(Xin + tn * 1024 + i * 256 + lane * 4);
          nxm[i] = *(const uint2*)(MIX + tn * 1024 + i * 256 + lane * 4);
        }
      }
      float xv[16];
      float s = 0.f;
#pragma unroll
      for (int i = 0; i < 4; ++i) {
        const float4 a = cxa[i];
        const float4 m = make_float4(__uint_as_float(cxm[i].x << 16), __uint_as_float(cxm[i].x & 0xffff0000u), __uint_as_float(cxm[i].y << 16), __uint_as_float(cxm[i].y & 0xffff0000u));
        xv[4 * i] = ALPHA * a.x + m.x; xv[4 * i + 1] = ALPHA * a.y + m.y;
        xv[4 * i + 2] = ALPHA * a.z + m.z; xv[4 * i + 3] = ALPHA * a.w + m.w;
        s += xv[4 * i] + xv[4 * i + 1] + xv[4 * i + 2] + xv[4 * i + 3];
      }
      const float mu = wave_sum(s) * (1.f / 1024.f);
      float vs = 0.f;
#pragma unroll
      for (int e = 0; e < 16; ++e) { float d = xv[e] - mu; vs += d * d; }
      const float rstd = rsqrtf(wave_sum(vs) * (1.f / 1024.f) + 1e-5f);
      float acc[20];
#pragma unroll
      for (int c = 0; c < 20; ++c) acc[c] = 0.f;
#pragma unroll
      for (int i = 0; i < 4; ++i) {
        float4 gg = *(const float4*)(g1 + i * 256 + lane * 4);
        float4 bb = *(const float4*)(b1 + i * 256 + lane * 4);
        const float o0 = (xv[4 * i] - mu) * rstd * gg.x + bb.x;
        const float o1 = (xv[4 * i + 1] - mu) * rstd * gg.y + bb.y;
        const float o2 = (xv[4 * i + 2] - mu) * rstd * gg.z + bb.z;
        const float o3 = (xv[4 * i + 3] - mu) * rstd * gg.w + bb.w;
        *(uint2*)(X1b + t * 1024 + i * 256 + lane * 4) = make_uint2(pack2(o0, o1), pack2(o2, o3));
#pragma unroll
        for (int c = 0; c < 16; ++c) {
          float4 wv = *(const float4*)(Wes + c * 1024 + i * 256 + lane * 4);
          acc[4 + c] += o0 * wv.x + o1 * wv.y + o2 * wv.z + o3 * wv.w;
        }
        const float* wgp = wg + (size_t)(i * 256 + lane * 4) * 4;
        float4 q0 = *(const float4*)(wgp), q1 = *(const float4*)(wgp + 4), q2 = *(const float4*)(wgp + 8), q3 = *(const float4*)(wgp + 12);
        acc[0] += o0 * q0.x + o1 * q1.x + o2 * q2.x + o3 * q3.x;
        acc[1] += o0 * q0.y + o1 * q1.y + o2 * q2.y + o3 * q3.y;
        acc[2] += o0 * q0.z + o1 * q1.z + o2 * q2.z + o3 * q3.z;
        acc[3] += o0 * q0.w + o1 * q1.w + o2 * q2.w + o3 * q3.w;
      }
#pragma unroll
      for (int c = 0; c < 20; ++c) acc[c] = wave_sum(acc[c]);
      float lg[4];
#pragma unroll
      for (int c = 0; c < 4; ++c) lg[c] = acc[c] + bg[c];
      int gi = 0; float gm = lg[0];
#pragma unroll
      for (int c = 1; c < 4; ++c) if (lg[c] > gm) { gm = lg[c]; gi = c; }
      float gs = 0.f;
#pragma unroll
      for (int c = 0; c < 4; ++c) gs += __expf(lg[c] - gm);
      const float gtop = 1.f / gs;
      float ev[4] = {0.f, 0.f, 0.f, 0.f};
#pragma unroll
      for (int gg = 0; gg < 4; ++gg)
#pragma unroll
        for (int c = 0; c < 4; ++c) if (gi == gg) ev[c] = acc[4 + gg * 4 + c] + be[gg * 4 + c];
      int i1 = 0; float v1 = ev[0];
#pragma unroll
      for (int c = 1; c < 4; ++c) if (ev[c] > v1) { v1 = ev[c]; i1 = c; }
      int i2 = -1; float v2 = -3e38f;
#pragma unroll
      for (int c = 0; c < 4; ++c) if (c != i1 && ev[c] > v2) { v2 = ev[c]; i2 = c; }
      const float ex = __expf(v2 - v1);
      const float w1 = gtop / (1.f + ex), w2 = gtop * ex / (1.f + ex);
      const int lo = min(i1, i2), hi = max(i1, i2);
      const float wlo = (i1 < i2) ? w1 : w2, whi = (i1 < i2) ? w2 : w1;
      const int pi = (lo == 0) ? (hi - 1) : ((lo == 1) ? (hi + 1) : 5);
      if (lane == 0) {
        const int tl = w * 16 + tk;
        tokb[tl] = gi * 6 + pi;
        tokw[(size_t)(tb + tl) * 2] = wlo;
        tokw[(size_t)(tb + tl) * 2 + 1] = whi;
      }
    }
    __syncthreads();
    int myb = 0;
    if (tid < 64) { myb = tokb[tid]; lpos[tid] = atomicAdd(&lcnt[myb], 1); }
    __syncthreads();
    if (tid < 24) { int c = lcnt[tid]; lbase[tid] = c ? atomicAdd(&gcnt[tid], c) : 0; }
    __syncthreads();
    if (tid < 64) list[(size_t)myb * T + lbase[myb] + lpos[tid]] = tb + tid;
  }
}

struct MoeTile { int bk, r0, cnt, srow0, elo, ehi; };
DEV int moe_total_tiles(const int* gcnt) {
  int tot = 0;
  for (int b = 0; b < 24; ++b) tot += (gcnt[b] + 127) >> 7;
  return tot;
}
DEV MoeTile moe_find(const int* gcnt, int tile) {
  MoeTile r; int acc = 0, srow = 0; r.bk = 0; r.r0 = 0; r.cnt = 0; r.srow0 = 0;
  for (int b = 0; b < 24; ++b) {
    int c = gcnt[b]; int nt = (c + 127) >> 7;
    if (tile >= acc && tile < acc + nt) { r.bk = b; r.r0 = (tile - acc) * 128; r.cnt = c; r.srow0 = srow; }
    acc += nt; srow += c;
  }
  int g = r.bk / 6, pi = r.bk - g * 6;
  int lo = (pi < 3) ? 0 : ((pi < 5) ? 1 : 2);
  int hi = (pi < 3) ? pi + 1 : ((pi < 5) ? pi - 1 : 3);
  r.elo = g * 4 + lo; r.ehi = g * 4 + hi;
  return r;
}

DEV void phase_moe1(const Params& p, int layer, unsigned char* smem) {
  const int* gcnt = (const int*)(p.ws + S_CNT) + layer * 32;
  const int* list = (const int*)(p.ws + S_LIST);
  const float* tokw = (const float*)(p.ws + S_TOKW);
  const bfu* X1b = (const bfu*)(p.ws + OFF_X1B);
  const bfu* Wgu = (const bfu*)(p.ws + OFF_WGU) + (size_t)layer * 16 * 512 * 1024;
  bfu* H = (bfu*)(p.ws + OFF_H);
  const int total = moe_total_tiles(gcnt) * 8;
  const int r0 = my_tid() >> 3;
  auto mkA = [&](const MoeTile& mt) {
    GatherLoader g;
    g.base = X1b;
#pragma unroll
    for (int i = 0; i < 4; ++i) {
      const int r = mt.r0 + r0 + 32 * i;
      const int tok = list[(size_t)mt.bk * T + (r < mt.cnt ? r : 0)];
      g.off[i] = (unsigned)tok * 1024u;
    }
    return g;
  };
  auto mkB = [&](const MoeTile& mt, int nt) {
    const int ex = (nt < 4) ? mt.elo : mt.ehi;
    return RowLoader{Wgu, (unsigned)(ex * 512 + (nt & 3) * 128 + r0) * 1024u, 32768u};
  };
  GemmPipe gp;
  bool first = true;
  int it = blockIdx.x;
  if (it >= total) return;
  MoeTile mt = moe_find(gcnt, it >> 3);
  GatherLoader al = mkA(mt);
  RowLoader bl = mkB(mt, it & 7);
  for (;;) {
    const int nt = it & 7;
    const int itn = it + gridDim.x;
    const bool hasNext = itn < total;
    const int itq = hasNext ? itn : it;
    const MoeTile mtn = moe_find(gcnt, itq >> 3);
    const GatherLoader aln = mkA(mtn);
    const RowLoader bln = mkB(mtn, itq & 7);
    auto epi = [&](f32x4(&acc)[4][4], int wm, int wn, int l15, int lq) {
      const int q = (nt & 3) * 2 + wn;
#pragma unroll
      for (int bi = 0; bi < 4; ++bi) {
        const int r = mt.r0 + wm * 64 + bi * 16 + l15;
        if (r < mt.cnt) {
          const int tok = list[(size_t)mt.bk * T + r];
          const float gw = tokw[(size_t)tok * 2 + (nt >> 2)];
#pragma unroll
          for (int ai = 0; ai < 2; ++ai) {
            float o[4];
#pragma unroll
            for (int j = 0; j < 4; ++j) o[j] = siluf(acc[ai][bi][j]) * acc[ai + 2][bi][j] * gw;
            *(uint2*)(H + (size_t)(mt.srow0 + r) * 512 + (nt >> 2) * 256 + q * 32 + ai * 16 + lq * 4) =
                make_uint2(pack2(o[0], o[1]), pack2(o[2], o[3]));
          }
        }
      }
    };
    gemm128(true, 1024, first, hasNext, al, bl, aln, bln, epi, gp, smem);
    first = false;
    if (!hasNext) break;
    it = itn; mt = mtn; al = aln; bl = bln;
  }
}

DEV void phase_moe2(const Params& p, int layer, unsigned char* smem) {
  const int* gcnt = (const int*)(p.ws + S_CNT) + layer * 32;
  const int* list = (const int*)(p.ws + S_LIST);
  const bfu* H = (const bfu*)(p.ws + OFF_H);
  const bfu* Wdn = (const bfu*)(p.ws + OFF_WDN) + (size_t)layer * 16 * 1024 * 256;
  bfu* FF = (bfu*)(p.ws + OFF_MIX);
  const int total = moe_total_tiles(gcnt) * 8;
  const int r0 = my_tid() >> 3;
  auto mkA = [&](const MoeTile& mt) { return RowLoader{H, (unsigned)(mt.srow0 + mt.r0 + r0) * 512u, 16384u}; };
  auto mkB = [&](const MoeTile& mt, int nt) {
    return SplitKLoader{Wdn, (unsigned)(mt.elo * 1024 + nt * 128 + r0) * 256u, (unsigned)((mt.ehi - mt.elo) * 1024) * 256u};
  };
  GemmPipe gp;
  bool first = true;
  int it = blockIdx.x;
  if (it >= total) return;
  MoeTile mt = moe_find(gcnt, it >> 3);
  RowLoader al = mkA(mt);
  SplitKLoader bl = mkB(mt, it & 7);
  for (;;) {
    const int nt = it & 7;
    const int itn = it + gridDim.x;
    const bool hasNext = itn < total;
    const int itq = hasNext ? itn : it;
    const MoeTile mtn = moe_find(gcnt, itq >> 3);
    const RowLoader aln = mkA(mtn);
    const SplitKLoader bln = mkB(mtn, itq & 7);
    auto epi = [&](f32x4(&acc)[4][4], int wm, int wn, int l15, int lq) {
#pragma unroll
      for (int bi = 0; bi < 4; ++bi) {
        const int r = mt.r0 + wm * 64 + bi * 16 + l15;
        if (r < mt.cnt) {
          const int tok = list[(size_t)mt.bk * T + r];
#pragma unroll
          for (int ai = 0; ai < 4; ++ai)
            *(uint2*)(FF + (size_t)tok * 1024 + nt * 128 + wn * 64 + ai * 16 + lq * 4) =
                make_uint2(pack2(acc[ai][bi][0], acc[ai][bi][1]), pack2(acc[ai][bi][2], acc[ai][bi][3]));
        }
      }
    };
    gemm128(true, 512, first, hasNext, al, bl, aln, bln, epi, gp, smem);
    first = false;
    if (!hasNext) break;
    it = itn; mt = mtn; al = aln; bl = bln;
  }
}

DEV void phase_ln2(const Params& p, int layer, float* __restrict__ outp, bfu* __restrict__ outb) {
  const bfu* X1b = (const bfu*)(p.ws + OFF_X1B);
  const bfu* FF = (const bfu*)(p.ws + OFF_MIX);
  const float* g2 = p.ln2_g + layer * 1024;
  const float* b2 = p.ln2_b + layer * 1024;
  const int lane = my_tid() & 63, w = my_tid() >> 6;
  const int stride = gridDim.x * 4;
  int t = blockIdx.x * 4 + w;
  if (t >= T) return;
  uint2 nxa[4]; uint2 nxm[4];
#pragma unroll
  for (int i = 0; i < 4; ++i) {
    nxa[i] = *(const uint2*)(X1b + (size_t)t * 1024 + i * 256 + lane * 4);
    nxm[i] = *(const uint2*)(FF + (size_t)t * 1024 + i * 256 + lane * 4);
  }
  for (; t < T; t += stride) {
    uint2 cxa[4]; uint2 cxm[4];
#pragma unroll
    for (int i = 0; i < 4; ++i) { cxa[i] = nxa[i]; cxm[i] = nxm[i]; }
    {
      const int tn = (t + stride < T) ? t + stride : t;
#pragma unroll
      for (int i = 0; i < 4; ++i) {
        nxa[i] = *(const uint2*)(X1b + (size_t)tn * 1024 + i * 256 + lane * 4);
        nxm[i] = *(const uint2*)(FF + (size_t)tn * 1024 + i * 256 + lane * 4);
      }
    }
    float xv[16];
    float s = 0.f;
#pragma unroll
    for (int i = 0; i < 4; ++i) {
      const uint2 ab_ = cxa[i];
      const float4 a = make_float4(__uint_as_float(ab_.x << 16), __uint_as_float(ab_.x & 0xffff0000u), __uint_as_float(ab_.y << 16), __uint_as_float(ab_.y & 0xffff0000u));
      const uint2 mb = cxm[i];
      const float4 m = make_float4(__uint_as_float(mb.x << 16), __uint_as_float(mb.x & 0xffff0000u), __uint_as_float(mb.y << 16), __uint_as_float(mb.y & 0xffff0000u));
      xv[4 * i] = ALPHA * a.x + m.x; xv[4 * i + 1] = ALPHA * a.y + m.y;
      xv[4 * i + 2] = ALPHA * a.z + m.z; xv[4 * i + 3] = ALPHA * a.w + m.w;
      s += xv[4 * i] + xv[4 * i + 1] + xv[4 * i + 2] + xv[4 * i + 3];
    }
    const float mu = wave_sum(s) * (1.f / 1024.f);
    float vs = 0.f;
#pragma unroll
    for (int e = 0; e < 16; ++e) { float d = xv[e] - mu; vs += d * d; }
    const float rstd = rsqrtf(wave_sum(vs) * (1.f / 1024.f) + 1e-5f);
#pragma unroll
    for (int i = 0; i < 4; ++i) {
      float4 gg = *(const float4*)(g2 + i * 256 + lane * 4);
      float4 bb = *(const float4*)(b2 + i * 256 + lane * 4);
      const float o0 = (xv[4 * i] - mu) * rstd * gg.x + bb.x, o1 = (xv[4 * i + 1] - mu) * rstd * gg.y + bb.y;
      const float o2 = (xv[4 * i + 2] - mu) * rstd * gg.z + bb.z, o3 = (xv[4 * i + 3] - mu) * rstd * gg.w + bb.w;
      *(float4*)(outp + (size_t)t * 1024 + i * 256 + lane * 4) = make_float4(o0, o1, o2, o3);
      if (outb) *(uint2*)(outb + (size_t)t * 1024 + i * 256 + lane * 4) = make_uint2(pack2(o0, o1), pack2(o2, o3));
    }
  }
}

template <int NK, bool SINK, typename KP, typename VP, typename MK, typename OUT>
DEV void attn_core(const bfu* qptr, KP kptr, VP vptr, MK maskf, float sink, OUT outf, unsigned char* smem) {
  constexpr int NT = NK / 16;
  constexpr int VS = NK + 16;
  constexpr int KS = 80;
  bfu* Ks = (bfu*)smem;
  bfu* Ps = Ks;
  bfu* Vt = Ks + NK * KS;
  const int tid = my_tid(), lane = tid & 63, w = tid >> 6, l15 = lane & 15, lq = lane >> 4;
  uint4 k0, k1, k2, k3, k4, k5, k6, k7, v0, v1, v2, v3, v4, v5, v6, v7;
#define ATT_LD(i) if constexpr (i < NK / 32) { const int idx = tid + 256 * i; const int kk = idx >> 3, sg = idx & 7; \
    k##i = *(const uint4*)(kptr(kk) + sg * 8); const int d = idx / (NK / 8), k8 = idx - d * (NK / 8); v##i = *(const uint4*)(vptr(d, k8)); }
  ATT_LD(0) ATT_LD(1) ATT_LD(2) ATT_LD(3) ATT_LD(4) ATT_LD(5) ATT_LD(6) ATT_LD(7)
#undef ATT_LD
  const uint4 qf0 = *(const uint4*)(qptr + lq * 8), qf1 = *(const uint4*)(qptr + 32 + lq * 8);
  __syncthreads();
#define ATT_ST(i) if constexpr (i < NK / 32) { const int idx = tid + 256 * i; const int kk = idx >> 3, sg = idx & 7; \
    *(uint4*)(Ks + kk * KS + sg * 8) = k##i; const int d = idx / (NK / 8), k8 = idx - d * (NK / 8); *(uint4*)(Vt + d * VS + k8 * 8) = v##i; }
  ATT_ST(0) ATT_ST(1) ATT_ST(2) ATT_ST(3) ATT_ST(4) ATT_ST(5) ATT_ST(6) ATT_ST(7)
#undef ATT_ST
  __syncthreads();
  f32x4 s[NT];
#pragma unroll
  for (int ni = 0; ni < NT; ++ni) {
    f32x4 a = f32x4{0.f, 0.f, 0.f, 0.f};
    a = mfma16(lds128(Ks + (ni * 16 + l15) * KS + lq * 8), qf0, a);
    a = mfma16(lds128(Ks + (ni * 16 + l15) * KS + 32 + lq * 8), qf1, a);
    s[ni] = a;
  }
  const int row = 16 * w + l15;
  float mx = NEGF;
#pragma unroll
  for (int ni = 0; ni < NT; ++ni)
#pragma unroll
    for (int j = 0; j < 4; ++j) {
      const int kk = ni * 16 + lq * 4 + j;
      float v = maskf(row, kk) ? s[ni][j] * (0.125f * 1.4426950408889634f) : NEGF;
      s[ni][j] = v;
      mx = fmaxf(mx, v);
    }
  mx = fmaxf(mx, __shfl_xor(mx, 16));
  mx = fmaxf(mx, __shfl_xor(mx, 32));
  const float sink2 = sink * 1.4426950408889634f;
  if (SINK) mx = fmaxf(mx, sink2);
  float ls = 0.f;
#pragma unroll
  for (int ni = 0; ni < NT; ++ni)
#pragma unroll
    for (int j = 0; j < 4; ++j) {
      float pv = __builtin_amdgcn_exp2f(s[ni][j] - mx);
      ls += pv;
      s[ni][j] = pv;
    }
  ls += __shfl_xor(ls, 16);
  ls += __shfl_xor(ls, 32);
  if (SINK) ls += __builtin_amdgcn_exp2f(sink2 - mx);
  __syncthreads();
#pragma unroll
  for (int ni = 0; ni < NT; ++ni)
    *(uint2*)(Ps + row * VS + ni * 16 + lq * 4) = make_uint2(pack2(s[ni][0], s[ni][1]), pack2(s[ni][2], s[ni][3]));
  wave_lds_sync();
  f32x4 o[4];
#pragma unroll
  for (int ni = 0; ni < 4; ++ni) o[ni] = f32x4{0.f, 0.f, 0.f, 0.f};
#pragma unroll
  for (int ks = 0; ks < NK / 32; ++ks) {
    uint4 pb = lds128(Ps + row * VS + ks * 32 + lq * 8);
#pragma unroll
    for (int ni = 0; ni < 4; ++ni) o[ni] = mfma16(lds128(Vt + (ni * 16 + l15) * VS + ks * 32 + lq * 8), pb, o[ni]);
  }
  const float mnat = mx * 0.6931471805599453f;
#pragma unroll
  for (int ni = 0; ni < 4; ++ni) outf(row, ni * 16 + lq * 4, o[ni], mnat, ls);
}

DEV void swa_item(const Params& p, int it, unsigned char* smem) {
  const int h = it & 7, qt = (it >> 3) & 255, b = it >> 11;
  const int hk = h >> 2;
  const int t0 = qt * 64, kstart = t0 - 128;
  const bfu* P = (const bfu*)(p.ws + OFF_P);
  bfu* Y = (bfu*)(p.ws + OFF_Y);
  const int lane = my_tid() & 63, w = my_tid() >> 6, l15 = lane & 15;
  const bfu* qptr = P + ((size_t)b * L + t0 + 16 * w + l15) * 1536 + h * 64;
  const bfu* kb = P + (size_t)b * L * 1536 + 512 + hk * 64;
  auto kptr = [&](int kk) -> const bfu* { int pos = kstart + kk; pos = pos < 0 ? 0 : pos; return kb + (size_t)pos * 1536; };
  const bfu* vtb = (const bfu*)(p.ws + OFF_VT) + (size_t)((0 * 2 + b) * 2 + hk) * 64 * L;
  auto vptr = [&](int d, int k8) -> const bfu* { int pos = kstart + k8 * 8; pos = pos < 0 ? 0 : pos; return vtb + (size_t)d * L + pos; };
  auto maskf = [&](int row, int kk) -> bool { int pos = kstart + kk, t = t0 + row; return pos >= 0 && pos <= t && (t - pos) < 128; };
  auto outf = [&](int row, int d0, f32x4 o, float m, float l) {
    const float inv = 1.f / l;
    *(uint2*)(Y + ((size_t)b * L + t0 + row) * 1024 + h * 64 + d0) = make_uint2(pack2(o[0] * inv, o[1] * inv), pack2(o[2] * inv, o[3] * inv));
  };
  attn_core<192, true>(qptr, kptr, vptr, maskf, p.od_sinks[h], outf, smem);
}

DEV void kmean_item(const Params& p, int it, unsigned char* smem) {
  const int j = it & 63, bhk = it >> 6, b = bhk >> 1, hk = bhk & 1;
  const bfu* P = (const bfu*)(p.ws + OFF_P);
  float* red = (float*)smem;
  const int tid = my_tid(), d = tid & 63, part = tid >> 6;
  const bfu* kb = P + ((size_t)b * L + j * 256 + part * 64) * 1536 + 1280 + hk * 64 + d;
  float s = 0.f;
  for (int i = 0; i < 64; ++i) s += bf2f(kb[(size_t)i * 1536]);
  __syncthreads();
  red[part * 64 + d] = s;
  __syncthreads();
  if (tid < 64) {
    float tot = red[tid] + red[64 + tid] + red[128 + tid] + red[192 + tid];
    ((bfu*)(p.ws + S_KMEAN))[(size_t)it * 64 + tid] = f2bf(tot * (1.f / 256.f));
  }
}

DEV int cap_off(int j) { return 1024 * (63 * j - (j * (j - 1)) / 2); }

DEV void moba_own_item(const Params& p, int it, unsigned char* smem) {
  const int h = it & 7, o4 = (it >> 3) & 3, c = (it >> 5) & 63, b = it >> 11;
  const int hk = h >> 2, g = h & 3;
  const int t0 = c * 256 + o4 * 64;
  const bfu* P = (const bfu*)(p.ws + OFF_P);
  bfu* PO = (bfu*)(p.ws + OFF_PO);
  float* PM = (float*)(p.ws + OFF_PM);
  float* PL = (float*)(p.ws + OFF_PL);
  const int tid = my_tid(), lane = tid & 63, w = tid >> 6, l15 = lane & 15, lq = lane >> 4;
  const bfu* qptr = P + ((size_t)b * L + t0 + 16 * w + l15) * 1536 + 768 + h * 64;
  const bfu* kb = P + ((size_t)b * L + c * 256) * 1536 + 1280 + hk * 64;
  auto kptr = [&](int kk) -> const bfu* { return kb + (size_t)kk * 1536; };
  const bfu* vtb = (const bfu*)(p.ws + OFF_VT) + (size_t)((1 * 2 + b) * 2 + hk) * 64 * L + c * 256;
  auto vptr = [&](int d, int k8) -> const bfu* { return vtb + (size_t)d * L + k8 * 8; };
  auto maskf = [&](int row, int kk) -> bool { return kk <= o4 * 64 + row; };
  auto outf = [&](int row, int d0, f32x4 o, float m, float l) {
    const size_t idx = (((size_t)b * L + t0 + row) * 8 + h) * 4;
    const float inv = 1.f / l;
    *(uint2*)(PO + idx * 64 + d0) = make_uint2(pack2(o[0] * inv, o[1] * inv), pack2(o[2] * inv, o[3] * inv));
    if (d0 == 0) { PM[idx] = m; PL[idx] = l; }
  };
  attn_core<256, false>(qptr, kptr, vptr, maskf, 0.f, outf, smem);
  int* lcnt = (int*)(smem + SM_AUX);
  int* lbase = lcnt + 64;
  int* sel = lbase + 64;
  if (tid < 64) lcnt[tid] = 0;
  __syncthreads();
  const uint4 qf0 = *(const uint4*)(qptr + lq * 8), qf1 = *(const uint4*)(qptr + 32 + lq * 8);
  const bfu* km = (const bfu*)(p.ws + S_KMEAN) + (size_t)(b * 2 + hk) * 64 * 64;
  float cand[4][4];
#pragma unroll
  for (int ni = 0; ni < 4; ++ni) {
    f32x4 a = f32x4{0.f, 0.f, 0.f, 0.f};
    a = mfma16(qf0, *(const uint4*)(km + (ni * 16 + l15) * 64 + lq * 8), a);
    a = mfma16(qf1, *(const uint4*)(km + (ni * 16 + l15) * 64 + 32 + lq * 8), a);
#pragma unroll
    for (int j = 0; j < 4; ++j) cand[ni][j] = (ni * 16 + l15 < c) ? a[j] : -3e38f;
  }
#pragma unroll
  for (int j = 0; j < 4; ++j) {
    const int row = 16 * w + lq * 4 + j;
#pragma unroll
    for (int sl = 0; sl < 3; ++sl) {
      float bv = cand[0][j]; int bi = l15;
#pragma unroll
      for (int ni = 1; ni < 4; ++ni) if (cand[ni][j] > bv) { bv = cand[ni][j]; bi = ni * 16 + l15; }
#pragma unroll
      for (int off = 8; off >= 1; off >>= 1) {
        float ov = __shfl_xor(bv, off); int oi = __shfl_xor(bi, off);
        if (ov > bv || (ov == bv && oi < bi)) { bv = ov; bi = oi; }
      }
      const bool valid = bv > -1e38f;
#pragma unroll
      for (int ni = 0; ni < 4; ++ni) if (ni * 16 + l15 == bi) cand[ni][j] = -3e38f;
      if (l15 == 0) {
        const size_t idx = (((size_t)b * L + t0 + row) * 8 + h) * 4 + 1 + sl;
        if (valid) {
          int lp = atomicAdd(&lcnt[bi], 1);
          sel[row * 3 + sl] = bi | (lp << 8);
        } else {
          sel[row * 3 + sl] = -1;
          PM[idx] = NEGF; PL[idx] = 0.f;
        }
      }
    }
  }
  __syncthreads();
  int* gcnt = (int*)(p.ws + S_CNT) + 64 + (b * 2 + hk) * 64;
  if (tid < 64) { int cc = lcnt[tid]; lbase[tid] = cc ? atomicAdd(&gcnt[tid], cc) : 0; }
  __syncthreads();
  if (tid < 192) {
    const int row = tid / 3, sl = tid - row * 3;
    const int sv = sel[tid];
    if (sv >= 0) {
      const int bi = sv & 255, lp = sv >> 8;
      int* bucket = (int*)(p.ws + OFF_BUCK) + (size_t)(b * 2 + hk) * BUCK_PER_BH + cap_off(bi);
      bucket[lbase[bi] + lp] = ((t0 + row) << 4) | (g << 2) | (sl + 1);
    }
  }
}

DEV void phase_moba_bucket(const Params& p, unsigned char* smem) {
  int* pref = (int*)(smem + SM_AUX);
  const int* gcnt = (const int*)(p.ws + S_CNT) + 64;
  const int tid = my_tid(), lane = tid & 63, w = tid >> 6, l15 = lane & 15;
  {
    int nt = (gcnt[tid] + 63) >> 6;
    __syncthreads();
    pref[tid] = nt;
    __syncthreads();
    for (int off = 1; off < 256; off <<= 1) {
      int v = pref[tid];
      if (tid >= off) v += pref[tid - off];
      __syncthreads();
      pref[tid] = v;
      __syncthreads();
    }
  }
  const int total = pref[255];
  const bfu* P = (const bfu*)(p.ws + OFF_P);
  bfu* PO = (bfu*)(p.ws + OFF_PO);
  float* PM = (float*)(p.ws + OFF_PM);
  float* PL = (float*)(p.ws + OFF_PL);
  const int lq = lane >> 4;
  struct Item { int bk, cnt, rbase; };
  auto decode = [&](int it) -> Item {
    int lo = 0, hi = 255;
    while (lo < hi) { int mid = (lo + hi) >> 1; if (pref[mid] > it) hi = mid; else lo = mid + 1; }
    Item r; r.bk = lo; r.cnt = gcnt[lo];
    const int ntb = (r.cnt + 63) >> 6;
    r.rbase = (it - (pref[lo] - ntb)) * 64;
    return r;
  };
  auto bucket_of = [&](int bk) -> const int* {
    return (const int*)(p.ws + OFF_BUCK) + (size_t)(bk >> 6) * BUCK_PER_BH + cap_off(bk & 63);
  };
  auto load_entries = [&](const Item& im, int& e, int (&en)[4]) {
    const int* bucket = bucket_of(im.bk);
    const int rr = im.rbase + 16 * w + l15;
    e = bucket[rr < im.cnt ? rr : 0];
#pragma unroll
    for (int j = 0; j < 4; ++j) { const int r = im.rbase + 16 * w + lq * 4 + j; en[j] = bucket[r < im.cnt ? r : 0]; }
  };
  int it = blockIdx.x;
  if (it >= total) return;
  Item cur = decode(it);
  int e, en[4];
  load_entries(cur, e, en);
  for (;;) {
    const int itn = it + gridDim.x;
    const bool hasNext = itn < total;
    Item nxt = cur; int e2 = e, en2[4] = {en[0], en[1], en[2], en[3]};
    if (hasNext) { nxt = decode(itn); load_entries(nxt, e2, en2); }
    const int bk = cur.bk, cnt = cur.cnt, rbase = cur.rbase;
    const int j = bk & 63, bhk = bk >> 6, b = bhk >> 1, hk = bhk & 1;
    const bfu* qptr = P + ((size_t)b * L + (e >> 4)) * 1536 + 768 + (hk * 4 + ((e >> 2) & 3)) * 64;
    const bfu* kb = P + ((size_t)b * L + j * 256) * 1536 + 1280 + hk * 64;
    auto kptr = [&](int kk) -> const bfu* { return kb + (size_t)kk * 1536; };
    const bfu* vtb = (const bfu*)(p.ws + OFF_VT) + (size_t)((1 * 2 + b) * 2 + hk) * 64 * L + j * 256;
    auto vptr = [&](int d, int k8) -> const bfu* { return vtb + (size_t)d * L + k8 * 8; };
    auto maskf = [&](int row, int kk) -> bool { return true; };
    auto outf = [&](int row, int d0, f32x4 o, float m, float l) {
      if (rbase + row < cnt) {
        const size_t idx = (((size_t)b * L + (e >> 4)) * 8 + hk * 4 + ((e >> 2) & 3)) * 4 + (e & 3);
        const float inv = 1.f / l;
        *(uint2*)(PO + idx * 64 + d0) = make_uint2(pack2(o[0] * inv, o[1] * inv), pack2(o[2] * inv, o[3] * inv));
        if (d0 == 0) { PM[idx] = m; PL[idx] = l; }
      }
    };
    attn_core<256, false>(qptr, kptr, vptr, maskf, 0.f, outf, smem);
    if (!hasNext) break;
    it = itn; cur = nxt; e = e2;
#pragma unroll
    for (int q = 0; q < 4; ++q) en[q] = en2[q];
  }
}

DEV void phase_moba_merge(const Params& p) {
  const bfu* PO = (const bfu*)(p.ws + OFF_PO);
  const float* PM = (const float*)(p.ws + OFF_PM);
  const float* PL = (const float*)(p.ws + OFF_PL);
  bfu* Y = (bfu*)(p.ws + OFF_Y);
  const size_t total = (size_t)T * 8 * 8;
  for (size_t id = (size_t)blockIdx.x * 256 + my_tid(); id < total; id += (size_t)gridDim.x * 256) {
    const int ds = (int)(id & 7);
    const size_t th = id >> 3;
    const float4 m4 = *(const float4*)(PM + th * 4);
    const float4 l4 = *(const float4*)(PL + th * 4);
    float mm[4] = {m4.x, m4.y, m4.z, m4.w}, ll[4] = {l4.x, l4.y, l4.z, l4.w};
    float M = mm[0];
#pragma unroll
    for (int s = 1; s < 4; ++s) if (ll[s] > 0.f) M = fmaxf(M, mm[s]);
    float wsum = 0.f;
    float acc[8] = {0.f, 0.f, 0.f, 0.f, 0.f, 0.f, 0.f, 0.f};
#pragma unroll
    for (int s = 0; s < 4; ++s) {
      if (s == 0 || ll[s] > 0.f) {
        const float wgt = ll[s] * __expf(mm[s] - M);
        wsum += wgt;
        uint4 ov = *(const uint4*)(PO + (th * 4 + s) * 64 + ds * 8);
        unsigned uu[4] = {ov.x, ov.y, ov.z, ov.w};
#pragma unroll
        for (int e = 0; e < 4; ++e) {
          acc[2 * e] += wgt * __uint_as_float(uu[e] << 16);
          acc[2 * e + 1] += wgt * __uint_as_float(uu[e] & 0xffff0000u);
        }
      }
    }
    const float inv = 1.f / wsum;
    const size_t t = th >> 3; const int h = (int)(th & 7);
    *(uint4*)(Y + t * 1024 + 512 + h * 64 + ds * 8) =
        make_uint4(pack2(acc[0] * inv, acc[1] * inv), pack2(acc[2] * inv, acc[3] * inv),
                   pack2(acc[4] * inv, acc[5] * inv), pack2(acc[6] * inv, acc[7] * inv));
  }
}


#define XB_TMO      128
#define XB_XCNT(j)  (256  + 64 * (j))
#define XB_XSUB(j)  (1280 + 64 * (j))
#define XB_XGEN(j)  (2304 + 64 * (j))
#define XB_TOP      3328
#define XB_TOPGEN   3392
#define XCD_BAR_WORDS 3456
#define XB_SPIN_CAP (1u << 22)
#define LAS __attribute__((address_space(3)))
DEV unsigned xb_ld(unsigned* p) { return __hip_atomic_load(p, __ATOMIC_RELAXED, __HIP_MEMORY_SCOPE_AGENT); }
DEV unsigned xb_add(unsigned* p, unsigned v) { return __hip_atomic_fetch_add(p, v, __ATOMIC_RELAXED, __HIP_MEMORY_SCOPE_AGENT); }
DEV unsigned xb_xcc_id() { return (unsigned)__builtin_amdgcn_s_getreg((3 << 11) | 20) & 0xFu; }
#define XB_SPIN(cond, bar) do { unsigned _sp = 0; while (cond) { __builtin_amdgcn_s_sleep(1); \
    if ((++_sp & 255u) == 0u) { if (xb_ld(&(bar)[XB_TMO])) break; if (_sp > XB_SPIN_CAP) { atomicAdd(&(bar)[XB_TMO], 1u); break; } } } } while (0)
struct XcdBarrier { unsigned* bar; unsigned x; volatile LAS unsigned* st; };
DEV XcdBarrier xcd_barrier_post(unsigned* bar, volatile LAS unsigned* st) {
  XcdBarrier b; b.bar = bar; b.x = xb_xcc_id(); b.st = st;
  if (threadIdx.x == 0) (void)xb_add(&bar[XB_XCNT(b.x)], 1u);
  return b;
}
DEV void xcd_barrier_complete(unsigned* bar, unsigned x, unsigned& nloc, unsigned& nx) {
  const unsigned G = gridDim.x * gridDim.y * gridDim.z;
  unsigned sum, cnt, mine, sp = 0u;
  for (;;) {
    sum = 0u; cnt = 0u; mine = 0u;
#pragma unroll
    for (unsigned j = 0; j < 16; ++j) { const unsigned c = xb_ld(&bar[XB_XCNT(j)]); sum += c; cnt += (c > 0u) ? 1u : 0u; mine = (j == x) ? c : mine; }
    if (sum == G) break;
    __builtin_amdgcn_s_sleep(1);
    if ((++sp & 255u) == 0u) { if (xb_ld(&bar[XB_TMO])) break; if (sp > XB_SPIN_CAP) { atomicAdd(&bar[XB_TMO], 1u); break; } }
  }
  nloc = mine > 0u ? mine : 1u; nx = cnt > 0u ? cnt : 1u;
}
DEV void xcd_barrier(const XcdBarrier& b) {
  asm volatile("s_waitcnt vmcnt(0)" ::: "memory");
  __syncthreads();
  if (threadIdx.x == 0) {
    unsigned* bar = b.bar;
    __builtin_amdgcn_s_waitcnt(0);
    unsigned nloc = b.st[0], nx = b.st[1];
    if (nloc == 0u) { xcd_barrier_complete(bar, b.x, nloc, nx); b.st[0] = nloc; b.st[1] = nx; }
    const unsigned old = xb_add(&bar[XB_XSUB(b.x)], 1u);
    const unsigned gen = old / nloc;
    if (old + 1u == (gen + 1u) * nloc) {
      __builtin_amdgcn_fence(__ATOMIC_RELEASE, "agent");
      asm volatile("s_waitcnt vmcnt(0)" ::: "memory");
      const unsigned og = xb_add(&bar[XB_TOP], 1u);
      const unsigned tg = og / nx;
      if (og + 1u == (tg + 1u) * nx) xb_add(&bar[XB_TOPGEN], 1u);
      else XB_SPIN(xb_ld(&bar[XB_TOPGEN]) == tg, bar);
      __builtin_amdgcn_fence(__ATOMIC_ACQUIRE, "agent");
      xb_add(&bar[XB_XGEN(b.x)], 1u);
      asm volatile("s_waitcnt vmcnt(0)" ::: "memory");
    } else {
      XB_SPIN(xb_ld(&bar[XB_XGEN(b.x)]) == gen, bar);
      __builtin_amdgcn_fence(__ATOMIC_ACQUIRE, "agent");
      asm volatile("s_waitcnt vmcnt(0)" ::: "memory");
    }
  }
  __syncthreads();
}

__global__ void __launch_bounds__(256, 2) mega(Params p) {
  __shared__ __attribute__((aligned(16))) unsigned char smem[SMEM_BYTES];
  cg::grid_group grid = cg::this_grid();
  unsigned char* ws = p.ws;
  unsigned* barw = (unsigned*)(ws + S_BAR);
  volatile LAS unsigned* xbst = (volatile LAS unsigned*)(smem + SMEM_BYTES - 16);
  if (threadIdx.x == 0) { xbst[0] = 0u; xbst[1] = 0u; }
  if (blockIdx.x == 0) for (int i = threadIdx.x; i < XCD_BAR_WORDS; i += 256) barw[i] = 0u;

#if XSYNC
  for (int i = 0; i < 20; ++i) grid.sync();
#endif
  phase_prep(p, smem);
#if (DUPMASK >> 0) & 1
  grid.sync();
  phase_prep(p, smem);
#endif
  grid.sync();
  XcdBarrier xb = xcd_barrier_post(barw, xbst);
  phase_proj((const bfu*)(ws + OFF_XB), (const bfu*)(ws + OFF_WEVIN), (bfu*)(ws + OFF_P), 2560, (bfu*)p.out, 0, smem);
#if (DUPMASK >> 1) & 1
  GSYNC;
  phase_proj((const bfu*)(ws + OFF_XB), (const bfu*)(ws + OFF_WEVIN), (bfu*)(ws + OFF_P), 2560, (bfu*)p.out, 0, smem);
#endif
  GSYNC;
  for (int it = blockIdx.x; it < 2048; it += gridDim.x) hgrn_dstate_item(p, it, smem);
  {
    uint4 bf[8], cf[4]; float2 ab; float dsk;
    s5_load_consts(p, (blockIdx.x & 7) * 4 + (my_tid() >> 6), my_tid() & 63, bf, cf, ab, dsk);
    for (int it = blockIdx.x; it < 4096; it += gridDim.x) s5_pass1_item(p, it, bf, ab, smem);
  }
#if (DUPMASK >> 2) & 1
  GSYNC;
  for (int it = blockIdx.x; it < 2048; it += gridDim.x) hgrn_dstate_item(p, it, smem);
  {
    uint4 bf[8], cf[4]; float2 ab; float dsk;
    s5_load_consts(p, (blockIdx.x & 7) * 4 + (my_tid() >> 6), my_tid() & 63, bf, cf, ab, dsk);
    for (int it = blockIdx.x; it < 4096; it += gridDim.x) s5_pass1_item(p, it, bf, ab, smem);
  }
#endif
  GSYNC;
  if (blockIdx.x < 64) hgrn_scan_item(p, blockIdx.x);
  else if (blockIdx.x < 80) s5_carry_item(p, blockIdx.x - 64);
#if (DUPMASK >> 3) & 1
  GSYNC;
  if (blockIdx.x < 64) hgrn_scan_item(p, blockIdx.x);
  else if (blockIdx.x < 80) s5_carry_item(p, blockIdx.x - 64);
#endif
  GSYNC;
  for (int it = blockIdx.x; it < 2048; it += gridDim.x) hgrn_out_item(p, it, smem);
  {
    uint4 bf[8], cf[4]; float2 ab; float dsk;
    s5_load_consts(p, (blockIdx.x & 7) * 4 + (my_tid() >> 6), my_tid() & 63, bf, cf, ab, dsk);
    for (int it = blockIdx.x; it < 4096; it += gridDim.x) s5_pass2_item(p, it, bf, cf, ab, dsk, smem);
  }
#if (DUPMASK >> 4) & 1
  GSYNC;
  for (int it = blockIdx.x; it < 2048; it += gridDim.x) hgrn_out_item(p, it, smem);
  {
    uint4 bf[8], cf[4]; float2 ab; float dsk;
    s5_load_consts(p, (blockIdx.x & 7) * 4 + (my_tid() >> 6), my_tid() & 63, bf, cf, ab, dsk);
    for (int it = blockIdx.x; it < 4096; it += gridDim.x) s5_pass2_item(p, it, bf, cf, ab, dsk, smem);
  }
#endif
  GSYNC;
  phase_glu(p, smem);
#if (DUPMASK >> 5) & 1
  GSYNC;
  phase_glu(p, smem);
#endif
  GSYNC;
  phase_outproj(p, (const bfu*)(ws + OFF_WEVOUT), smem);
#if (DUPMASK >> 6) & 1
  GSYNC;
  phase_outproj(p, (const bfu*)(ws + OFF_WEVOUT), smem);
#endif
  GSYNC;
  phase_ln1_router(p, p.x, 0, smem);
#if (DUPMASK >> 7) & 1
  GSYNC;
  if (blockIdx.x == 0 && my_tid() < 24) ((int*)(ws + S_CNT))[my_tid()] = 0;
  GSYNC;
  phase_ln1_router(p, p.x, 0, smem);
#endif
  GSYNC;
  phase_moe1(p, 0, smem);
#if (DUPMASK >> 8) & 1
  GSYNC;
  phase_moe1(p, 0, smem);
#endif
  GSYNC;
  phase_moe2(p, 0, smem);
#if (DUPMASK >> 9) & 1
  GSYNC;
  phase_moe2(p, 0, smem);
#endif
  GSYNC;
  phase_ln2(p, 0, p.out, (bfu*)(ws + OFF_X2B));
#if (DUPMASK >> 10) & 1
  GSYNC;
  phase_ln2(p, 0, p.out, (bfu*)(ws + OFF_X2B));
#endif
  GSYNC;
  phase_proj((const bfu*)(ws + OFF_X2B), (const bfu*)(ws + OFF_WODIN), (bfu*)(ws + OFF_P), 1536, (bfu*)(ws + OFF_VT), 1, smem);
#if (DUPMASK >> 11) & 1
  GSYNC;
  phase_proj((const bfu*)(ws + OFF_X2B), (const bfu*)(ws + OFF_WODIN), (bfu*)(ws + OFF_P), 1536, (bfu*)(ws + OFF_VT), 1, smem);
#endif
  GSYNC;
  for (int it = blockIdx.x; it < 4096 + 256; it += gridDim.x) {
    if (it < 4096) swa_item(p, it, smem); else kmean_item(p, it - 4096, smem);
  }
#if (DUPMASK >> 12) & 1
  GSYNC;
  for (int it = blockIdx.x; it < 4096 + 256; it += gridDim.x) {
    if (it < 4096) swa_item(p, it, smem); else kmean_item(p, it - 4096, smem);
  }
#endif
  GSYNC;
  for (int it = blockIdx.x; it < 4096; it += gridDim.x) moba_own_item(p, it, smem);
#if (DUPMASK >> 13) & 1
  GSYNC;
  if (blockIdx.x == 0) ((int*)(ws + S_CNT))[64 + my_tid()] = 0;
  GSYNC;
  for (int it = blockIdx.x; it < 4096; it += gridDim.x) moba_own_item(p, it, smem);
#endif
  GSYNC;
  phase_moba_bucket(p, smem);
#if (DUPMASK >> 14) & 1
  GSYNC;
  phase_moba_bucket(p, smem);
#endif
  GSYNC;
  phase_moba_merge(p);
#if (DUPMASK >> 15) & 1
  GSYNC;
  phase_moba_merge(p);
#endif
  GSYNC;
  phase_outproj(p, (const bfu*)(ws + OFF_WODOUT), smem);
#if (DUPMASK >> 16) & 1
  GSYNC;
  phase_outproj(p, (const bfu*)(ws + OFF_WODOUT), smem);
#endif
  GSYNC;
  phase_ln1_router(p, p.out, 1, smem);
#if (DUPMASK >> 17) & 1
  GSYNC;
  phase_ln1_router(p, p.out, 1, smem);
#endif
  GSYNC;
  phase_moe1(p, 1, smem);
#if (DUPMASK >> 18) & 1
  GSYNC;
  phase_moe1(p, 1, smem);
#endif
  GSYNC;
  phase_moe2(p, 1, smem);
#if (DUPMASK >> 19) & 1
  GSYNC;
  phase_moe2(p, 1, smem);
#endif
  GSYNC;
  phase_ln2(p, 1, p.out, (bfu*)nullptr);
#if (DUPMASK >> 20) & 1
  GSYNC;
  phase_ln2(p, 1, p.out, (bfu*)nullptr);
#endif
}

extern "C" void kernel_launch(void* const* d_in, const int* in_sizes, int n_in, void* d_out, int out_size, void* d_ws,
                              size_t ws_size, hipStream_t stream) {
  static int grid_blocks = 0;
  if (!grid_blocks) {
    int dev = 0, cus = 0, per_cu = 0;
    hipGetDevice(&dev);
    hipDeviceGetAttribute(&cus, hipDeviceAttributeMultiprocessorCount, dev);
    hipOccupancyMaxActiveBlocksPerMultiprocessor(&per_cu, mega, 256, 0);
    if (per_cu < 1) per_cu = 1;
    if (per_cu > 2) per_cu = 2;
    grid_blocks = (cus * per_cu) & ~7;
    if (ws_size < WS_NEED) fprintf(stderr, "workspace too small: %zu < %zu\n", ws_size, (size_t)WS_NEED);
  }
  Params p{};
  const float** f = (const float**)&p;
  for (int i = 0; i < 27; ++i) f[i] = (const float*)d_in[i];
  p.out = (float*)d_out;
  p.ws = (unsigned char*)d_ws;
  void* args[] = {&p};
  hipError_t e = hipLaunchCooperativeKernel((void*)mega, dim3(grid_blocks), dim3(256), args, 0, stream);
  if (e != hipSuccess) fprintf(stderr, "cooperative launch failed: %s (grid %d)\n", hipGetErrorString(e), grid_blocks);
}
```
